# Optimizing an MI355X kernel written in HIP

```python
import math
import jax, jax.numpy as jnp
from jax import lax
import numpy as np

D_MODEL = 4096
BATCH = 4
SEQ = 4096
DEPTH = 1

GRID_W = 64
MIX_WIDTH = D_MODEL
HG_WIDTH = MIX_WIDTH // 2
NA_WIDTH = MIX_WIDTH - HG_WIDTH
HG_HEAD_DIM = 128
HG_HEADS = HG_WIDTH // HG_HEAD_DIM
NA_HEAD_DIM = 128
NA_HEADS = NA_WIDTH // NA_HEAD_DIM
NA_WIN_ROWS = 8
NA_WIN_COLS = 16
HG_CHUNK = 64
D_FF = ((8 * D_MODEL // 3 + 255) // 256) * 256
FFN_RES_WEIGHT = 0.5
EPS = 1e-6
IN_COLS = 5 * HG_WIDTH + 3 * NA_WIDTH
IN_SPLITS = [HG_WIDTH, 2 * HG_WIDTH, 3 * HG_WIDTH, 4 * HG_WIDTH, 5 * HG_WIDTH,
             5 * HG_WIDTH + NA_WIDTH, 5 * HG_WIDTH + 2 * NA_WIDTH]

kernel_name = "hybrid_hgrn2_natten_macaron_block"


def rmsnorm(x, gain):
    xf = x.astype(jnp.float32)
    y = xf * lax.rsqrt(jnp.mean(xf * xf, axis=-1, keepdims=True) + EPS)
    return (y * gain.astype(jnp.float32)).astype(x.dtype)


def swiglu(x, w_gate, w_up, w_down):
    return (jax.nn.silu(x @ w_gate) * (x @ w_up)) @ w_down


def gla_chunkwise(q, k, v, log_f):
    B, T, H, DK = q.shape
    DV = v.shape[-1]
    n_chunks = T // HG_CHUNK

    def to_chunks(a):
        return a.reshape(B, n_chunks, HG_CHUNK, H, a.shape[-1]).transpose(1, 0, 3, 2, 4)

    xs = tuple(to_chunks(a) for a in (q, k, v, log_f))
    tri = jnp.tril(jnp.ones((HG_CHUNK, HG_CHUNK), dtype=bool))

    def step(S, chunk):
        qb, kb, vb, gb = chunk
        b = jnp.cumsum(gb, axis=-2)
        diff = b[..., :, None, :] - b[..., None, :, :]
        decay = jnp.exp(jnp.where(tri[:, :, None], diff, -jnp.inf))
        scores = jnp.einsum('bhtk,bhsk,bhtsk->bhts', qb, kb, decay)
        o = (jnp.einsum('bhts,bhsv->bhtv', scores, vb)
             + jnp.einsum('bhtk,bhkv->bhtv', qb * jnp.exp(b), S))
        b_last = b[..., -1:, :]
        S = (jnp.exp(b_last[..., 0, :])[..., None] * S
             + jnp.einsum('bhsk,bhsv->bhkv', kb * jnp.exp(b_last - b), vb))
        return S, o

    S0 = jnp.zeros((B, H, DK, DV), jnp.float32)
    _, o = lax.scan(step, S0, xs)
    return o.transpose(1, 0, 3, 2, 4).reshape(B, T, H, DV)


def hgrn2_bidirectional(q_raw, f_fwd_raw, f_bwd_raw, i_raw, g_raw, lb_logits, layer, head_norm):
    B, T, _ = q_raw.shape
    out_dtype = q_raw.dtype
    lb = jnp.cumsum(jax.nn.softmax(lb_logits.astype(jnp.float32), axis=0), axis=0)[layer]

    def heads(a):
        return a.astype(jnp.float32).reshape(B, T, HG_HEADS, HG_HEAD_DIM)

    qh = heads(jax.nn.silu(q_raw))
    vh = heads(i_raw)

    def direction(f_raw, lb_d, reverse):
        f = lb_d + (1.0 - lb_d) * jax.nn.sigmoid(f_raw.astype(jnp.float32))
        fh = heads(f)
        args = (qh, 1.0 - fh, vh, jnp.log(fh))
        if reverse:
            args = tuple(jnp.flip(a, axis=1) for a in args)
        o = gla_chunkwise(*args)
        return jnp.flip(o, axis=1) if reverse else o

    o = direction(f_fwd_raw, lb[0], False) + direction(f_bwd_raw, lb[1], True)
    o = rmsnorm(o, head_norm) * jax.nn.silu(heads(g_raw))
    return o.reshape(B, T, HG_WIDTH).astype(out_dtype)


def neighbourhood_attention_2d(q, k, v, rpb):
    B, T, _ = q.shape
    rows = T // GRID_W
    kr = min(NA_WIN_ROWS, rows)
    kc = NA_WIN_COLS

    def grid(a):
        return a.reshape(B, rows, GRID_W, NA_HEADS, NA_HEAD_DIM).transpose(0, 3, 1, 2, 4)

    qg, kg, vg = grid(q), grid(k), grid(v)
    col = jnp.arange(GRID_W)
    col_start = jnp.clip(col - kc // 2, 0, GRID_W - kc)
    col_mask = (col[None, :] >= col_start[:, None]) & (col[None, :] < col_start[:, None] + kc)
    dc_idx = jnp.clip(col[None, :] - col[:, None] + NA_WIN_COLS - 1, 0, 2 * NA_WIN_COLS - 2)
    rpb32 = rpb.astype(jnp.float32)
    scale = NA_HEAD_DIM ** -0.5

    def one_row(args):
        r, q_row = args
        row_start = jnp.clip(r - kr // 2, 0, rows - kr)
        k_blk = lax.dynamic_slice_in_dim(kg, row_start, kr, axis=2)
        v_blk = lax.dynamic_slice_in_dim(vg, row_start, kr, axis=2)
        s = jnp.einsum('bhcd,bhrwd->bhcrw', q_row, k_blk).astype(jnp.float32) * scale
        dr_idx = row_start + jnp.arange(kr) - r + NA_WIN_ROWS - 1
        bias = rpb32[:, dr_idx[None, :, None], dc_idx[:, None, :]]
        s = jnp.where(col_mask[:, None, :], s + bias, -jnp.inf)
        p = jax.nn.softmax(s.reshape(B, NA_HEADS, GRID_W, kr * GRID_W), axis=-1).reshape(s.shape)
        return jnp.einsum('bhcrw,bhrwd->bhcd', p.astype(v_blk.dtype), v_blk)

    out = lax.map(one_row, (jnp.arange(rows), qg.transpose(2, 0, 1, 3, 4)))
    return out.transpose(1, 0, 3, 2, 4).reshape(B, T, NA_WIDTH)


def setup_inputs(seed: int = 0) -> dict:
    key = jax.random.key(seed)
    ks = jax.random.split(key, 20)
    f32 = jnp.float32

    def normal(k, shape, scale):
        return jax.random.normal(k, shape, f32) * scale

    def gain(k, shape):
        return 1.0 + 0.01 * jax.random.normal(k, shape, f32)

    return {
        "x": jax.random.normal(ks[0], (BATCH, SEQ, D_MODEL), f32),
        "ffn1_norm_pre": gain(ks[1], (DEPTH, D_MODEL)),
        "ffn1_w_gate": normal(ks[2], (DEPTH, D_MODEL, D_FF), D_MODEL ** -0.5),
        "ffn1_w_up": normal(ks[3], (DEPTH, D_MODEL, D_FF), D_MODEL ** -0.5),
        "ffn1_w_down": normal(ks[4], (DEPTH, D_FF, D_MODEL), D_FF ** -0.5),
        "ffn1_norm_post": gain(ks[5], (DEPTH, D_MODEL)),
        "mix_norm_pre": gain(ks[6], (DEPTH, D_MODEL)),
        "w_in": normal(ks[7], (DEPTH, D_MODEL, IN_COLS), D_MODEL ** -0.5),
        "hgrn_lb_logits": normal(ks[8], (DEPTH + 1, 2, HG_WIDTH), 1.0),
        "hgrn_head_norm": gain(ks[9], (DEPTH, HG_HEAD_DIM)),
        "na_rpb": normal(ks[10], (DEPTH, NA_HEADS, 2 * NA_WIN_ROWS - 1, 2 * NA_WIN_COLS - 1), 0.02),
        "w_out": normal(ks[11], (DEPTH, MIX_WIDTH, D_MODEL), MIX_WIDTH ** -0.5),
        "mix_norm_post": gain(ks[12], (DEPTH, D_MODEL)),
        "ffn2_norm_pre": gain(ks[13], (DEPTH, D_MODEL)),
        "ffn2_w_gate": normal(ks[14], (DEPTH, D_MODEL, D_FF), D_MODEL ** -0.5),
        "ffn2_w_up": normal(ks[15], (DEPTH, D_MODEL, D_FF), D_MODEL ** -0.5),
        "ffn2_w_down": normal(ks[16], (DEPTH, D_FF, D_MODEL), D_FF ** -0.5),
        "ffn2_norm_post": gain(ks[17], (DEPTH, D_MODEL)),
    }


def reference(x, ffn1_norm_pre, ffn1_w_gate, ffn1_w_up, ffn1_w_down, ffn1_norm_post,
              mix_norm_pre, w_in, hgrn_lb_logits, hgrn_head_norm, na_rpb, w_out, mix_norm_post,
              ffn2_norm_pre, ffn2_w_gate, ffn2_w_up, ffn2_w_down, ffn2_norm_post):
    h = x
    for layer in range(DEPTH):
        ff = swiglu(rmsnorm(h, ffn1_norm_pre[layer]), ffn1_w_gate[layer], ffn1_w_up[layer], ffn1_w_down[layer])
        h = h + FFN_RES_WEIGHT * rmsnorm(ff, ffn1_norm_post[layer])

        u = rmsnorm(h, mix_norm_pre[layer])
        proj = u @ w_in[layer]
        hq, hf_fwd, hf_bwd, hi, hg, nq, nk, nv = jnp.split(proj, IN_SPLITS, axis=-1)
        o_hg = hgrn2_bidirectional(hq, hf_fwd, hf_bwd, hi, hg, hgrn_lb_logits, layer, hgrn_head_norm[layer])
        o_na = neighbourhood_attention_2d(nq, nk, nv, na_rpb[layer])
        mixed = jnp.concatenate([o_hg, o_na], axis=-1) @ w_out[layer]
        h = h + rmsnorm(mixed, mix_norm_post[layer])

        ff = swiglu(rmsnorm(h, ffn2_norm_pre[layer]), ffn2_w_gate[layer], ffn2_w_up[layer], ffn2_w_down[layer])
        h = h + FFN_RES_WEIGHT * rmsnorm(ff, ffn2_norm_post[layer])
    return h
```

```cpp
#include <hip/hip_runtime.h>
#include <cstdio>
#include <cstdint>

#ifndef MK_PER_PHASE
#define MK_PER_PHASE 1
#endif

namespace pg8 {
#define PG8_LAS __attribute__((address_space(3)))
typedef unsigned short bf16_t;
typedef short bf16x8 __attribute__((ext_vector_type(8)));
typedef float f32x4 __attribute__((ext_vector_type(4)));
typedef unsigned u32x4 __attribute__((ext_vector_type(4)));
constexpr int BM = 256, BK = 64, HALF = 128, HTB = HALF * BK * 2  , STAGE_BYTES = 8 * HTB, NXCD = 8, WGM = 8;

__host__ __device__ __forceinline__ int lds_byte(int r, int c) { const int st = (r >> 4) * 2 + (c >> 5), rr = r & 15, cc = c & 31, ob = rr * 64 + cc * 2; return st * 1024 + (ob ^ (((ob >> 9) & 1) << 5)); }
__host__ __device__ __forceinline__ void stage_rc(int b, int& R, int& C) { const int st = b / 1024, sb = b % 1024, swz = sb ^ (((sb >> 9) & 1) << 5); R = (st >> 1) * 16 + swz / 64; C = (st & 1) * 32 + (swz % 64) / 2; }
__host__ __device__ __forceinline__ int perm32(int rho) { const int n = rho >> 4, i = rho & 15; return 8 * (i >> 2) + 4 * n + (i & 3); }

struct Unit { int pm, pn; };
struct Gemm { const bf16_t* A; const bf16_t* Bt; int M, N, K; };

struct StaticOrder {
    int nM, nN, nwg, G, c;
    __host__ __device__ void init(int M, int N, int G_, int c_) { nM = M / BM; nN = N / BM; nwg = nM * nN; G = G_; c = c_; }
    __host__ __device__ bool next(int i, Unit& u) const {
        const long L = (long)i * G + c; if (L >= nwg) return false;
        int wgid = (int)L; { const int q = nwg / NXCD, r = nwg % NXCD, xcd = wgid % NXCD, off = wgid / NXCD; wgid = (xcd < r ? xcd * (q + 1) : r * (q + 1) + (xcd - r) * q) + off; }
        const int nig = WGM * nN, gid = wgid / nig, fm = gid * WGM, gsz = (nM - fm) < WGM ? (nM - fm) : WGM;
        u.pm = fm + ((wgid % nig) % gsz); u.pn = (wgid % nig) / gsz; return true;
    }
    __device__ __forceinline__ void a_ready(const Unit&) const {}
    __device__ __forceinline__ void done(const Unit&) const {}
};

__device__ __forceinline__ unsigned cvt_pk_bf16(float lo, float hi) { unsigned r; asm volatile("v_cvt_pk_bf16_f32 %0, %1, %2" : "=v"(r) : "v"(lo), "v"(hi)); return r; }
__device__ __forceinline__ unsigned cvt_pk_f16(float lo, float hi) { typedef _Float16 h2 __attribute__((ext_vector_type(2))); h2 v; v.x = (_Float16)lo; v.y = (_Float16)hi; return __builtin_bit_cast(unsigned, v); }
__device__ __forceinline__ float sigmoidf_fast(float v) { return __builtin_amdgcn_rcpf(1.0f + __builtin_amdgcn_exp2f(-1.4426950408889634f * v)); }

struct EpiF32 {
    static constexpr bool PERM = false, AFTER_DRAIN = false;
    float* C; int ldc;
    __device__ __forceinline__ void operator()(const f32x4 (&acc)[2][2][4][2], const Unit& u, int wr, int wc, int fr, int fq) const {
        const int row0 = u.pm * BM + wr * 64 + fr, col0 = u.pn * BM + wc * 32 + 4 * fq;
#pragma unroll
        for (int ai = 0; ai < 2; ++ai)
#pragma unroll
            for (int m = 0; m < 4; ++m) { float* rowp = C + (size_t)(row0 + ai * HALF + m * 16) * ldc + col0;
#pragma unroll
                for (int bj = 0; bj < 2; ++bj)
#pragma unroll
                    for (int n = 0; n < 2; ++n) *(f32x4*)(rowp + bj * HALF + n * 16) = acc[ai][bj][m][n]; }
    }
};
struct EpiBf16Plain {
    static constexpr bool PERM = true, AFTER_DRAIN = false;
    bf16_t* O; int ldc;
    __device__ __forceinline__ void operator()(const f32x4 (&acc)[2][2][4][2], const Unit& u, int wr, int wc, int fr, int fq) const {
        const int row0 = u.pm * BM + wr * 64 + fr, col0 = u.pn * BM + wc * 32 + 8 * fq;
#pragma unroll
        for (int ai = 0; ai < 2; ++ai)
#pragma unroll
            for (int m = 0; m < 4; ++m) { bf16_t* rowp = O + (size_t)(row0 + ai * HALF + m * 16) * ldc + col0;
#pragma unroll
                for (int bj = 0; bj < 2; ++bj) { const f32x4 v0 = acc[ai][bj][m][0], v1 = acc[ai][bj][m][1];
                    u32x4 w; w.x = cvt_pk_bf16(v0[0], v0[1]); w.y = cvt_pk_bf16(v0[2], v0[3]); w.z = cvt_pk_bf16(v1[0], v1[1]); w.w = cvt_pk_bf16(v1[2], v1[3]);
                    *(u32x4*)(rowp + bj * HALF) = w; } }
    }
};
struct EpiSwiGLU {
    static constexpr bool PERM = true, AFTER_DRAIN = false;
    bf16_t* H; int ldc;
    __device__ __forceinline__ void operator()(const f32x4 (&acc)[2][2][4][2], const Unit& u, int wr, int wc, int fr, int fq) const {
        const int row0 = u.pm * BM + wr * 64 + fr, col0 = u.pn * HALF + wc * 32 + 8 * fq;
#pragma unroll
        for (int ai = 0; ai < 2; ++ai)
#pragma unroll
            for (int m = 0; m < 4; ++m) { bf16_t* rowp = H + (size_t)(row0 + ai * HALF + m * 16) * ldc + col0;
                float h[8];
#pragma unroll
                for (int n = 0; n < 2; ++n)
#pragma unroll
                    for (int e = 0; e < 4; ++e) { const float g = acc[ai][0][m][n][e], up = acc[ai][1][m][n][e]; h[4 * n + e] = g * sigmoidf_fast(g) * up; }
                u32x4 w; w.x = cvt_pk_bf16(h[0], h[1]); w.y = cvt_pk_bf16(h[2], h[3]); w.z = cvt_pk_bf16(h[4], h[5]); w.w = cvt_pk_bf16(h[6], h[7]);
                *(u32x4*)rowp = w; }
    }
};
struct EpiProj {
    static constexpr bool PERM = true, AFTER_DRAIN = false;
    bf16_t* P; int ldc; const float* lb;
    __device__ __forceinline__ void operator()(const f32x4 (&acc)[2][2][4][2], const Unit& u, int wr, int wc, int fr, int fq) const {
        const int sec = u.pn >> 3;
        const int row0 = u.pm * BM + wr * 64 + fr, col0 = u.pn * BM + wc * 32 + 8 * fq;
        const bool isg = (sec == 1 || sec == 2), act = (sec == 0 || sec == 4); const float sc = (sec == 5) ? 0.08838834764831845f : 1.0f;
        const float* lbp = lb + (isg ? (col0 - 2048) : 0);
#pragma unroll
        for (int ai = 0; ai < 2; ++ai)
#pragma unroll
            for (int m = 0; m < 4; ++m) { bf16_t* rowp = P + (size_t)(row0 + ai * HALF + m * 16) * ldc + col0;
#pragma unroll
                for (int bj = 0; bj < 2; ++bj) { float g[8]; u32x4 w;
                    if (isg) {
                        const f32x4 la = *(const f32x4*)(lbp + bj * HALF), lc = *(const f32x4*)(lbp + bj * HALF + 4);
#pragma unroll
                        for (int e = 0; e < 4; ++e) { const float f0 = la[e] + (1.0f - la[e]) * sigmoidf_fast(acc[ai][bj][m][0][e]), f1 = lc[e] + (1.0f - lc[e]) * sigmoidf_fast(acc[ai][bj][m][1][e]);
                            g[e] = __builtin_amdgcn_logf(f0) * 0.6931471805599453f; g[4 + e] = __builtin_amdgcn_logf(f1) * 0.6931471805599453f; }
                        w.x = cvt_pk_f16(g[0], g[1]); w.y = cvt_pk_f16(g[2], g[3]); w.z = cvt_pk_f16(g[4], g[5]); w.w = cvt_pk_f16(g[6], g[7]);
                    } else {
#pragma unroll
                        for (int n = 0; n < 2; ++n)
#pragma unroll
                            for (int e = 0; e < 4; ++e) { const float v = acc[ai][bj][m][n][e]; g[4 * n + e] = act ? v * sigmoidf_fast(v) : v * sc; }
                        w.x = cvt_pk_bf16(g[0], g[1]); w.y = cvt_pk_bf16(g[2], g[3]); w.z = cvt_pk_bf16(g[4], g[5]); w.w = cvt_pk_bf16(g[6], g[7]);
                    }
                    *(u32x4*)(rowp + bj * HALF) = w; }
                asm volatile("" ::: "memory"); }
    }
};

template <class Epi, class Sched, bool ALIGN_EPI = false, bool SP2 = false>
__device__ __forceinline__ void gemm_phase(PG8_LAS unsigned char* lds, const Gemm g, const Sched& S, const Epi& E) {
    int tid_ = threadIdx.x; asm volatile("" : "+v"(tid_));
    const int tid = tid_, wid = __builtin_amdgcn_readfirstlane(tid >> 6), lane = tid & 63, wr = wid >> 2, wc = wid & 3, fr = lane & 15, fq = lane >> 4;
    const int K = g.K, nt = K / BK;
    unsigned voffA[2], voffB[2];
#pragma unroll
    for (int i = 0; i < 2; ++i) { int R, C; stage_rc(tid * 16 + i * 8192, R, C); const int Rb = Epi::PERM ? ((R & ~31) + perm32(R & 31)) : R;
        voffA[i] = (unsigned)(R * K + C) * 2u; voffB[i] = (unsigned)(Rb * K + C) * 2u; }
    const size_t kstep = (size_t)(BK * 2);
    const size_t hstep = (size_t)HALF * K * 2;
    const size_t tstep = 2 * hstep;
    const unsigned ldsw = (unsigned)wid * 1024u;
    const int aoff = lds_byte(wr * 64 + fr, fq * 8), boff = lds_byte(wc * 32 + fr, fq * 8);
#define PG8_SA(b, h) (((b) * 2 + (h)) * HTB)
#define PG8_SB(b, h) ((4 + (b) * 2 + (h)) * HTB)
#define PG8_STAGE(bufoff, gbase, voff) do { _Pragma("unroll") for (int _i = 0; _i < 2; ++_i) \
        __builtin_amdgcn_global_load_lds((const unsigned*)((const char*)(gbase) + (voff)[_i]), (PG8_LAS unsigned*)(lds + (bufoff) + ldsw + _i * 8192), 16, 0, 0); } while (0)
#define PG8_LDA(dst, b, h) do { _Pragma("unroll") for (int m = 0; m < 4; ++m) _Pragma("unroll") for (int k = 0; k < 2; ++k) dst[m][k] = *(const PG8_LAS bf16x8*)(lds + PG8_SA(b, h) + aoff + m * 2048 + k * 1024); } while (0)
#define PG8_LDB(dst, b, h) do { _Pragma("unroll") for (int n = 0; n < 2; ++n) _Pragma("unroll") for (int k = 0; k < 2; ++k) dst[n][k] = *(const PG8_LAS bf16x8*)(lds + PG8_SB(b, h) + boff + n * 2048 + k * 1024); } while (0)
#define PG8_MMA(ai, bj, At, Bt) do { __builtin_amdgcn_s_setprio(1); _Pragma("unroll") for (int m = 0; m < 4; ++m) _Pragma("unroll") for (int n = 0; n < 2; ++n) _Pragma("unroll") for (int k = 0; k < 2; ++k) \
        acc[ai][bj][m][n] = __builtin_amdgcn_mfma_f32_16x16x32_bf16(Bt[n][k], At[m][k], acc[ai][bj][m][n], 0, 0, 0); __builtin_amdgcn_s_setprio(0); } while (0)
#define PG8_WAIT_V(n) asm volatile("s_waitcnt vmcnt(" #n ")" ::: "memory")
#define PG8_WAIT_L(n) asm volatile("s_waitcnt lgkmcnt(" #n ")" ::: "memory")
#define PG8_BAR __builtin_amdgcn_s_barrier()
#define PG8_SCHED __builtin_amdgcn_sched_barrier(0)
    Unit cur, nxt; int ui = 0;
    if (!S.next(0, cur)) return;
    f32x4 acc[2][2][4][2];
#pragma unroll
    for (int a = 0; a < 2; ++a)
#pragma unroll
        for (int b = 0; b < 2; ++b)
#pragma unroll
            for (int m = 0; m < 4; ++m)
#pragma unroll
                for (int n = 0; n < 2; ++n) acc[a][b][m][n] = (f32x4){0.f, 0.f, 0.f, 0.f};
    bf16x8 At[4][2], B0[2][2], B1[2][2];
    const char* cA = (const char*)g.A + (size_t)cur.pm * tstep; const char* cB = (const char*)g.Bt + (size_t)cur.pn * tstep;
    S.a_ready(cur);
    if constexpr (SP2) {
        PG8_STAGE(PG8_SB(0, 0), cB, voffB); PG8_STAGE(PG8_SB(0, 1), cB + hstep, voffB); PG8_STAGE(PG8_SA(0, 0), cA, voffA); PG8_STAGE(PG8_SA(0, 1), cA + hstep, voffA);
        if (wr == 1) PG8_BAR;
        PG8_WAIT_V(2); PG8_BAR;
        PG8_STAGE(PG8_SB(1, 0), cB + kstep, voffB); PG8_STAGE(PG8_SA(1, 0), cA + kstep, voffA); PG8_STAGE(PG8_SB(1, 1), cB + hstep + kstep, voffB);
        PG8_WAIT_V(6); PG8_BAR;
    } else {
        PG8_STAGE(PG8_SB(0, 0), cB, voffB); PG8_STAGE(PG8_SA(0, 0), cA, voffA); PG8_STAGE(PG8_SB(0, 1), cB + hstep, voffB); PG8_STAGE(PG8_SA(0, 1), cA + hstep, voffA);
        if (wr == 1) PG8_BAR;
        PG8_WAIT_V(4); PG8_BAR;
        PG8_STAGE(PG8_SB(1, 0), cB + kstep, voffB); PG8_STAGE(PG8_SA(1, 0), cA + kstep, voffA); PG8_STAGE(PG8_SB(1, 1), cB + hstep + kstep, voffB);
        PG8_WAIT_V(6); PG8_BAR;
    }
    for (;;) {
        const bool has_next = S.next(ui + 1, nxt);
        const char* nA = has_next ? (const char*)g.A + (size_t)nxt.pm * tstep : cA; const char* nB = has_next ? (const char*)g.Bt + (size_t)nxt.pn * tstep : cB;
        for (int t = 0; t < nt; t += 2) {
            const bool last = (t == nt - 2);
            const char* a1 = cA + (size_t)(t + 1) * kstep;
            const char* a2 = last ? nA : cA + (size_t)(t + 2) * kstep; const char* b2 = last ? nB : cB + (size_t)(t + 2) * kstep;
            const char* a3 = a2 + kstep; const char* b3 = b2 + kstep;
            if (last && has_next) S.a_ready(nxt);
            if constexpr (SP2) {
            PG8_LDB(B0, 0, 0); PG8_LDB(B1, 0, 1); PG8_SCHED; PG8_LDA(At, 0, 0); PG8_STAGE(PG8_SA(1, 1), a1 + hstep, voffA);
            PG8_WAIT_V(8); PG8_WAIT_L(0); PG8_BAR; PG8_MMA(0, 0, At, B0); PG8_MMA(0, 1, At, B1); PG8_BAR; PG8_SCHED;
            PG8_LDA(At, 0, 1); PG8_STAGE(PG8_SB(0, 0), b2, voffB); PG8_STAGE(PG8_SB(0, 1), b2 + hstep, voffB); PG8_STAGE(PG8_SA(0, 0), a2, voffA);
            PG8_WAIT_V(8); PG8_WAIT_L(0); PG8_BAR; PG8_MMA(1, 0, At, B0); PG8_MMA(1, 1, At, B1); PG8_BAR; PG8_SCHED;
            PG8_LDB(B0, 1, 0); PG8_LDB(B1, 1, 1); PG8_SCHED; PG8_LDA(At, 1, 0); PG8_STAGE(PG8_SA(0, 1), a2 + hstep, voffA);
            PG8_WAIT_V(8); PG8_WAIT_L(0); PG8_BAR; PG8_MMA(0, 0, At, B0); PG8_MMA(0, 1, At, B1); PG8_BAR; PG8_SCHED;
            PG8_LDA(At, 1, 1); PG8_STAGE(PG8_SB(1, 0), b3, voffB); PG8_STAGE(PG8_SB(1, 1), b3 + hstep, voffB); PG8_STAGE(PG8_SA(1, 0), a3, voffA);
            PG8_WAIT_V(8); PG8_WAIT_L(0); PG8_BAR; PG8_MMA(1, 0, At, B0); PG8_MMA(1, 1, At, B1); PG8_BAR; PG8_SCHED;
            } else {
            PG8_LDB(B0, 0, 0); PG8_SCHED; PG8_LDA(At, 0, 0); PG8_STAGE(PG8_SA(1, 1), a1 + hstep, voffA);
            PG8_WAIT_L(8); PG8_BAR; PG8_WAIT_L(0); PG8_MMA(0, 0, At, B0); PG8_BAR; PG8_SCHED;
            PG8_LDB(B1, 0, 1); PG8_STAGE(PG8_SB(0, 0), b2, voffB);
            PG8_BAR; PG8_WAIT_L(0); PG8_MMA(0, 1, At, B1); PG8_BAR;
            PG8_LDA(At, 0, 1); PG8_STAGE(PG8_SA(0, 0), a2, voffA);
            PG8_BAR; PG8_WAIT_L(0); PG8_MMA(1, 0, At, B0); PG8_BAR; PG8_SCHED;
            PG8_STAGE(PG8_SB(0, 1), b2 + hstep, voffB);
            PG8_WAIT_V(6); PG8_BAR; PG8_MMA(1, 1, At, B1); PG8_BAR;
            PG8_LDB(B0, 1, 0); PG8_SCHED; PG8_LDA(At, 1, 0); PG8_STAGE(PG8_SA(0, 1), a2 + hstep, voffA);
            PG8_WAIT_L(8); PG8_BAR; PG8_WAIT_L(0); PG8_MMA(0, 0, At, B0); PG8_BAR; PG8_SCHED;
            PG8_LDB(B1, 1, 1); PG8_STAGE(PG8_SB(1, 0), b3, voffB);
            PG8_BAR; PG8_WAIT_L(0); PG8_MMA(0, 1, At, B1); PG8_BAR;
            PG8_LDA(At, 1, 1); PG8_STAGE(PG8_SA(1, 0), a3, voffA);
            PG8_BAR; PG8_WAIT_L(0); PG8_MMA(1, 0, At, B0); PG8_BAR; PG8_SCHED;
            PG8_STAGE(PG8_SB(1, 1), b3 + hstep, voffB);
            PG8_WAIT_V(6); PG8_BAR; PG8_MMA(1, 1, At, B1); PG8_BAR;
            }
        }
        if constexpr (ALIGN_EPI) { if (wr == 0) PG8_BAR; }
        if constexpr (!Epi::AFTER_DRAIN) { E(acc, cur, wr, wc, fr, fq); S.done(cur); }
        if (!has_next) break;
#pragma unroll
        for (int a = 0; a < 2; ++a)
#pragma unroll
            for (int b = 0; b < 2; ++b)
#pragma unroll
                for (int m = 0; m < 4; ++m)
#pragma unroll
                    for (int n = 0; n < 2; ++n) acc[a][b][m][n] = (f32x4){0.f, 0.f, 0.f, 0.f};
        cur = nxt; cA = nA; cB = nB; ++ui;
        if constexpr (ALIGN_EPI) { if (wr == 1) PG8_BAR; }
    }
    PG8_WAIT_V(0);
    if constexpr (!ALIGN_EPI) { if (wr == 0) PG8_BAR; }
    PG8_BAR;
#undef PG8_SA
#undef PG8_SB
#undef PG8_STAGE
#undef PG8_LDA
#undef PG8_LDB
#undef PG8_MMA
#undef PG8_WAIT_V
#undef PG8_WAIT_L
#undef PG8_BAR
#undef PG8_SCHED
}
}

constexpr int NWAVES = 8;
constexpr int DM = 4096, BATCH = 4, SEQ = 4096, MROWS = BATCH * SEQ;
constexpr int FF = 11008, HGW = 2048, NAW = 2048, HD = 128, NHEAD = 16;
constexpr int PROJ_W = 14336;
constexpr int C_Q = 0, C_GF = 2048, C_GB = 4096, C_I = 6144, C_GATE = 8192, C_NQ = 10240, C_NK = 12288;
constexpr int GRID_W = 64, NROWS = 64, WIN_R = 8, WIN_C = 16;
constexpr float EPS = 1e-6f;
constexpr int N_PHASES = 12;

constexpr size_t MiB = 1u << 20;
constexpr size_t WS_CTL = 0, CTL_ZERO_BYTES = 1 * MiB;
constexpr size_t WS_LB = 1 * MiB;
constexpr size_t WS_WGU1 = 2 * MiB, WS_WD1 = 174 * MiB, WS_WIN = 260 * MiB, WS_WOUT = 388 * MiB, WS_WGU2 = 420 * MiB, WS_WD2 = 592 * MiB;
constexpr size_t WS_R1 = 678 * MiB;
constexpr size_t WS_VT = WS_R1 + 448 * MiB;
constexpr size_t WS_R2 = 1190 * MiB;
constexpr size_t WS_R3 = 1446 * MiB;
constexpr size_t WS_END = 1574 * MiB;
static_assert((size_t)2 * FF * DM * 2 <= 172 * MiB && (size_t)FF * DM * 2 <= 86 * MiB, "weights");
static_assert((size_t)MROWS * PROJ_W * 2 == 448 * MiB && (size_t)MROWS * FF * 2 <= 512 * MiB, "R1");
constexpr int CW_TMO = 0, CW_CODE = 1;
constexpr int CW_BAR = 4096;
constexpr int CW_QUEUE = 8192;

constexpr int RING_OFF = 0, RING_BYTES = 131072;
constexpr int LDSCTL_OFF = RING_BYTES, MISC_OFF = LDSCTL_OFF + 320;
constexpr int LDS_BYTES = 147456;

#define GAS __attribute__((address_space(1)))
#define LAS __attribute__((address_space(3)))
typedef unsigned short bf16;
typedef unsigned v4u __attribute__((ext_vector_type(4)));
typedef unsigned v2u __attribute__((ext_vector_type(2)));
typedef float f32x4 __attribute__((ext_vector_type(4)));
typedef GAS unsigned gu32;
#define RLX_AGENT __ATOMIC_RELAXED, __HIP_MEMORY_SCOPE_AGENT
#define LDS_WAIT() asm volatile("s_waitcnt lgkmcnt(0)" ::: "memory")
#define VM_WAIT() asm volatile("s_waitcnt vmcnt(0)" ::: "memory")
__device__ __forceinline__ unsigned f2bf(float f) { unsigned u = __builtin_bit_cast(unsigned, f); return (u + 0x7fffu + ((u >> 16) & 1u)) >> 16; }
__device__ __forceinline__ unsigned pk2(float lo, float hi) { return f2bf(lo) | (f2bf(hi) << 16); }
__device__ __forceinline__ float bf2f(unsigned short b) { return __builtin_bit_cast(float, (unsigned)b << 16); }
__device__ __forceinline__ float bflo(unsigned w) { return __builtin_bit_cast(float, w << 16); }
__device__ __forceinline__ float bfhi(unsigned w) { return __builtin_bit_cast(float, w & 0xffff0000u); }
__device__ __forceinline__ float h2f(unsigned short b) { return (float)__builtin_bit_cast(_Float16, b); }

#define XB_TMO      128
#define XB_XCNT(j)  (256  + 64 * (j))
#define XB_XSUB(j)  (1280 + 64 * (j))
#define XB_XGEN(j)  (2304 + 64 * (j))
#define XB_TOP      3328
#define XB_TOPGEN   3392
#define XCD_BAR_WORDS 3456
#define XB_SPIN_CAP (1u << 18)
__device__ __forceinline__ unsigned xb_ld(unsigned* p)              { return __hip_atomic_load(p, __ATOMIC_RELAXED, __HIP_MEMORY_SCOPE_AGENT); }
__device__ __forceinline__ unsigned xb_add(unsigned* p, unsigned v) { return __hip_atomic_fetch_add(p, v, __ATOMIC_RELAXED, __HIP_MEMORY_SCOPE_AGENT); }
__device__ __forceinline__ unsigned xb_xcc_id() { return (unsigned)__builtin_amdgcn_s_getreg((3 << 11) | 20) & 0xFu; }
#define XB_SPIN(cond, bar) do { unsigned _sp = 0; while (cond) { __builtin_amdgcn_s_sleep(1); \
    if ((++_sp & 255u) == 0u) { if (xb_ld(&(bar)[XB_TMO])) break; if (_sp > XB_SPIN_CAP) { atomicAdd(&(bar)[XB_TMO], 1u); break; } } } } while (0)
struct XcdBarrier { unsigned* bar; unsigned x; volatile LAS unsigned* st; };
__device__ __forceinline__ XcdBarrier xcd_barrier_post(unsigned* bar, volatile LAS unsigned* st) {
    XcdBarrier b; b.bar = bar; b.x = xb_xcc_id(); b.st = st;
    if (threadIdx.x == 0) (void)xb_add(&bar[XB_XCNT(b.x)], 1u);
    return b;
}
__device__ __forceinline__ void xcd_barrier_complete(unsigned* bar, unsigned x, unsigned& nloc, unsigned& nx) {
    const unsigned G = gridDim.x * gridDim.y * gridDim.z;
    unsigned sum, cnt, mine, sp = 0u;
    for (;;) {
        sum = 0u; cnt = 0u; mine = 0u;
#pragma unroll
        for (unsigned j = 0; j < 16; ++j) { const unsigned c = xb_ld(&bar[XB_XCNT(j)]); sum += c; cnt += (c > 0u) ? 1u : 0u; mine = (j == x) ? c : mine; }
        if (sum == G) break;
        __builtin_amdgcn_s_sleep(1);
        if ((++sp & 255u) == 0u) { if (xb_ld(&bar[XB_TMO])) break; if (sp > XB_SPIN_CAP) { atomicAdd(&bar[XB_TMO], 1u); break; } }
    }
    nloc = mine > 0u ? mine : 1u; nx = cnt > 0u ? cnt : 1u;
}
__device__ __forceinline__ void xcd_barrier(const XcdBarrier& b) {
    asm volatile("s_waitcnt vmcnt(0)" ::: "memory");
    __syncthreads();
    if (threadIdx.x == 0) {
        unsigned* bar = b.bar;
        __builtin_amdgcn_s_waitcnt(0);
        unsigned nloc = b.st[0], nx = b.st[1];
        if (nloc == 0u) { xcd_barrier_complete(bar, b.x, nloc, nx); b.st[0] = nloc; b.st[1] = nx; }
        const unsigned old = xb_add(&bar[XB_XSUB(b.x)], 1u);
        const unsigned gen = old / nloc;
        if (old + 1u == (gen + 1u) * nloc) {
            __builtin_amdgcn_fence(__ATOMIC_RELEASE, "agent");
            asm volatile("s_waitcnt vmcnt(0)" ::: "memory");
            const unsigned og = xb_add(&bar[XB_TOP], 1u);
            const unsigned tg = og / nx;
            if (og + 1u == (tg + 1u) * nx) xb_add(&bar[XB_TOPGEN], 1u);
            else XB_SPIN(xb_ld(&bar[XB_TOPGEN]) == tg, bar);
            __builtin_amdgcn_fence(__ATOMIC_ACQUIRE, "agent");
            xb_add(&bar[XB_XGEN(b.x)], 1u);
            asm volatile("s_waitcnt vmcnt(0)" ::: "memory");
        } else {
            XB_SPIN(xb_ld(&bar[XB_XGEN(b.x)]) == gen, bar);
            __builtin_amdgcn_fence(__ATOMIC_ACQUIRE, "agent");
            asm volatile("s_waitcnt vmcnt(0)" ::: "memory");
        }
    }
    __syncthreads();
}

__device__ __forceinline__ float wave_sum(float v) {
#pragma unroll
    for (int o = 1; o < 64; o <<= 1) v += __shfl_xor(v, o);
    return v;
}
__device__ __forceinline__ float wave_max(float v) {
#pragma unroll
    for (int o = 1; o < 64; o <<= 1) v = fmaxf(v, __shfl_xor(v, o));
    return v;
}
__device__ __forceinline__ void transpose_item(const float* W, int K, int N, bf16* WT, int mode, LAS float* scr, int item, int lane) {
    const int nblk = N / 32, kb = item / nblk, nb = item % nblk, k0 = 64 * kb, n0 = 32 * nb;
    const int rbase = (mode == 0) ? n0 : (256 * (n0 >> 7) + (n0 & 127) + (mode == 2 ? 128 : 0));
#pragma unroll 8
    for (int i = 0; i < 32; ++i) { const int kk = 2 * i + (lane >> 5); scr[kk * 33 + (lane & 31)] = W[(size_t)(k0 + kk) * N + n0 + (lane & 31)]; }
    LDS_WAIT(); asm volatile("" ::: "memory");
    const int c = lane & 7;
#pragma unroll
    for (int j = 0; j < 4; ++j) { const int n = (lane >> 3) + 8 * j; const LAS float* s = scr + (8 * c) * 33 + n;
        v4u o; o.x = pk2(s[0 * 33], s[1 * 33]); o.y = pk2(s[2 * 33], s[3 * 33]); o.z = pk2(s[4 * 33], s[5 * 33]); o.w = pk2(s[6 * 33], s[7 * 33]);
        *(GAS v4u*)(WT + (size_t)(rbase + n) * K + k0 + 8 * c) = o; }
    LDS_WAIT(); asm volatile("" ::: "memory");
}
__device__ __forceinline__ void rms_row_to_bf16(const float* xrow, const float* gain, bf16* orow, int lane) {
    const GAS f32x4* xr = (const GAS f32x4*)xrow + lane; const GAS f32x4* gr = (const GAS f32x4*)gain + lane;
    f32x4 v[16]; float ss = 0.f;
#pragma unroll
    for (int j = 0; j < 16; ++j) { v[j] = xr[64 * j]; ss += (v[j].x * v[j].x + v[j].y * v[j].y) + (v[j].z * v[j].z + v[j].w * v[j].w); }
    const float rs = 1.0f / sqrtf(wave_sum(ss) * (1.0f / DM) + EPS);
    GAS v2u* o8 = (GAS v2u*)orow + lane;
#pragma unroll
    for (int j = 0; j < 16; ++j) { const f32x4 g = gr[64 * j]; v2u w; w.x = pk2(v[j].x * rs * g.x, v[j].y * rs * g.y); w.y = pk2(v[j].z * rs * g.z, v[j].w * rs * g.w); o8[64 * j] = w; }
}
__device__ __forceinline__ void norm_res_row(const float* ffrow, const float* baserow, float* hrow, float w, const float* gpost, const float* g2, bf16* urow, int lane) {
    const GAS f32x4* fr = (const GAS f32x4*)ffrow + lane; const GAS f32x4* br = (const GAS f32x4*)baserow + lane; const GAS f32x4* gp = (const GAS f32x4*)gpost + lane;
    f32x4 v[16]; float ss = 0.f;
#pragma unroll
    for (int j = 0; j < 16; ++j) { v[j] = fr[64 * j]; ss += (v[j].x * v[j].x + v[j].y * v[j].y) + (v[j].z * v[j].z + v[j].w * v[j].w); }
    const float rs = w / sqrtf(wave_sum(ss) * (1.0f / DM) + EPS);
    GAS f32x4* ho = (GAS f32x4*)hrow + lane; float s2 = 0.f;
#pragma unroll
    for (int j = 0; j < 16; ++j) { const f32x4 g = gp[64 * j]; const f32x4 b = br[64 * j]; v[j] = b + v[j] * rs * g; ho[64 * j] = v[j];
        s2 += (v[j].x * v[j].x + v[j].y * v[j].y) + (v[j].z * v[j].z + v[j].w * v[j].w); }
    if (urow) {
        const float r2 = 1.0f / sqrtf(wave_sum(s2) * (1.0f / DM) + EPS);
        const GAS f32x4* gq = (const GAS f32x4*)g2 + lane; GAS v2u* o8 = (GAS v2u*)urow + lane;
#pragma unroll
        for (int j = 0; j < 16; ++j) { const f32x4 g = gq[64 * j]; v2u o; o.x = pk2(v[j].x * r2 * g.x, v[j].y * r2 * g.y); o.y = pk2(v[j].z * r2 * g.z, v[j].w * r2 * g.w); o8[64 * j] = o; }
    }
}

__device__ __forceinline__ void hgrn_scan_unit(LAS unsigned char* lds, const bf16* proj, float* obuf, int b, int h, int dir, int tid) {
    LAS float* Fs = (LAS float*)lds; LAS float* Ks = Fs + 4096; LAS float* Qs = Ks + 4096; LAS float* Vs = Qs + 4096; LAS float* Ps = Vs + 4096;
    const int v = tid & 127, kg = tid >> 7;
    float S[32];
#pragma unroll
    for (int i = 0; i < 32; ++i) S[i] = 0.f;
    const size_t rowbase = (size_t)b * SEQ;
    for (int c = 0; c < SEQ / 32; ++c) {
        for (int e = tid; e < 32 * 128; e += 512) { const int il = e >> 7, k = e & 127; const int i = 32 * c + il; const int t = dir ? (SEQ - 1 - i) : i;
            const bf16* pr = proj + (rowbase + t) * (size_t)PROJ_W + h * HD + k;
            const float q = bf2f(pr[C_Q]); const float g = h2f(pr[dir ? C_GB : C_GF]); const float vv = bf2f(pr[C_I]);
            const float kk = -expm1f(g);
            Fs[e] = 1.0f - kk; Ks[e] = kk; Qs[e] = q; Vs[e] = vv; }
        __syncthreads();
        for (int il = 0; il < 32; ++il) {
            const float vv = Vs[il * 128 + v]; float p = 0.f;
#pragma unroll
            for (int k4 = 0; k4 < 8; ++k4) {
                const f32x4 f4 = *(const LAS f32x4*)&Fs[il * 128 + kg * 32 + 4 * k4], k4v = *(const LAS f32x4*)&Ks[il * 128 + kg * 32 + 4 * k4], q4 = *(const LAS f32x4*)&Qs[il * 128 + kg * 32 + 4 * k4];
#pragma unroll
                for (int e = 0; e < 4; ++e) { S[4 * k4 + e] = f4[e] * S[4 * k4 + e] + k4v[e] * vv; p += S[4 * k4 + e] * q4[e]; }
            }
            Ps[(kg * 32 + il) * 128 + v] = p;
        }
        __syncthreads();
        for (int e = tid; e < 32 * 128; e += 512) { const int il = e >> 7, vv = e & 127; const int i = 32 * c + il; const int t = dir ? (SEQ - 1 - i) : i;
            obuf[(rowbase + t) * (size_t)HGW + h * HD + vv] = (Ps[e] + Ps[4096 + e]) + (Ps[8192 + e] + Ps[12288 + e]); }
    }
    __syncthreads();
}

__device__ __forceinline__ void na_unit(LAS unsigned char* lds, const bf16* proj, const bf16* vt, const float* rpb, bf16* mix, int b, int h, int r, int wave, int lane) {
    LAS float* pl = (LAS float*)(lds + wave * 512);
    const int rs = min(max(r - WIN_R / 2, 0), NROWS - WIN_R);
    const float* rp = rpb + h * (15 * 31);
    for (int ci = 0; ci < 8; ++ci) {
        const int c = wave * 8 + ci; const int cs = min(max(c - WIN_C / 2, 0), GRID_W - WIN_C);
        const bf16* qrow = proj + ((size_t)b * SEQ + r * GRID_W + c) * PROJ_W + C_NQ + h * HD;
        float s[2];
#pragma unroll
        for (int jj = 0; jj < 2; ++jj) { const int j = lane + 64 * jj; const int kr = rs + (j >> 4), kc = cs + (j & 15);
            const bf16* krow = proj + ((size_t)b * SEQ + kr * GRID_W + kc) * PROJ_W + C_NK + h * HD;
            float a = 0.f;
#pragma unroll
            for (int d8 = 0; d8 < 16; ++d8) { const v4u kv = *(const GAS v4u*)(krow + 8 * d8), qv = *(const GAS v4u*)(qrow + 8 * d8);
                a += bflo(kv.x) * bflo(qv.x) + bfhi(kv.x) * bfhi(qv.x) + bflo(kv.y) * bflo(qv.y) + bfhi(kv.y) * bfhi(qv.y)
                   + bflo(kv.z) * bflo(qv.z) + bfhi(kv.z) * bfhi(qv.z) + bflo(kv.w) * bflo(qv.w) + bfhi(kv.w) * bfhi(qv.w); }
            s[jj] = a + rp[(kr - r + WIN_R - 1) * 31 + (kc - c + WIN_C - 1)]; }
        const float m = wave_max(fmaxf(s[0], s[1]));
        const float e0 = __expf(s[0] - m), e1 = __expf(s[1] - m);
        const float inv = 1.0f / wave_sum(e0 + e1);
        pl[lane] = e0 * inv; pl[64 + lane] = e1 * inv;
        LDS_WAIT(); asm volatile("" ::: "memory");
        float o[2];
#pragma unroll
        for (int dd = 0; dd < 2; ++dd) { const int d = lane + 64 * dd; const bf16* vrow = vt + (size_t)(h * HD + d) * MROWS + (size_t)b * SEQ;
            float a = 0.f;
            for (int wr = 0; wr < WIN_R; ++wr) { const bf16* vp = vrow + (rs + wr) * GRID_W + cs;
#pragma unroll
                for (int wc = 0; wc < WIN_C; ++wc) a += pl[wr * 16 + wc] * bf2f(vp[wc]); }
            o[dd] = a; }
        bf16* orow = mix + ((size_t)b * SEQ + r * GRID_W + c) * DM + HGW + h * HD;
        orow[lane] = (bf16)f2bf(o[0]); orow[64 + lane] = (bf16)f2bf(o[1]);
        LDS_WAIT(); asm volatile("" ::: "memory");
    }
}

__device__ __forceinline__ void hgrn_combine_row(const float* of, const float* ob, const bf16* gaterow, const float* hn, bf16* orow, int lane) {
    const GAS f32x4* a = (const GAS f32x4*)of + lane; const GAS f32x4* bq = (const GAS f32x4*)ob + lane; const GAS v2u* gr = (const GAS v2u*)gaterow + lane;
    const f32x4 hg = *((const GAS f32x4*)hn + (lane & 31));
    GAS v2u* o8 = (GAS v2u*)orow + lane;
#pragma unroll
    for (int j = 0; j < 8; ++j) {
        f32x4 v = a[64 * j] + bq[64 * j];
        float ss = (v.x * v.x + v.y * v.y) + (v.z * v.z + v.w * v.w);
#pragma unroll
        for (int o = 1; o < 32; o <<= 1) ss += __shfl_xor(ss, o);
        const float rs = 1.0f / sqrtf(ss * (1.0f / HD) + EPS);
        const v2u g = gr[64 * j];
        v2u w; w.x = pk2(v.x * rs * hg.x * bflo(g.x), v.y * rs * hg.y * bfhi(g.x)); w.y = pk2(v.z * rs * hg.z * bflo(g.y), v.w * rs * hg.w * bfhi(g.y));
        o8[64 * j] = w;
    }
}

struct Args { const float* in[18]; float* out; unsigned char* ws; int ph_lo, ph_hi; };
__global__ void __launch_bounds__(NWAVES * 64, 2) fwd_kernel(Args args) {
    extern __shared__ __attribute__((aligned(16))) unsigned char lds_raw[];
    LAS unsigned char* lds = (LAS unsigned char*)lds_raw;
    volatile LAS unsigned* MISC = (volatile LAS unsigned*)(lds + MISC_OFF);
    const int G = gridDim.x, bx = blockIdx.x;
    const int vcu = (G % 8 == 0) ? (bx % 8) * (G / 8) + bx / 8 : bx;
    gu32* ctl = (gu32*)(args.ws + WS_CTL);
    for (int u = threadIdx.x; u < (LDS_BYTES - LDSCTL_OFF) / 4; u += NWAVES * 64) ((LAS unsigned*)(lds + LDSCTL_OFF))[u] = 0u;
    __syncthreads();
    XcdBarrier bar; bar.bar = (unsigned*)(args.ws + WS_CTL) + CW_BAR; bar.x = 0; bar.st = nullptr;
#if !MK_PER_PHASE
    bar = xcd_barrier_post((unsigned*)(args.ws + WS_CTL) + CW_BAR, MISC + 8);
#endif
    const int lo = args.ph_lo, hi = args.ph_hi;
#define IN(k) (lo <= (k) && (k) < hi)
#define BOTH(k) (IN(k) && IN((k) + 1))
#if MK_PER_PHASE
#define GRID_BAR() do { if (threadIdx.x == 0) __hip_atomic_store(ctl + CW_TMO, 0xBADBA0u, RLX_AGENT); } while (0)
#else
#define GRID_BAR() xcd_barrier(bar)
#endif
#define WGU1 ((bf16*)(args.ws + WS_WGU1))
#define WGU2 ((bf16*)(args.ws + WS_WGU2))
#define WD1 ((bf16*)(args.ws + WS_WD1))
#define WD2 ((bf16*)(args.ws + WS_WD2))
#define WIN ((bf16*)(args.ws + WS_WIN))
#define WOUT ((bf16*)(args.ws + WS_WOUT))
#define R1 ((bf16*)(args.ws + WS_R1))
#define VT ((bf16*)(args.ws + WS_VT))
#define R2 ((float*)(args.ws + WS_R2))
#define R3 ((bf16*)(args.ws + WS_R3))
#define LB ((float*)(args.ws + WS_LB))
#define PHASE_IDS() int tid = threadIdx.x; asm volatile("" : "+v"(tid)); const int lane = tid & 63, wave = __builtin_amdgcn_readfirstlane(tid >> 6); \
    const int gw = vcu * NWAVES + wave, NGW = G * NWAVES; (void)lane; (void)gw; (void)NGW
#define PHASE_GATEUP(k, W) if (IN(k)) { \
        pg8::Gemm g{R3, (W), MROWS, 2 * FF, DM}; pg8::StaticOrder S; S.init(MROWS, 2 * FF, G, bx); \
        pg8::EpiSwiGLU E{R1, FF}; \
        pg8::gemm_phase<pg8::EpiSwiGLU, pg8::StaticOrder, true, true>(lds + RING_OFF, g, S, E); \
        if (BOTH(k)) GRID_BAR(); }
#define PHASE_DOWN(k, W) if (IN(k)) { \
        pg8::Gemm g{R1, (W), MROWS, DM, FF}; pg8::StaticOrder S; S.init(MROWS, DM, G, bx); \
        pg8::EpiF32 E{R2, DM}; \
        pg8::gemm_phase<pg8::EpiF32, pg8::StaticOrder, true, true>(lds + RING_OFF, g, S, E); \
        if (BOTH(k)) GRID_BAR(); }
#define PHASE_NORM(k, BASE, WGT, GPOST, G2, HASU) if (IN(k)) { PHASE_IDS(); \
        for (int m = gw; m < MROWS; m += NGW) \
            norm_res_row(R2 + (size_t)m * DM, (BASE) + (size_t)m * DM, args.out + (size_t)m * DM, (WGT), (GPOST), (G2), (HASU) ? R3 + (size_t)m * DM : (bf16*)nullptr, lane); \
        if (BOTH(k)) GRID_BAR(); }

    if (IN(0)) { PHASE_IDS();
        LAS float* scr = (LAS float*)(lds + RING_OFF + wave * 16384);
        constexpr int I_GU = (DM / 64) * (FF / 32), I_D = (FF / 64) * (DM / 32), I_IN = (DM / 64) * (16384 / 32), I_OUT = (DM / 64) * (DM / 32);
        constexpr int NITEMS = 6 * I_GU + I_IN + I_OUT;
        static_assert(I_GU == I_D, "items");
        for (int it = gw; it < NITEMS; it += NGW) {
            int r = it; const float* W; bf16* WT; int K = DM, N = FF, mode = 0;
            if (r < I_GU) { W = args.in[2]; WT = WGU1; mode = 1; }
            else if ((r -= I_GU) < I_GU) { W = args.in[3]; WT = WGU1; mode = 2; }
            else if ((r -= I_GU) < I_D) { W = args.in[4]; WT = WD1; K = FF; N = DM; }
            else if ((r -= I_D) < I_IN) { W = args.in[7]; WT = WIN; N = 16384; }
            else if ((r -= I_IN) < I_OUT) { W = args.in[11]; WT = WOUT; N = DM; }
            else if ((r -= I_OUT) < I_GU) { W = args.in[14]; WT = WGU2; mode = 1; }
            else if ((r -= I_GU) < I_GU) { W = args.in[15]; WT = WGU2; mode = 2; }
            else { r -= I_GU; W = args.in[16]; WT = WD2; K = FF; N = DM; }
            transpose_item(W, K, N, WT, mode, scr, r, lane);
        }
        for (int m = gw; m < MROWS; m += NGW) rms_row_to_bf16(args.in[0] + (size_t)m * DM, args.in[1], R3 + (size_t)m * DM, lane);
        for (int i = bx * 512 + tid; i < 2 * HGW; i += G * 512) { const float l0 = args.in[8][i], l1 = args.in[8][2 * HGW + i]; LB[i] = 1.0f / (1.0f + expf(l1 - l0)); }
        if (BOTH(0)) GRID_BAR();
    }
    PHASE_GATEUP(1, WGU1)
    PHASE_DOWN(2, WD1)
    PHASE_NORM(3, args.in[0], 0.5f, args.in[5], args.in[6], true)
    if (IN(4)) {
        { pg8::Gemm g{R3, WIN, MROWS, PROJ_W, DM}; pg8::StaticOrder S; S.init(MROWS, PROJ_W, G, bx);
          pg8::EpiProj E{R1, PROJ_W, LB};
          pg8::gemm_phase<pg8::EpiProj, pg8::StaticOrder, true, true>(lds + RING_OFF, g, S, E); }
        { pg8::Gemm g{WIN + (size_t)PROJ_W * DM, R3, NAW, MROWS, DM}; pg8::StaticOrder S; S.init(NAW, MROWS, G, bx);
          pg8::EpiBf16Plain E{VT, MROWS};
          pg8::gemm_phase<pg8::EpiBf16Plain, pg8::StaticOrder, true, true>(lds + RING_OFF, g, S, E); }
        if (BOTH(4)) GRID_BAR();
    }
    if (IN(5)) { PHASE_IDS();
        if (bx < 2 * BATCH * NHEAD) { const int dir = bx & 1, h = (bx >> 1) & 15, b = bx >> 5;
            hgrn_scan_unit(lds + RING_OFF, R1, R2 + (size_t)dir * MROWS * HGW, b, h, dir, tid); }
        for (;;) {
            if (tid == 0) MISC[16] = __hip_atomic_fetch_add(ctl + CW_QUEUE, 1u, RLX_AGENT);
            __syncthreads();
            const int wu = (int)MISC[16];
            __syncthreads();
            if (wu >= BATCH * NHEAD * NROWS) break;
            const int r = wu & 63, h = (wu >> 6) & 15, b = wu >> 10;
            na_unit(lds + RING_OFF, R1, VT, args.in[10], R3, b, h, r, wave, lane);
        }
        if (BOTH(5)) GRID_BAR();
    }
    if (IN(6)) { PHASE_IDS();
        for (int m = gw; m < MROWS; m += NGW)
            hgrn_combine_row(R2 + (size_t)m * HGW, R2 + (size_t)MROWS * HGW + (size_t)m * HGW, R1 + (size_t)m * PROJ_W + C_GATE, args.in[9], R3 + (size_t)m * DM, lane);
        if (BOTH(6)) GRID_BAR();
    }
    if (IN(7)) {
        pg8::Gemm g{R3, WOUT, MROWS, DM, DM}; pg8::StaticOrder S; S.init(MROWS, DM, G, bx);
        pg8::EpiF32 E{R2, DM};
        pg8::gemm_phase<pg8::EpiF32, pg8::StaticOrder, true, true>(lds + RING_OFF, g, S, E);
        if (BOTH(7)) GRID_BAR();
    }
    PHASE_NORM(8, args.out, 1.0f, args.in[12], args.in[13], true)
    PHASE_GATEUP(9, WGU2)
    PHASE_DOWN(10, WD2)
    PHASE_NORM(11, args.out, 0.5f, args.in[17], args.in[17], false)
#if !MK_PER_PHASE
    if (IN(11)) { if (xb_ld((unsigned*)(args.ws + WS_CTL) + CW_BAR + XB_TMO) != 0u) { const float q = __builtin_nanf(""); for (int m = bx; m < MROWS; m += G) for (int c = threadIdx.x; c < DM; c += 512) args.out[(size_t)m * DM + c] = q; } }
#endif
#undef IN
#undef BOTH
}

extern "C" void kernel_launch(void* const* d_in, const int* in_sizes, int n_in, void* d_out, int out_size, void* d_ws, size_t ws_size, hipStream_t stream) {
    static int grid = 0;
    if (grid == 0) {
        if (n_in != 18 || in_sizes[0] != MROWS * DM || out_size != MROWS * DM || ws_size < WS_END) {
            fprintf(stderr, "kernel_launch: unexpected shapes (n_in %d, in0 %d, out %d, ws %zu need %zu); nothing launched\n", n_in, n_in > 0 ? in_sizes[0] : -1, out_size, ws_size, (size_t)WS_END); grid = -1; return; }
        int dev = 0, cus = 0;
        if (hipGetDevice(&dev) != hipSuccess || hipDeviceGetAttribute(&cus, hipDeviceAttributeMultiprocessorCount, dev) != hipSuccess) { grid = -1; return; }
        if (hipFuncSetAttribute((const void*)fwd_kernel, hipFuncAttributeMaxDynamicSharedMemorySize, LDS_BYTES) != hipSuccess) { fprintf(stderr, "kernel_launch: hipFuncSetAttribute failed\n"); grid = -1; return; }
        int per_cu = 0;
        if (hipOccupancyMaxActiveBlocksPerMultiprocessor(&per_cu, (const void*)fwd_kernel, NWAVES * 64, LDS_BYTES) != hipSuccess || per_cu < 1)
            fprintf(stderr, "kernel_launch: note: occupancy query reports %d workgroups per CU\n", per_cu);
        (void)hipGetLastError();
        grid = cus;
    }
    if (grid < 0) return;
    if (hipMemsetAsync((char*)d_ws + WS_CTL, 0, CTL_ZERO_BYTES, stream) != hipSuccess) { fprintf(stderr, "kernel_launch: memset failed\n"); return; }
    Args a{};
    for (int i = 0; i < 18; ++i) a.in[i] = (const float*)d_in[i];
    a.out = (float*)d_out; a.ws = (unsigned char*)d_ws;
#if MK_PER_PHASE
    for (int p = 0; p < N_PHASES; ++p) { a.ph_lo = p; a.ph_hi = p + 1; hipLaunchKernelGGL(fwd_kernel, dim3(grid), dim3(NWAVES * 64), LDS_BYTES, stream, a); }
#else
    a.ph_lo = 0; a.ph_hi = N_PHASES;
    hipLaunchKernelGGL(fwd_kernel, dim3(grid), dim3(NWAVES * 64), LDS_BYTES, stream, a);
#endif
    const hipError_t le = hipPeekAtLastError();
    if (le != hipSuccess) fprintf(stderr, "kernel_launch: launch failed: %s\n", hipGetErrorName(le));
}
```

```cpp
#include <hip/hip_runtime.h>
#include <cstdio>
#include <cstdint>

#ifndef MK_PER_PHASE
#define MK_PER_PHASE 0
#endif

namespace pg8 {
#define PG8_LAS __attribute__((address_space(3)))
typedef unsigned short bf16_t;
typedef short bf16x8 __attribute__((ext_vector_type(8)));
typedef float f32x4 __attribute__((ext_vector_type(4)));
typedef unsigned u32x4 __attribute__((ext_vector_type(4)));
constexpr int BM = 256, BK = 64, HALF = 128, HTB = HALF * BK * 2  , STAGE_BYTES = 8 * HTB, NXCD = 8, WGM = 8;

__host__ __device__ __forceinline__ int lds_byte(int r, int c) { const int st = (r >> 4) * 2 + (c >> 5), rr = r & 15, cc = c & 31, ob = rr * 64 + cc * 2; return st * 1024 + (ob ^ (((ob >> 9) & 1) << 5)); }
__host__ __device__ __forceinline__ void stage_rc(int b, int& R, int& C) { const int st = b / 1024, sb = b % 1024, swz = sb ^ (((sb >> 9) & 1) << 5); R = (st >> 1) * 16 + swz / 64; C = (st & 1) * 32 + (swz % 64) / 2; }
__host__ __device__ __forceinline__ int perm32(int rho) { const int n = rho >> 4, i = rho & 15; return 8 * (i >> 2) + 4 * n + (i & 3); }

struct Unit { int pm, pn; };
struct Gemm { const bf16_t* A; const bf16_t* Bt; int M, N, K; };

struct StaticOrder {
    int nM, nN, nwg, G, c;
    __host__ __device__ void init(int M, int N, int G_, int c_) { nM = M / BM; nN = N / BM; nwg = nM * nN; G = G_; c = c_; }
    __host__ __device__ bool next(int i, Unit& u) const {
        const long L = (long)i * G + c; if (L >= nwg) return false;
        int wgid = (int)L; { const int q = nwg / NXCD, r = nwg % NXCD, xcd = wgid % NXCD, off = wgid / NXCD; wgid = (xcd < r ? xcd * (q + 1) : r * (q + 1) + (xcd - r) * q) + off; }
        const int nig = WGM * nN, gid = wgid / nig, fm = gid * WGM, gsz = (nM - fm) < WGM ? (nM - fm) : WGM;
        u.pm = fm + ((wgid % nig) % gsz); u.pn = (wgid % nig) / gsz; return true;
    }
    __device__ __forceinline__ void a_ready(const Unit&) const {}
    __device__ __forceinline__ void done(const Unit&) const {}
};

__device__ __forceinline__ unsigned cvt_pk_bf16(float lo, float hi) { unsigned r; asm volatile("v_cvt_pk_bf16_f32 %0, %1, %2" : "=v"(r) : "v"(lo), "v"(hi)); return r; }
__device__ __forceinline__ unsigned cvt_pk_f16(float lo, float hi) { typedef _Float16 h2 __attribute__((ext_vector_type(2))); h2 v; v.x = (_Float16)lo; v.y = (_Float16)hi; return __builtin_bit_cast(unsigned, v); }
__device__ __forceinline__ float sigmoidf_fast(float v) { return __builtin_amdgcn_rcpf(1.0f + __builtin_amdgcn_exp2f(-1.4426950408889634f * v)); }

struct EpiF32 {
    static constexpr bool PERM = false, AFTER_DRAIN = false;
    float* C; int ldc;
    __device__ __forceinline__ void operator()(const f32x4 (&acc)[2][2][4][2], const Unit& u, int wr, int wc, int fr, int fq) const {
        const int row0 = u.pm * BM + wr * 64 + fr, col0 = u.pn * BM + wc * 32 + 4 * fq;
#pragma unroll
        for (int ai = 0; ai < 2; ++ai)
#pragma unroll
            for (int m = 0; m < 4; ++m) { float* rowp = C + (size_t)(row0 + ai * HALF + m * 16) * ldc + col0;
#pragma unroll
                for (int bj = 0; bj < 2; ++bj)
#pragma unroll
                    for (int n = 0; n < 2; ++n) *(f32x4*)(rowp + bj * HALF + n * 16) = acc[ai][bj][m][n]; }
    }
};
struct EpiBf16Plain {
    static constexpr bool PERM = true, AFTER_DRAIN = false;
    bf16_t* O; int ldc;
    __device__ __forceinline__ void operator()(const f32x4 (&acc)[2][2][4][2], const Unit& u, int wr, int wc, int fr, int fq) const {
        const int row0 = u.pm * BM + wr * 64 + fr, col0 = u.pn * BM + wc * 32 + 8 * fq;
#pragma unroll
        for (int ai = 0; ai < 2; ++ai)
#pragma unroll
            for (int m = 0; m < 4; ++m) { bf16_t* rowp = O + (size_t)(row0 + ai * HALF + m * 16) * ldc + col0;
#pragma unroll
                for (int bj = 0; bj < 2; ++bj) { const f32x4 v0 = acc[ai][bj][m][0], v1 = acc[ai][bj][m][1];
                    u32x4 w; w.x = cvt_pk_bf16(v0[0], v0[1]); w.y = cvt_pk_bf16(v0[2], v0[3]); w.z = cvt_pk_bf16(v1[0], v1[1]); w.w = cvt_pk_bf16(v1[2], v1[3]);
                    *(u32x4*)(rowp + bj * HALF) = w; } }
    }
};
struct EpiSwiGLU {
    static constexpr bool PERM = true, AFTER_DRAIN = false;
    bf16_t* H; int ldc;
    __device__ __forceinline__ void operator()(const f32x4 (&acc)[2][2][4][2], const Unit& u, int wr, int wc, int fr, int fq) const {
        const int row0 = u.pm * BM + wr * 64 + fr, col0 = u.pn * HALF + wc * 32 + 8 * fq;
#pragma unroll
        for (int ai = 0; ai < 2; ++ai)
#pragma unroll
            for (int m = 0; m < 4; ++m) { bf16_t* rowp = H + (size_t)(row0 + ai * HALF + m * 16) * ldc + col0;
                float h[8];
#pragma unroll
                for (int n = 0; n < 2; ++n)
#pragma unroll
                    for (int e = 0; e < 4; ++e) { const float g = acc[ai][0][m][n][e], up = acc[ai][1][m][n][e]; h[4 * n + e] = g * sigmoidf_fast(g) * up; }
                u32x4 w; w.x = cvt_pk_bf16(h[0], h[1]); w.y = cvt_pk_bf16(h[2], h[3]); w.z = cvt_pk_bf16(h[4], h[5]); w.w = cvt_pk_bf16(h[6], h[7]);
                *(u32x4*)rowp = w; }
    }
};
struct EpiProj {
    static constexpr bool PERM = true, AFTER_DRAIN = false;
    bf16_t* P; int ldc; const float* lb;
    __device__ __forceinline__ void operator()(const f32x4 (&acc)[2][2][4][2], const Unit& u, int wr, int wc, int fr, int fq) const {
        const int sec = u.pn >> 3;
        const int row0 = u.pm * BM + wr * 64 + fr, col0 = u.pn * BM + wc * 32 + 8 * fq;
        const bool isg = (sec == 1 || sec == 2), act = (sec == 0 || sec == 4); const float sc = (sec == 5) ? 0.08838834764831845f : 1.0f;
        const float* lbp = lb + (isg ? (col0 - 2048) : 0);
#pragma unroll
        for (int ai = 0; ai < 2; ++ai)
#pragma unroll
            for (int m = 0; m < 4; ++m) { bf16_t* rowp = P + (size_t)(row0 + ai * HALF + m * 16) * ldc + col0;
#pragma unroll
                for (int bj = 0; bj < 2; ++bj) { float g[8]; u32x4 w;
                    if (isg) {
                        const f32x4 la = *(const f32x4*)(lbp + bj * HALF), lc = *(const f32x4*)(lbp + bj * HALF + 4);
#pragma unroll
                        for (int e = 0; e < 4; ++e) { const float f0 = la[e] + (1.0f - la[e]) * sigmoidf_fast(acc[ai][bj][m][0][e]), f1 = lc[e] + (1.0f - lc[e]) * sigmoidf_fast(acc[ai][bj][m][1][e]);
                            g[e] = __builtin_amdgcn_logf(f0) * 0.6931471805599453f; g[4 + e] = __builtin_amdgcn_logf(f1) * 0.6931471805599453f; }
                        w.x = cvt_pk_f16(g[0], g[1]); w.y = cvt_pk_f16(g[2], g[3]); w.z = cvt_pk_f16(g[4], g[5]); w.w = cvt_pk_f16(g[6], g[7]);
                    } else {
#pragma unroll
                        for (int n = 0; n < 2; ++n)
#pragma unroll
                            for (int e = 0; e < 4; ++e) { const float v = acc[ai][bj][m][n][e]; g[4 * n + e] = act ? v * sigmoidf_fast(v) : v * sc; }
                        w.x = cvt_pk_bf16(g[0], g[1]); w.y = cvt_pk_bf16(g[2], g[3]); w.z = cvt_pk_bf16(g[4], g[5]); w.w = cvt_pk_bf16(g[6], g[7]);
                    }
                    *(u32x4*)(rowp + bj * HALF) = w; }
                asm volatile("" ::: "memory"); }
    }
};

template <class Epi, class Sched, bool ALIGN_EPI = false, bool SP2 = false>
__device__ __forceinline__ void gemm_phase(PG8_LAS unsigned char* lds, const Gemm g, const Sched& S, const Epi& E) {
    int tid_ = threadIdx.x; asm volatile("" : "+v"(tid_));
    const int tid = tid_, wid = __builtin_amdgcn_readfirstlane(tid >> 6), lane = tid & 63, wr = wid >> 2, wc = wid & 3, fr = lane & 15, fq = lane >> 4;
    const int K = g.K, nt = K / BK;
    unsigned voffA[2], voffB[2];
#pragma unroll
    for (int i = 0; i < 2; ++i) { int R, C; stage_rc(tid * 16 + i * 8192, R, C); const int Rb = Epi::PERM ? ((R & ~31) + perm32(R & 31)) : R;
        voffA[i] = (unsigned)(R * K + C) * 2u; voffB[i] = (unsigned)(Rb * K + C) * 2u; }
    const size_t kstep = (size_t)(BK * 2);
    const size_t hstep = (size_t)HALF * K * 2;
    const size_t tstep = 2 * hstep;
    const unsigned ldsw = (unsigned)wid * 1024u;
    const int aoff = lds_byte(wr * 64 + fr, fq * 8), boff = lds_byte(wc * 32 + fr, fq * 8);
#define PG8_SA(b, h) (((b) * 2 + (h)) * HTB)
#define PG8_SB(b, h) ((4 + (b) * 2 + (h)) * HTB)
#define PG8_STAGE(bufoff, gbase, voff) do { _Pragma("unroll") for (int _i = 0; _i < 2; ++_i) \
        __builtin_amdgcn_global_load_lds((const unsigned*)((const char*)(gbase) + (voff)[_i]), (PG8_LAS unsigned*)(lds + (bufoff) + ldsw + _i * 8192), 16, 0, 0); } while (0)
#define PG8_LDA(dst, b, h) do { _Pragma("unroll") for (int m = 0; m < 4; ++m) _Pragma("unroll") for (int k = 0; k < 2; ++k) dst[m][k] = *(const PG8_LAS bf16x8*)(lds + PG8_SA(b, h) + aoff + m * 2048 + k * 1024); } while (0)
#define PG8_LDB(dst, b, h) do { _Pragma("unroll") for (int n = 0; n < 2; ++n) _Pragma("unroll") for (int k = 0; k < 2; ++k) dst[n][k] = *(const PG8_LAS bf16x8*)(lds + PG8_SB(b, h) + boff + n * 2048 + k * 1024); } while (0)
#define PG8_MMA(ai, bj, At, Bt) do { __builtin_amdgcn_s_setprio(1); _Pragma("unroll") for (int m = 0; m < 4; ++m) _Pragma("unroll") for (int n = 0; n < 2; ++n) _Pragma("unroll") for (int k = 0; k < 2; ++k) \
        acc[ai][bj][m][n] = __builtin_amdgcn_mfma_f32_16x16x32_bf16(Bt[n][k], At[m][k], acc[ai][bj][m][n], 0, 0, 0); __builtin_amdgcn_s_setprio(0); } while (0)
#define PG8_WAIT_V(n) asm volatile("s_waitcnt vmcnt(" #n ")" ::: "memory")
#define PG8_WAIT_L(n) asm volatile("s_waitcnt lgkmcnt(" #n ")" ::: "memory")
#define PG8_BAR __builtin_amdgcn_s_barrier()
#define PG8_SCHED __builtin_amdgcn_sched_barrier(0)
    Unit cur, nxt; int ui = 0;
    if (!S.next(0, cur)) return;
    f32x4 acc[2][2][4][2];
#pragma unroll
    for (int a = 0; a < 2; ++a)
#pragma unroll
        for (int b = 0; b < 2; ++b)
#pragma unroll
            for (int m = 0; m < 4; ++m)
#pragma unroll
                for (int n = 0; n < 2; ++n) acc[a][b][m][n] = (f32x4){0.f, 0.f, 0.f, 0.f};
    bf16x8 At[4][2], B0[2][2], B1[2][2];
    const char* cA = (const char*)g.A + (size_t)cur.pm * tstep; const char* cB = (const char*)g.Bt + (size_t)cur.pn * tstep;
    S.a_ready(cur);
    if constexpr (SP2) {
        PG8_STAGE(PG8_SB(0, 0), cB, voffB); PG8_STAGE(PG8_SB(0, 1), cB + hstep, voffB); PG8_STAGE(PG8_SA(0, 0), cA, voffA); PG8_STAGE(PG8_SA(0, 1), cA + hstep, voffA);
        if (wr == 1) PG8_BAR;
        PG8_WAIT_V(2); PG8_BAR;
        PG8_STAGE(PG8_SB(1, 0), cB + kstep, voffB); PG8_STAGE(PG8_SA(1, 0), cA + kstep, voffA); PG8_STAGE(PG8_SB(1, 1), cB + hstep + kstep, voffB);
        PG8_WAIT_V(6); PG8_BAR;
    } else {
        PG8_STAGE(PG8_SB(0, 0), cB, voffB); PG8_STAGE(PG8_SA(0, 0), cA, voffA); PG8_STAGE(PG8_SB(0, 1), cB + hstep, voffB); PG8_STAGE(PG8_SA(0, 1), cA + hstep, voffA);
        if (wr == 1) PG8_BAR;
        PG8_WAIT_V(4); PG8_BAR;
        PG8_STAGE(PG8_SB(1, 0), cB + kstep, voffB); PG8_STAGE(PG8_SA(1, 0), cA + kstep, voffA); PG8_STAGE(PG8_SB(1, 1), cB + hstep + kstep, voffB);
        PG8_WAIT_V(6); PG8_BAR;
    }
    for (;;) {
        const bool has_next = S.next(ui + 1, nxt);
        const char* nA = has_next ? (const char*)g.A + (size_t)nxt.pm * tstep : cA; const char* nB = has_next ? (const char*)g.Bt + (size_t)nxt.pn * tstep : cB;
        for (int t = 0; t < nt; t += 2) {
            const bool last = (t == nt - 2);
            const char* a1 = cA + (size_t)(t + 1) * kstep;
            const char* a2 = last ? nA : cA + (size_t)(t + 2) * kstep; const char* b2 = last ? nB : cB + (size_t)(t + 2) * kstep;
            const char* a3 = a2 + kstep; const char* b3 = b2 + kstep;
            if (last && has_next) S.a_ready(nxt);
            if constexpr (SP2) {
            PG8_LDB(B0, 0, 0); PG8_LDB(B1, 0, 1); PG8_SCHED; PG8_LDA(At, 0, 0); PG8_STAGE(PG8_SA(1, 1), a1 + hstep, voffA);
            PG8_WAIT_V(8); PG8_WAIT_L(0); PG8_BAR; PG8_MMA(0, 0, At, B0); PG8_MMA(0, 1, At, B1); PG8_BAR; PG8_SCHED;
            PG8_LDA(At, 0, 1); PG8_STAGE(PG8_SB(0, 0), b2, voffB); PG8_STAGE(PG8_SB(0, 1), b2 + hstep, voffB); PG8_STAGE(PG8_SA(0, 0), a2, voffA);
            PG8_WAIT_V(8); PG8_WAIT_L(0); PG8_BAR; PG8_MMA(1, 0, At, B0); PG8_MMA(1, 1, At, B1); PG8_BAR; PG8_SCHED;
            PG8_LDB(B0, 1, 0); PG8_LDB(B1, 1, 1); PG8_SCHED; PG8_LDA(At, 1, 0); PG8_STAGE(PG8_SA(0, 1), a2 + hstep, voffA);
            PG8_WAIT_V(8); PG8_WAIT_L(0); PG8_BAR; PG8_MMA(0, 0, At, B0); PG8_MMA(0, 1, At, B1); PG8_BAR; PG8_SCHED;
            PG8_LDA(At, 1, 1); PG8_STAGE(PG8_SB(1, 0), b3, voffB); PG8_STAGE(PG8_SB(1, 1), b3 + hstep, voffB); PG8_STAGE(PG8_SA(1, 0), a3, voffA);
            PG8_WAIT_V(8); PG8_WAIT_L(0); PG8_BAR; PG8_MMA(1, 0, At, B0); PG8_MMA(1, 1, At, B1); PG8_BAR; PG8_SCHED;
            } else {
            PG8_LDB(B0, 0, 0); PG8_SCHED; PG8_LDA(At, 0, 0); PG8_STAGE(PG8_SA(1, 1), a1 + hstep, voffA);
            PG8_WAIT_L(8); PG8_BAR; PG8_WAIT_L(0); PG8_MMA(0, 0, At, B0); PG8_BAR; PG8_SCHED;
            PG8_LDB(B1, 0, 1); PG8_STAGE(PG8_SB(0, 0), b2, voffB);
            PG8_BAR; PG8_WAIT_L(0); PG8_MMA(0, 1, At, B1); PG8_BAR;
            PG8_LDA(At, 0, 1); PG8_STAGE(PG8_SA(0, 0), a2, voffA);
            PG8_BAR; PG8_WAIT_L(0); PG8_MMA(1, 0, At, B0); PG8_BAR; PG8_SCHED;
            PG8_STAGE(PG8_SB(0, 1), b2 + hstep, voffB);
            PG8_WAIT_V(6); PG8_BAR; PG8_MMA(1, 1, At, B1); PG8_BAR;
            PG8_LDB(B0, 1, 0); PG8_SCHED; PG8_LDA(At, 1, 0); PG8_STAGE(PG8_SA(0, 1), a2 + hstep, voffA);
            PG8_WAIT_L(8); PG8_BAR; PG8_WAIT_L(0); PG8_MMA(0, 0, At, B0); PG8_BAR; PG8_SCHED;
            PG8_LDB(B1, 1, 1); PG8_STAGE(PG8_SB(1, 0), b3, voffB);
            PG8_BAR; PG8_WAIT_L(0); PG8_MMA(0, 1, At, B1); PG8_BAR;
            PG8_LDA(At, 1, 1); PG8_STAGE(PG8_SA(1, 0), a3, voffA);
            PG8_BAR; PG8_WAIT_L(0); PG8_MMA(1, 0, At, B0); PG8_BAR; PG8_SCHED;
            PG8_STAGE(PG8_SB(1, 1), b3 + hstep, voffB);
            PG8_WAIT_V(6); PG8_BAR; PG8_MMA(1, 1, At, B1); PG8_BAR;
            }
        }
        if constexpr (ALIGN_EPI) { if (wr == 0) PG8_BAR; }
        if constexpr (!Epi::AFTER_DRAIN) { E(acc, cur, wr, wc, fr, fq); S.done(cur); }
        if (!has_next) break;
#pragma unroll
        for (int a = 0; a < 2; ++a)
#pragma unroll
            for (int b = 0; b < 2; ++b)
#pragma unroll
                for (int m = 0; m < 4; ++m)
#pragma unroll
                    for (int n = 0; n < 2; ++n) acc[a][b][m][n] = (f32x4){0.f, 0.f, 0.f, 0.f};
        cur = nxt; cA = nA; cB = nB; ++ui;
        if constexpr (ALIGN_EPI) { if (wr == 1) PG8_BAR; }
    }
    PG8_WAIT_V(0);
    if constexpr (!ALIGN_EPI) { if (wr == 0) PG8_BAR; }
    PG8_BAR;
#undef PG8_SA
#undef PG8_SB
#undef PG8_STAGE
#undef PG8_LDA
#undef PG8_LDB
#undef PG8_MMA
#undef PG8_WAIT_V
#undef PG8_WAIT_L
#undef PG8_BAR
#undef PG8_SCHED
}
}

constexpr int NWAVES = 8;
constexpr int DM = 4096, BATCH = 4, SEQ = 4096, MROWS = BATCH * SEQ;
constexpr int FF = 11008, HGW = 2048, NAW = 2048, HD = 128, NHEAD = 16;
constexpr int PROJ_W = 14336;
constexpr int C_Q = 0, C_GF = 2048, C_GB = 4096, C_I = 6144, C_GATE = 8192, C_NQ = 10240, C_NK = 12288;
constexpr int GRID_W = 64, NROWS = 64, WIN_R = 8, WIN_C = 16;
constexpr float EPS = 1e-6f;
constexpr int N_PHASES = 12;

constexpr size_t MiB = 1u << 20;
constexpr size_t WS_CTL = 0, CTL_ZERO_BYTES = 1 * MiB;
constexpr size_t WS_LB = 1 * MiB;
constexpr size_t WS_WGU1 = 2 * MiB, WS_WD1 = 174 * MiB, WS_WIN = 260 * MiB, WS_WOUT = 388 * MiB, WS_WGU2 = 420 * MiB, WS_WD2 = 592 * MiB;
constexpr size_t WS_R1 = 678 * MiB;
constexpr size_t WS_VT = WS_R1 + 448 * MiB;
constexpr size_t WS_R2 = 1190 * MiB;
constexpr size_t WS_R3 = 1446 * MiB;
constexpr size_t WS_END = 1574 * MiB;
static_assert((size_t)2 * FF * DM * 2 <= 172 * MiB && (size_t)FF * DM * 2 <= 86 * MiB, "weights");
static_assert((size_t)MROWS * PROJ_W * 2 == 448 * MiB && (size_t)MROWS * FF * 2 <= 512 * MiB, "R1");
constexpr int CW_TMO = 0, CW_CODE = 1;
constexpr int CW_BAR = 4096;
constexpr int CW_QUEUE = 8192;

constexpr int RING_OFF = 0, RING_BYTES = 131072;
constexpr int LDSCTL_OFF = RING_BYTES, MISC_OFF = LDSCTL_OFF + 320;
constexpr int LDS_BYTES = 147456;

#define GAS __attribute__((address_space(1)))
#define LAS __attribute__((address_space(3)))
typedef unsigned short bf16;
typedef unsigned v4u __attribute__((ext_vector_type(4)));
typedef unsigned v2u __attribute__((ext_vector_type(2)));
typedef float f32x4 __attribute__((ext_vector_type(4)));
typedef GAS unsigned gu32;
#define RLX_AGENT __ATOMIC_RELAXED, __HIP_MEMORY_SCOPE_AGENT
#define LDS_WAIT() asm volatile("s_waitcnt lgkmcnt(0)" ::: "memory")
#define VM_WAIT() asm volatile("s_waitcnt vmcnt(0)" ::: "memory")
__device__ __forceinline__ unsigned f2bf(float f) { unsigned u = __builtin_bit_cast(unsigned, f); return (u + 0x7fffu + ((u >> 16) & 1u)) >> 16; }
__device__ __forceinline__ unsigned pk2(float lo, float hi) { return f2bf(lo) | (f2bf(hi) << 16); }
__device__ __forceinline__ float bf2f(unsigned short b) { return __builtin_bit_cast(float, (unsigned)b << 16); }
__device__ __forceinline__ float bflo(unsigned w) { return __builtin_bit_cast(float, w << 16); }
__device__ __forceinline__ float bfhi(unsigned w) { return __builtin_bit_cast(float, w & 0xffff0000u); }
__device__ __forceinline__ float h2f(unsigned short b) { return (float)__builtin_bit_cast(_Float16, b); }

#define XB_TMO      128
#define XB_XCNT(j)  (256  + 64 * (j))
#define XB_XSUB(j)  (1280 + 64 * (j))
#define XB_XGEN(j)  (2304 + 64 * (j))
#define XB_TOP      3328
#define XB_TOPGEN   3392
#define XCD_BAR_WORDS 3456
#define XB_SPIN_CAP (1u << 18)
__device__ __forceinline__ unsigned xb_ld(unsigned* p)              { return __hip_atomic_load(p, __ATOMIC_RELAXED, __HIP_MEMORY_SCOPE_AGENT); }
__device__ __forceinline__ unsigned xb_add(unsigned* p, unsigned v) { return __hip_atomic_fetch_add(p, v, __ATOMIC_RELAXED, __HIP_MEMORY_SCOPE_AGENT); }
__device__ __forceinline__ unsigned xb_xcc_id() { return (unsigned)__builtin_amdgcn_s_getreg((3 << 11) | 20) & 0xFu; }
#define XB_SPIN(cond, bar) do { unsigned _sp = 0; while (cond) { __builtin_amdgcn_s_sleep(1); \
    if ((++_sp & 255u) == 0u) { if (xb_ld(&(bar)[XB_TMO])) break; if (_sp > XB_SPIN_CAP) { atomicAdd(&(bar)[XB_TMO], 1u); break; } } } } while (0)
struct XcdBarrier { unsigned* bar; unsigned x; volatile LAS unsigned* st; };
__device__ __forceinline__ XcdBarrier xcd_barrier_post(unsigned* bar, volatile LAS unsigned* st) {
    XcdBarrier b; b.bar = bar; b.x = xb_xcc_id(); b.st = st;
    if (threadIdx.x == 0) (void)xb_add(&bar[XB_XCNT(b.x)], 1u);
    return b;
}
__device__ __forceinline__ void xcd_barrier_complete(unsigned* bar, unsigned x, unsigned& nloc, unsigned& nx) {
    const unsigned G = gridDim.x * gridDim.y * gridDim.z;
    unsigned sum, cnt, mine, sp = 0u;
    for (;;) {
        sum = 0u; cnt = 0u; mine = 0u;
#pragma unroll
        for (unsigned j = 0; j < 16; ++j) { const unsigned c = xb_ld(&bar[XB_XCNT(j)]); sum += c; cnt += (c > 0u) ? 1u : 0u; mine = (j == x) ? c : mine; }
        if (sum == G) break;
        __builtin_amdgcn_s_sleep(1);
        if ((++sp & 255u) == 0u) { if (xb_ld(&bar[XB_TMO])) break; if (sp > XB_SPIN_CAP) { atomicAdd(&bar[XB_TMO], 1u); break; } }
    }
    nloc = mine > 0u ? mine : 1u; nx = cnt > 0u ? cnt : 1u;
}
__device__ __forceinline__ void xcd_barrier(const XcdBarrier& b) {
    asm volatile("s_waitcnt vmcnt(0)" ::: "memory");
    __syncthreads();
    if (threadIdx.x == 0) {
        unsigned* bar = b.bar;
        __builtin_amdgcn_s_waitcnt(0);
        unsigned nloc = b.st[0], nx = b.st[1];
        if (nloc == 0u) { xcd_barrier_complete(bar, b.x, nloc, nx); b.st[0] = nloc; b.st[1] = nx; }
        const unsigned old = xb_add(&bar[XB_XSUB(b.x)], 1u);
        const unsigned gen = old / nloc;
        if (old + 1u == (gen + 1u) * nloc) {
            __builtin_amdgcn_fence(__ATOMIC_RELEASE, "agent");
            asm volatile("s_waitcnt vmcnt(0)" ::: "memory");
            const unsigned og = xb_add(&bar[XB_TOP], 1u);
            const unsigned tg = og / nx;
            if (og + 1u == (tg + 1u) * nx) xb_add(&bar[XB_TOPGEN], 1u);
            else XB_SPIN(xb_ld(&bar[XB_TOPGEN]) == tg, bar);
            __builtin_amdgcn_fence(__ATOMIC_ACQUIRE, "agent");
            xb_add(&bar[XB_XGEN(b.x)], 1u);
            asm volatile("s_waitcnt vmcnt(0)" ::: "memory");
        } else {
            XB_SPIN(xb_ld(&bar[XB_XGEN(b.x)]) == gen, bar);
            __builtin_amdgcn_fence(__ATOMIC_ACQUIRE, "agent");
            asm volatile("s_waitcnt vmcnt(0)" ::: "memory");
        }
    }
    __syncthreads();
}

__device__ __forceinline__ float wave_sum(float v) {
#pragma unroll
    for (int o = 1; o < 64; o <<= 1) v += __shfl_xor(v, o);
    return v;
}
__device__ __forceinline__ float wave_max(float v) {
#pragma unroll
    for (int o = 1; o < 64; o <<= 1) v = fmaxf(v, __shfl_xor(v, o));
    return v;
}
__device__ __forceinline__ void transpose_item(const float* W, int K, int N, bf16* WT, int mode, LAS float* scr, int item, int lane) {
    const int nblk = N / 32, kb = item / nblk, nb = item % nblk, k0 = 64 * kb, n0 = 32 * nb;
    const int rbase = (mode == 0) ? n0 : (256 * (n0 >> 7) + (n0 & 127) + (mode == 2 ? 128 : 0));
#pragma unroll 8
    for (int i = 0; i < 32; ++i) { const int kk = 2 * i + (lane >> 5); scr[kk * 33 + (lane & 31)] = W[(size_t)(k0 + kk) * N + n0 + (lane & 31)]; }
    LDS_WAIT(); asm volatile("" ::: "memory");
    const int c = lane & 7;
#pragma unroll
    for (int j = 0; j < 4; ++j) { const int n = (lane >> 3) + 8 * j; const LAS float* s = scr + (8 * c) * 33 + n;
        v4u o; o.x = pk2(s[0 * 33], s[1 * 33]); o.y = pk2(s[2 * 33], s[3 * 33]); o.z = pk2(s[4 * 33], s[5 * 33]); o.w = pk2(s[6 * 33], s[7 * 33]);
        *(GAS v4u*)(WT + (size_t)(rbase + n) * K + k0 + 8 * c) = o; }
    LDS_WAIT(); asm volatile("" ::: "memory");
}
__device__ __forceinline__ void rms_row_to_bf16(const float* xrow, const float* gain, bf16* orow, int lane) {
    const GAS f32x4* xr = (const GAS f32x4*)xrow + lane; const GAS f32x4* gr = (const GAS f32x4*)gain + lane;
    f32x4 v[16]; float ss = 0.f;
#pragma unroll
    for (int j = 0; j < 16; ++j) { v[j] = xr[64 * j]; ss += (v[j].x * v[j].x + v[j].y * v[j].y) + (v[j].z * v[j].z + v[j].w * v[j].w); }
    const float rs = 1.0f / sqrtf(wave_sum(ss) * (1.0f / DM) + EPS);
    GAS v2u* o8 = (GAS v2u*)orow + lane;
#pragma unroll
    for (int j = 0; j < 16; ++j) { const f32x4 g = gr[64 * j]; v2u w; w.x = pk2(v[j].x * rs * g.x, v[j].y * rs * g.y); w.y = pk2(v[j].z * rs * g.z, v[j].w * rs * g.w); o8[64 * j] = w; }
}
__device__ __forceinline__ void norm_res_row(const float* ffrow, const float* baserow, float* hrow, float w, const float* gpost, const float* g2, bf16* urow, int lane) {
    const GAS f32x4* fr = (const GAS f32x4*)ffrow + lane; const GAS f32x4* br = (const GAS f32x4*)baserow + lane; const GAS f32x4* gp = (const GAS f32x4*)gpost + lane;
    f32x4 v[16]; float ss = 0.f;
#pragma unroll
    for (int j = 0; j < 16; ++j) { v[j] = fr[64 * j]; ss += (v[j].x * v[j].x + v[j].y * v[j].y) + (v[j].z * v[j].z + v[j].w * v[j].w); }
    const float rs = w / sqrtf(wave_sum(ss) * (1.0f / DM) + EPS);
    GAS f32x4* ho = (GAS f32x4*)hrow + lane; float s2 = 0.f;
#pragma unroll
    for (int j = 0; j < 16; ++j) { const f32x4 g = gp[64 * j]; const f32x4 b = br[64 * j]; v[j] = b + v[j] * rs * g; ho[64 * j] = v[j];
        s2 += (v[j].x * v[j].x + v[j].y * v[j].y) + (v[j].z * v[j].z + v[j].w * v[j].w); }
    if (urow) {
        const float r2 = 1.0f / sqrtf(wave_sum(s2) * (1.0f / DM) + EPS);
        const GAS f32x4* gq = (const GAS f32x4*)g2 + lane; GAS v2u* o8 = (GAS v2u*)urow + lane;
#pragma unroll
        for (int j = 0; j < 16; ++j) { const f32x4 g = gq[64 * j]; v2u o; o.x = pk2(v[j].x * r2 * g.x, v[j].y * r2 * g.y); o.y = pk2(v[j].z * r2 * g.z, v[j].w * r2 * g.w); o8[64 * j] = o; }
    }
}

__device__ __forceinline__ void hgrn_scan_unit(LAS unsigned char* lds, const bf16* proj, float* obuf, int b, int h, int dir, int tid) {
    LAS float* Fs = (LAS float*)lds; LAS float* Ks = Fs + 4096; LAS float* Qs = Ks + 4096; LAS float* Vs = Qs + 4096; LAS float* Ps = Vs + 4096;
    const int v = tid & 127, kg = tid >> 7;
    float S[32];
#pragma unroll
    for (int i = 0; i < 32; ++i) S[i] = 0.f;
    const size_t rowbase = (size_t)b * SEQ;
    for (int c = 0; c < SEQ / 32; ++c) {
        for (int e = tid; e < 32 * 128; e += 512) { const int il = e >> 7, k = e & 127; const int i = 32 * c + il; const int t = dir ? (SEQ - 1 - i) : i;
            const bf16* pr = proj + (rowbase + t) * (size_t)PROJ_W + h * HD + k;
            const float q = bf2f(pr[C_Q]); const float g = h2f(pr[dir ? C_GB : C_GF]); const float vv = bf2f(pr[C_I]);
            const float kk = -expm1f(g);
            Fs[e] = 1.0f - kk; Ks[e] = kk; Qs[e] = q; Vs[e] = vv; }
        __syncthreads();
        for (int il = 0; il < 32; ++il) {
            const float vv = Vs[il * 128 + v]; float p = 0.f;
#pragma unroll
            for (int k4 = 0; k4 < 8; ++k4) {
                const f32x4 f4 = *(const LAS f32x4*)&Fs[il * 128 + kg * 32 + 4 * k4], k4v = *(const LAS f32x4*)&Ks[il * 128 + kg * 32 + 4 * k4], q4 = *(const LAS f32x4*)&Qs[il * 128 + kg * 32 + 4 * k4];
#pragma unroll
                for (int e = 0; e < 4; ++e) { S[4 * k4 + e] = f4[e] * S[4 * k4 + e] + k4v[e] * vv; p += S[4 * k4 + e] * q4[e]; }
            }
            Ps[(kg * 32 + il) * 128 + v] = p;
        }
        __syncthreads();
        for (int e = tid; e < 32 * 128; e += 512) { const int il = e >> 7, vv = e & 127; const int i = 32 * c + il; const int t = dir ? (SEQ - 1 - i) : i;
            obuf[(rowbase + t) * (size_t)HGW + h * HD + vv] = (Ps[e] + Ps[4096 + e]) + (Ps[8192 + e] + Ps[12288 + e]); }
    }
    __syncthreads();
}

__device__ __forceinline__ void na_unit(LAS unsigned char* lds, const bf16* proj, const bf16* vt, const float* rpb, bf16* mix, int b, int h, int r, int wave, int lane) {
    LAS float* pl = (LAS float*)(lds + wave * 512);
    const int rs = min(max(r - WIN_R / 2, 0), NROWS - WIN_R);
    const float* rp = rpb + h * (15 * 31);
    for (int ci = 0; ci < 8; ++ci) {
        const int c = wave * 8 + ci; const int cs = min(max(c - WIN_C / 2, 0), GRID_W - WIN_C);
        const bf16* qrow = proj + ((size_t)b * SEQ + r * GRID_W + c) * PROJ_W + C_NQ + h * HD;
        float s[2];
#pragma unroll
        for (int jj = 0; jj < 2; ++jj) { const int j = lane + 64 * jj; const int kr = rs + (j >> 4), kc = cs + (j & 15);
            const bf16* krow = proj + ((size_t)b * SEQ + kr * GRID_W + kc) * PROJ_W + C_NK + h * HD;
            float a = 0.f;
#pragma unroll
            for (int d8 = 0; d8 < 16; ++d8) { const v4u kv = *(const GAS v4u*)(krow + 8 * d8), qv = *(const GAS v4u*)(qrow + 8 * d8);
                a += bflo(kv.x) * bflo(qv.x) + bfhi(kv.x) * bfhi(qv.x) + bflo(kv.y) * bflo(qv.y) + bfhi(kv.y) * bfhi(qv.y)
                   + bflo(kv.z) * bflo(qv.z) + bfhi(kv.z) * bfhi(qv.z) + bflo(kv.w) * bflo(qv.w) + bfhi(kv.w) * bfhi(qv.w); }
            s[jj] = a + rp[(kr - r + WIN_R - 1) * 31 + (kc - c + WIN_C - 1)]; }
        const float m = wave_max(fmaxf(s[0], s[1]));
        const float e0 = __expf(s[0] - m), e1 = __expf(s[1] - m);
        const float inv = 1.0f / wave_sum(e0 + e1);
        pl[lane] = e0 * inv; pl[64 + lane] = e1 * inv;
        LDS_WAIT(); asm volatile("" ::: "memory");
        float o[2];
#pragma unroll
        for (int dd = 0; dd < 2; ++dd) { const int d = lane + 64 * dd; const bf16* vrow = vt + (size_t)(h * HD + d) * MROWS + (size_t)b * SEQ;
            float a = 0.f;
            for (int wr = 0; wr < WIN_R; ++wr) { const bf16* vp = vrow + (rs + wr) * GRID_W + cs;
#pragma unroll
                for (int wc = 0; wc < WIN_C; ++wc) a += pl[wr * 16 + wc] * bf2f(vp[wc]); }
            o[dd] = a; }
        bf16* orow = mix + ((size_t)b * SEQ + r * GRID_W + c) * DM + HGW + h * HD;
        orow[lane] = (bf16)f2bf(o[0]); orow[64 + lane] = (bf16)f2bf(o[1]);
        LDS_WAIT(); asm volatile("" ::: "memory");
    }
}

__device__ __forceinline__ void hgrn_combine_row(const float* of, const float* ob, const bf16* gaterow, const float* hn, bf16* orow, int lane) {
    const GAS f32x4* a = (const GAS f32x4*)of + lane; const GAS f32x4* bq = (const GAS f32x4*)ob + lane; const GAS v2u* gr = (const GAS v2u*)gaterow + lane;
    const f32x4 hg = *((const GAS f32x4*)hn + (lane & 31));
    GAS v2u* o8 = (GAS v2u*)orow + lane;
#pragma unroll
    for (int j = 0; j < 8; ++j) {
        f32x4 v = a[64 * j] + bq[64 * j];
        float ss = (v.x * v.x + v.y * v.y) + (v.z * v.z + v.w * v.w);
#pragma unroll
        for (int o = 1; o < 32; o <<= 1) ss += __shfl_xor(ss, o);
        const float rs = 1.0f / sqrtf(ss * (1.0f / HD) + EPS);
        const v2u g = gr[64 * j];
        v2u w; w.x = pk2(v.x * rs * hg.x * bflo(g.x), v.y * rs * hg.y * bfhi(g.x)); w.y = pk2(v.z * rs * hg.z * bflo(g.y), v.w * rs * hg.w * bfhi(g.y));
        o8[64 * j] = w;
    }
}

struct Args { const float* in[18]; float* out; unsigned char* ws; int ph_lo, ph_hi; };
__global__ void __launch_bounds__(NWAVES * 64, 2) fwd_kernel(Args args) {
    extern __shared__ __attribute__((aligned(16))) unsigned char lds_raw[];
    LAS unsigned char* lds = (LAS unsigned char*)lds_raw;
    volatile LAS unsigned* MISC = (volatile LAS unsigned*)(lds + MISC_OFF);
    const int G = gridDim.x, bx = blockIdx.x;
    const int vcu = (G % 8 == 0) ? (bx % 8) * (G / 8) + bx / 8 : bx;
    gu32* ctl = (gu32*)(args.ws + WS_CTL);
    for (int u = threadIdx.x; u < (LDS_BYTES - LDSCTL_OFF) / 4; u += NWAVES * 64) ((LAS unsigned*)(lds + LDSCTL_OFF))[u] = 0u;
    __syncthreads();
    XcdBarrier bar; bar.bar = (unsigned*)(args.ws + WS_CTL) + CW_BAR; bar.x = 0; bar.st = nullptr;
#if !MK_PER_PHASE
    bar = xcd_barrier_post((unsigned*)(args.ws + WS_CTL) + CW_BAR, MISC + 8);
#endif
    const int lo = args.ph_lo, hi = args.ph_hi;
#define IN(k) (lo <= (k) && (k) < hi)
#define BOTH(k) (IN(k) && IN((k) + 1))
#if MK_PER_PHASE
#define GRID_BAR() do { if (threadIdx.x == 0) __hip_atomic_store(ctl + CW_TMO, 0xBADBA0u, RLX_AGENT); } while (0)
#else
#define GRID_BAR() xcd_barrier(bar)
#endif
#define WGU1 ((bf16*)(args.ws + WS_WGU1))
#define WGU2 ((bf16*)(args.ws + WS_WGU2))
#define WD1 ((bf16*)(args.ws + WS_WD1))
#define WD2 ((bf16*)(args.ws + WS_WD2))
#define WIN ((bf16*)(args.ws + WS_WIN))
#define WOUT ((bf16*)(args.ws + WS_WOUT))
#define R1 ((bf16*)(args.ws + WS_R1))
#define VT ((bf16*)(args.ws + WS_VT))
#define R2 ((float*)(args.ws + WS_R2))
#define R3 ((bf16*)(args.ws + WS_R3))
#define LB ((float*)(args.ws + WS_LB))
#define PHASE_IDS() int tid = threadIdx.x; asm volatile("" : "+v"(tid)); const int lane = tid & 63, wave = __builtin_amdgcn_readfirstlane(tid >> 6); \
    const int gw = vcu * NWAVES + wave, NGW = G * NWAVES; (void)lane; (void)gw; (void)NGW
#define PHASE_GATEUP(k, W) if (IN(k)) { \
        pg8::Gemm g{R3, (W), MROWS, 2 * FF, DM}; pg8::StaticOrder S; S.init(MROWS, 2 * FF, G, bx); \
        pg8::EpiSwiGLU E{R1, FF}; \
        pg8::gemm_phase<pg8::EpiSwiGLU, pg8::StaticOrder, true, true>(lds + RING_OFF, g, S, E); \
        if (BOTH(k)) GRID_BAR(); }
#define PHASE_DOWN(k, W) if (IN(k)) { \
        pg8::Gemm g{R1, (W), MROWS, DM, FF}; pg8::StaticOrder S; S.init(MROWS, DM, G, bx); \
        pg8::EpiF32 E{R2, DM}; \
        pg8::gemm_phase<pg8::EpiF32, pg8::StaticOrder, true, true>(lds + RING_OFF, g, S, E); \
        if (BOTH(k)) GRID_BAR(); }
#define PHASE_NORM(k, BASE, WGT, GPOST, G2, HASU) if (IN(k)) { PHASE_IDS(); \
        for (int m = gw; m < MROWS; m += NGW) \
            norm_res_row(R2 + (size_t)m * DM, (BASE) + (size_t)m * DM, args.out + (size_t)m * DM, (WGT), (GPOST), (G2), (HASU) ? R3 + (size_t)m * DM : (bf16*)nullptr, lane); \
        if (BOTH(k)) GRID_BAR(); }

    if (IN(0)) { PHASE_IDS();
        LAS float* scr = (LAS float*)(lds + RING_OFF + wave * 16384);
        constexpr int I_GU = (DM / 64) * (FF / 32), I_D = (FF / 64) * (DM / 32), I_IN = (DM / 64) * (16384 / 32), I_OUT = (DM / 64) * (DM / 32);
        constexpr int NITEMS = 6 * I_GU + I_IN + I_OUT;
        static_assert(I_GU == I_D, "items");
        for (int it = gw; it < NITEMS; it += NGW) {
            int r = it; const float* W; bf16* WT; int K = DM, N = FF, mode = 0;
            if (r < I_GU) { W = args.in[2]; WT = WGU1; mode = 1; }
            else if ((r -= I_GU) < I_GU) { W = args.in[3]; WT = WGU1; mode = 2; }
            else if ((r -= I_GU) < I_D) { W = args.in[4]; WT = WD1; K = FF; N = DM; }
            else if ((r -= I_D) < I_IN) { W = args.in[7]; WT = WIN; N = 16384; }
            else if ((r -= I_IN) < I_OUT) { W = args.in[11]; WT = WOUT; N = DM; }
            else if ((r -= I_OUT) < I_GU) { W = args.in[14]; WT = WGU2; mode = 1; }
            else if ((r -= I_GU) < I_GU) { W = args.in[15]; WT = WGU2; mode = 2; }
            else { r -= I_GU; W = args.in[16]; WT = WD2; K = FF; N = DM; }
            transpose_item(W, K, N, WT, mode, scr, r, lane);
        }
        for (int m = gw; m < MROWS; m += NGW) rms_row_to_bf16(args.in[0] + (size_t)m * DM, args.in[1], R3 + (size_t)m * DM, lane);
        for (int i = bx * 512 + tid; i < 2 * HGW; i += G * 512) { const float l0 = args.in[8][i], l1 = args.in[8][2 * HGW + i]; LB[i] = 1.0f / (1.0f + expf(l1 - l0)); }
        if (BOTH(0)) GRID_BAR();
    }
    PHASE_GATEUP(1, WGU1)
    PHASE_DOWN(2, WD1)
    PHASE_NORM(3, args.in[0], 0.5f, args.in[5], args.in[6], true)
    if (IN(4)) {
        { pg8::Gemm g{R3, WIN, MROWS, PROJ_W, DM}; pg8::StaticOrder S; S.init(MROWS, PROJ_W, G, bx);
          pg8::EpiProj E{R1, PROJ_W, LB};
          pg8::gemm_phase<pg8::EpiProj, pg8::StaticOrder, true, true>(lds + RING_OFF, g, S, E); }
        { pg8::Gemm g{WIN + (size_t)PROJ_W * DM, R3, NAW, MROWS, DM}; pg8::StaticOrder S; S.init(NAW, MROWS, G, bx);
          pg8::EpiBf16Plain E{VT, MROWS};
          pg8::gemm_phase<pg8::EpiBf16Plain, pg8::StaticOrder, true, true>(lds + RING_OFF, g, S, E); }
        if (BOTH(4)) GRID_BAR();
    }
    if (IN(5)) { PHASE_IDS();
        if (bx < 2 * BATCH * NHEAD) { const int dir = bx & 1, h = (bx >> 1) & 15, b = bx >> 5;
            hgrn_scan_unit(lds + RING_OFF, R1, R2 + (size_t)dir * MROWS * HGW, b, h, dir, tid); }
        for (;;) {
            if (tid == 0) MISC[16] = __hip_atomic_fetch_add(ctl + CW_QUEUE, 1u, RLX_AGENT);
            __syncthreads();
            const int wu = (int)MISC[16];
            __syncthreads();
            if (wu >= BATCH * NHEAD * NROWS) break;
            const int r = wu & 63, h = (wu >> 6) & 15, b = wu >> 10;
            na_unit(lds + RING_OFF, R1, VT, args.in[10], R3, b, h, r, wave, lane);
        }
        if (BOTH(5)) GRID_BAR();
    }
    if (IN(6)) { PHASE_IDS();
        for (int m = gw; m < MROWS; m += NGW)
            hgrn_combine_row(R2 + (size_t)m * HGW, R2 + (size_t)MROWS * HGW + (size_t)m * HGW, R1 + (size_t)m * PROJ_W + C_GATE, args.in[9], R3 + (size_t)m * DM, lane);
        if (BOTH(6)) GRID_BAR();
    }
    if (IN(7)) {
        pg8::Gemm g{R3, WOUT, MROWS, DM, DM}; pg8::StaticOrder S; S.init(MROWS, DM, G, bx);
        pg8::EpiF32 E{R2, DM};
        pg8::gemm_phase<pg8::EpiF32, pg8::StaticOrder, true, true>(lds + RING_OFF, g, S, E);
        if (BOTH(7)) GRID_BAR();
    }
    PHASE_NORM(8, args.out, 1.0f, args.in[12], args.in[13], true)
    PHASE_GATEUP(9, WGU2)
    PHASE_DOWN(10, WD2)
    PHASE_NORM(11, args.out, 0.5f, args.in[17], args.in[17], false)
#if !MK_PER_PHASE
    if (IN(11)) { if (xb_ld((unsigned*)(args.ws + WS_CTL) + CW_BAR + XB_TMO) != 0u) { const float q = __builtin_nanf(""); for (int m = bx; m < MROWS; m += G) for (int c = threadIdx.x; c < DM; c += 512) args.out[(size_t)m * DM + c] = q; } }
#endif
#undef IN
#undef BOTH
}

extern "C" void kernel_launch(void* const* d_in, const int* in_sizes, int n_in, void* d_out, int out_size, void* d_ws, size_t ws_size, hipStream_t stream) {
    static int grid = 0;
    if (grid == 0) {
        if (n_in != 18 || in_sizes[0] != MROWS * DM || out_size != MROWS * DM || ws_size < WS_END) {
            fprintf(stderr, "kernel_launch: unexpected shapes (n_in %d, in0 %d, out %d, ws %zu need %zu); nothing launched\n", n_in, n_in > 0 ? in_sizes[0] : -1, out_size, ws_size, (size_t)WS_END); grid = -1; return; }
        int dev = 0, cus = 0;
        if (hipGetDevice(&dev) != hipSuccess || hipDeviceGetAttribute(&cus, hipDeviceAttributeMultiprocessorCount, dev) != hipSuccess) { grid = -1; return; }
        if (hipFuncSetAttribute((const void*)fwd_kernel, hipFuncAttributeMaxDynamicSharedMemorySize, LDS_BYTES) != hipSuccess) { fprintf(stderr, "kernel_launch: hipFuncSetAttribute failed\n"); grid = -1; return; }
        int per_cu = 0;
        if (hipOccupancyMaxActiveBlocksPerMultiprocessor(&per_cu, (const void*)fwd_kernel, NWAVES * 64, LDS_BYTES) != hipSuccess || per_cu < 1)
            fprintf(stderr, "kernel_launch: note: occupancy query reports %d workgroups per CU\n", per_cu);
        (void)hipGetLastError();
        grid = cus;
    }
    if (grid < 0) return;
    if (hipMemsetAsync((char*)d_ws + WS_CTL, 0, CTL_ZERO_BYTES, stream) != hipSuccess) { fprintf(stderr, "kernel_launch: memset failed\n"); return; }
    Args a{};
    for (int i = 0; i < 18; ++i) a.in[i] = (const float*)d_in[i];
    a.out = (float*)d_out; a.ws = (unsigned char*)d_ws;
#if MK_PER_PHASE
    for (int p = 0; p < N_PHASES; ++p) { a.ph_lo = p; a.ph_hi = p + 1; hipLaunchKernelGGL(fwd_kernel, dim3(grid), dim3(NWAVES * 64), LDS_BYTES, stream, a); }
#else
    a.ph_lo = 0; a.ph_hi = N_PHASES;
    hipLaunchKernelGGL(fwd_kernel, dim3(grid), dim3(NWAVES * 64), LDS_BYTES, stream, a);
#endif
    const hipError_t le = hipPeekAtLastError();
    if (le != hipSuccess) fprintf(stderr, "kernel_launch: launch failed: %s\n", hipGetErrorName(le));
}
```

```cpp
#include <hip/hip_runtime.h>
#include <cstdio>
#include <cstdint>

#ifndef REPEAT_MASK
#define REPEAT_MASK 0
#endif
#define NREP(k) (1 + ((REPEAT_MASK >> (k)) & 1))
#ifndef MK_PER_PHASE
#define MK_PER_PHASE 0
#endif

namespace pg8 {
#define PG8_LAS __attribute__((address_space(3)))
typedef unsigned short bf16_t;
typedef short bf16x8 __attribute__((ext_vector_type(8)));
typedef float f32x4 __attribute__((ext_vector_type(4)));
typedef unsigned u32x4 __attribute__((ext_vector_type(4)));
constexpr int BM = 256, BK = 64, HALF = 128, HTB = HALF * BK * 2  , STAGE_BYTES = 8 * HTB, NXCD = 8, WGM = 8;

__host__ __device__ __forceinline__ int lds_byte(int r, int c) { const int st = (r >> 4) * 2 + (c >> 5), rr = r & 15, cc = c & 31, ob = rr * 64 + cc * 2; return st * 1024 + (ob ^ (((ob >> 9) & 1) << 5)); }
__host__ __device__ __forceinline__ void stage_rc(int b, int& R, int& C) { const int st = b / 1024, sb = b % 1024, swz = sb ^ (((sb >> 9) & 1) << 5); R = (st >> 1) * 16 + swz / 64; C = (st & 1) * 32 + (swz % 64) / 2; }
__host__ __device__ __forceinline__ int perm32(int rho) { const int n = rho >> 4, i = rho & 15; return 8 * (i >> 2) + 4 * n + (i & 3); }

struct Unit { int pm, pn; };
struct Gemm { const bf16_t* A; const bf16_t* Bt; int M, N, K; };

struct StaticOrder {
    int nM, nN, nwg, G, c;
    __host__ __device__ void init(int M, int N, int G_, int c_) { nM = M / BM; nN = N / BM; nwg = nM * nN; G = G_; c = c_; }
    __host__ __device__ bool next(int i, Unit& u) const {
        const long L = (long)i * G + c; if (L >= nwg) return false;
        int wgid = (int)L; { const int q = nwg / NXCD, r = nwg % NXCD, xcd = wgid % NXCD, off = wgid / NXCD; wgid = (xcd < r ? xcd * (q + 1) : r * (q + 1) + (xcd - r) * q) + off; }
        const int nig = WGM * nN, gid = wgid / nig, fm = gid * WGM, gsz = (nM - fm) < WGM ? (nM - fm) : WGM;
        u.pm = fm + ((wgid % nig) % gsz); u.pn = (wgid % nig) / gsz; return true;
    }
    __device__ __forceinline__ void a_ready(const Unit&) const {}
    __device__ __forceinline__ void done(const Unit&) const {}
};

__device__ __forceinline__ unsigned cvt_pk_bf16(float lo, float hi) { unsigned r; asm volatile("v_cvt_pk_bf16_f32 %0, %1, %2" : "=v"(r) : "v"(lo), "v"(hi)); return r; }
__device__ __forceinline__ unsigned cvt_pk_f16(float lo, float hi) { typedef _Float16 h2 __attribute__((ext_vector_type(2))); h2 v; v.x = (_Float16)lo; v.y = (_Float16)hi; return __builtin_bit_cast(unsigned, v); }
__device__ __forceinline__ float sigmoidf_fast(float v) { return __builtin_amdgcn_rcpf(1.0f + __builtin_amdgcn_exp2f(-1.4426950408889634f * v)); }

struct EpiF32 {
    static constexpr bool PERM = false, AFTER_DRAIN = false;
    float* C; int ldc;
    __device__ __forceinline__ void operator()(const f32x4 (&acc)[2][2][4][2], const Unit& u, int wr, int wc, int fr, int fq) const {
        const int row0 = u.pm * BM + wr * 64 + fr, col0 = u.pn * BM + wc * 32 + 4 * fq;
#pragma unroll
        for (int ai = 0; ai < 2; ++ai)
#pragma unroll
            for (int m = 0; m < 4; ++m) { float* rowp = C + (size_t)(row0 + ai * HALF + m * 16) * ldc + col0;
#pragma unroll
                for (int bj = 0; bj < 2; ++bj)
#pragma unroll
                    for (int n = 0; n < 2; ++n) *(f32x4*)(rowp + bj * HALF + n * 16) = acc[ai][bj][m][n]; }
    }
};
struct EpiBf16Plain {
    static constexpr bool PERM = true, AFTER_DRAIN = false;
    bf16_t* O; int ldc;
    __device__ __forceinline__ void operator()(const f32x4 (&acc)[2][2][4][2], const Unit& u, int wr, int wc, int fr, int fq) const {
        const int row0 = u.pm * BM + wr * 64 + fr, col0 = u.pn * BM + wc * 32 + 8 * fq;
#pragma unroll
        for (int ai = 0; ai < 2; ++ai)
#pragma unroll
            for (int m = 0; m < 4; ++m) { bf16_t* rowp = O + (size_t)(row0 + ai * HALF + m * 16) * ldc + col0;
#pragma unroll
                for (int bj = 0; bj < 2; ++bj) { const f32x4 v0 = acc[ai][bj][m][0], v1 = acc[ai][bj][m][1];
                    u32x4 w; w.x = cvt_pk_bf16(v0[0], v0[1]); w.y = cvt_pk_bf16(v0[2], v0[3]); w.z = cvt_pk_bf16(v1[0], v1[1]); w.w = cvt_pk_bf16(v1[2], v1[3]);
                    *(u32x4*)(rowp + bj * HALF) = w; } }
    }
};
struct EpiSwiGLU {
    static constexpr bool PERM = true, AFTER_DRAIN = false;
    bf16_t* H; int ldc;
    __device__ __forceinline__ void operator()(const f32x4 (&acc)[2][2][4][2], const Unit& u, int wr, int wc, int fr, int fq) const {
        const int row0 = u.pm * BM + wr * 64 + fr, col0 = u.pn * HALF + wc * 32 + 8 * fq;
#pragma unroll
        for (int ai = 0; ai < 2; ++ai)
#pragma unroll
            for (int m = 0; m < 4; ++m) { bf16_t* rowp = H + (size_t)(row0 + ai * HALF + m * 16) * ldc + col0;
                float h[8];
#pragma unroll
                for (int n = 0; n < 2; ++n)
#pragma unroll
                    for (int e = 0; e < 4; ++e) { const float g = acc[ai][0][m][n][e], up = acc[ai][1][m][n][e]; h[4 * n + e] = g * sigmoidf_fast(g) * up; }
                u32x4 w; w.x = cvt_pk_bf16(h[0], h[1]); w.y = cvt_pk_bf16(h[2], h[3]); w.z = cvt_pk_bf16(h[4], h[5]); w.w = cvt_pk_bf16(h[6], h[7]);
                *(u32x4*)rowp = w; }
    }
};
struct EpiProj {
    static constexpr bool PERM = true, AFTER_DRAIN = false;
    bf16_t* P; int ldc; const float* lb;
    __device__ __forceinline__ void operator()(const f32x4 (&acc)[2][2][4][2], const Unit& u, int wr, int wc, int fr, int fq) const {
        const int sec = u.pn >> 3;
        const int row0 = u.pm * BM + wr * 64 + fr, col0 = u.pn * BM + wc * 32 + 8 * fq;
        const bool isg = (sec == 1 || sec == 2), act = (sec == 0 || sec == 4); const float sc = (sec == 5) ? 0.08838834764831845f : 1.0f;
        const float* lbp = lb + (isg ? (col0 - 2048) : 0);
#pragma unroll
        for (int ai = 0; ai < 2; ++ai)
#pragma unroll
            for (int m = 0; m < 4; ++m) { bf16_t* rowp = P + (size_t)(row0 + ai * HALF + m * 16) * ldc + col0;
#pragma unroll
                for (int bj = 0; bj < 2; ++bj) { float g[8]; u32x4 w;
                    if (isg) {
                        const f32x4 la = *(const f32x4*)(lbp + bj * HALF), lc = *(const f32x4*)(lbp + bj * HALF + 4);
#pragma unroll
                        for (int e = 0; e < 4; ++e) { const float f0 = la[e] + (1.0f - la[e]) * sigmoidf_fast(acc[ai][bj][m][0][e]), f1 = lc[e] + (1.0f - lc[e]) * sigmoidf_fast(acc[ai][bj][m][1][e]);
                            g[e] = __builtin_amdgcn_logf(f0) * 0.6931471805599453f; g[4 + e] = __builtin_amdgcn_logf(f1) * 0.6931471805599453f; }
                        w.x = cvt_pk_f16(g[0], g[1]); w.y = cvt_pk_f16(g[2], g[3]); w.z = cvt_pk_f16(g[4], g[5]); w.w = cvt_pk_f16(g[6], g[7]);
                    } else {
#pragma unroll
                        for (int n = 0; n < 2; ++n)
#pragma unroll
                            for (int e = 0; e < 4; ++e) { const float v = acc[ai][bj][m][n][e]; g[4 * n + e] = act ? v * sigmoidf_fast(v) : v * sc; }
                        w.x = cvt_pk_bf16(g[0], g[1]); w.y = cvt_pk_bf16(g[2], g[3]); w.z = cvt_pk_bf16(g[4], g[5]); w.w = cvt_pk_bf16(g[6], g[7]);
                    }
                    *(u32x4*)(rowp + bj * HALF) = w; }
                asm volatile("" ::: "memory"); }
    }
};

template <class Epi, class Sched, bool ALIGN_EPI = false, bool SP2 = false>
__device__ __forceinline__ void gemm_phase(PG8_LAS unsigned char* lds, const Gemm g, const Sched& S, const Epi& E) {
    int tid_ = threadIdx.x; asm volatile("" : "+v"(tid_));
    const int tid = tid_, wid = __builtin_amdgcn_readfirstlane(tid >> 6), lane = tid & 63, wr = wid >> 2, wc = wid & 3, fr = lane & 15, fq = lane >> 4;
    const int K = g.K, nt = K / BK;
    unsigned voffA[2], voffB[2];
#pragma unroll
    for (int i = 0; i < 2; ++i) { int R, C; stage_rc(tid * 16 + i * 8192, R, C); const int Rb = Epi::PERM ? ((R & ~31) + perm32(R & 31)) : R;
        voffA[i] = (unsigned)(R * K + C) * 2u; voffB[i] = (unsigned)(Rb * K + C) * 2u; }
    const size_t kstep = (size_t)(BK * 2);
    const size_t hstep = (size_t)HALF * K * 2;
    const size_t tstep = 2 * hstep;
    const unsigned ldsw = (unsigned)wid * 1024u;
    const int aoff = lds_byte(wr * 64 + fr, fq * 8), boff = lds_byte(wc * 32 + fr, fq * 8);
#define PG8_SA(b, h) (((b) * 2 + (h)) * HTB)
#define PG8_SB(b, h) ((4 + (b) * 2 + (h)) * HTB)
#define PG8_STAGE(bufoff, gbase, voff) do { _Pragma("unroll") for (int _i = 0; _i < 2; ++_i) \
        __builtin_amdgcn_global_load_lds((const unsigned*)((const char*)(gbase) + (voff)[_i]), (PG8_LAS unsigned*)(lds + (bufoff) + ldsw + _i * 8192), 16, 0, 0); } while (0)
#define PG8_LDA(dst, b, h) do { _Pragma("unroll") for (int m = 0; m < 4; ++m) _Pragma("unroll") for (int k = 0; k < 2; ++k) dst[m][k] = *(const PG8_LAS bf16x8*)(lds + PG8_SA(b, h) + aoff + m * 2048 + k * 1024); } while (0)
#define PG8_LDB(dst, b, h) do { _Pragma("unroll") for (int n = 0; n < 2; ++n) _Pragma("unroll") for (int k = 0; k < 2; ++k) dst[n][k] = *(const PG8_LAS bf16x8*)(lds + PG8_SB(b, h) + boff + n * 2048 + k * 1024); } while (0)
#define PG8_MMA(ai, bj, At, Bt) do { __builtin_amdgcn_s_setprio(1); _Pragma("unroll") for (int m = 0; m < 4; ++m) _Pragma("unroll") for (int n = 0; n < 2; ++n) _Pragma("unroll") for (int k = 0; k < 2; ++k) \
        acc[ai][bj][m][n] = __builtin_amdgcn_mfma_f32_16x16x32_bf16(Bt[n][k], At[m][k], acc[ai][bj][m][n], 0, 0, 0); __builtin_amdgcn_s_setprio(0); } while (0)
#define PG8_WAIT_V(n) asm volatile("s_waitcnt vmcnt(" #n ")" ::: "memory")
#define PG8_WAIT_L(n) asm volatile("s_waitcnt lgkmcnt(" #n ")" ::: "memory")
#define PG8_BAR __builtin_amdgcn_s_barrier()
#define PG8_SCHED __builtin_amdgcn_sched_barrier(0)
    Unit cur, nxt; int ui = 0;
    if (!S.next(0, cur)) return;
    f32x4 acc[2][2][4][2];
#pragma unroll
    for (int a = 0; a < 2; ++a)
#pragma unroll
        for (int b = 0; b < 2; ++b)
#pragma unroll
            for (int m = 0; m < 4; ++m)
#pragma unroll
                for (int n = 0; n < 2; ++n) acc[a][b][m][n] = (f32x4){0.f, 0.f, 0.f, 0.f};
    bf16x8 At[4][2], B0[2][2], B1[2][2];
    const char* cA = (const char*)g.A + (size_t)cur.pm * tstep; const char* cB = (const char*)g.Bt + (size_t)cur.pn * tstep;
    S.a_ready(cur);
    if constexpr (SP2) {
        PG8_STAGE(PG8_SB(0, 0), cB, voffB); PG8_STAGE(PG8_SB(0, 1), cB + hstep, voffB); PG8_STAGE(PG8_SA(0, 0), cA, voffA); PG8_STAGE(PG8_SA(0, 1), cA + hstep, voffA);
        if (wr == 1) PG8_BAR;
        PG8_WAIT_V(2); PG8_BAR;
        PG8_STAGE(PG8_SB(1, 0), cB + kstep, voffB); PG8_STAGE(PG8_SA(1, 0), cA + kstep, voffA); PG8_STAGE(PG8_SB(1, 1), cB + hstep + kstep, voffB);
        PG8_WAIT_V(6); PG8_BAR;
    } else {
        PG8_STAGE(PG8_SB(0, 0), cB, voffB); PG8_STAGE(PG8_SA(0, 0), cA, voffA); PG8_STAGE(PG8_SB(0, 1), cB + hstep, voffB); PG8_STAGE(PG8_SA(0, 1), cA + hstep, voffA);
        if (wr == 1) PG8_BAR;
        PG8_WAIT_V(4); PG8_BAR;
        PG8_STAGE(PG8_SB(1, 0), cB + kstep, voffB); PG8_STAGE(PG8_SA(1, 0), cA + kstep, voffA); PG8_STAGE(PG8_SB(1, 1), cB + hstep + kstep, voffB);
        PG8_WAIT_V(6); PG8_BAR;
    }
    for (;;) {
        const bool has_next = S.next(ui + 1, nxt);
        const char* nA = has_next ? (const char*)g.A + (size_t)nxt.pm * tstep : cA; const char* nB = has_next ? (const char*)g.Bt + (size_t)nxt.pn * tstep : cB;
        for (int t = 0; t < nt; t += 2) {
            const bool last = (t == nt - 2);
            const char* a1 = cA + (size_t)(t + 1) * kstep;
            const char* a2 = last ? nA : cA + (size_t)(t + 2) * kstep; const char* b2 = last ? nB : cB + (size_t)(t + 2) * kstep;
            const char* a3 = a2 + kstep; const char* b3 = b2 + kstep;
            if (last && has_next) S.a_ready(nxt);
            if constexpr (SP2) {
            PG8_LDB(B0, 0, 0); PG8_LDB(B1, 0, 1); PG8_SCHED; PG8_LDA(At, 0, 0); PG8_STAGE(PG8_SA(1, 1), a1 + hstep, voffA);
            PG8_WAIT_V(8); PG8_WAIT_L(0); PG8_BAR; PG8_MMA(0, 0, At, B0); PG8_MMA(0, 1, At, B1); PG8_BAR; PG8_SCHED;
            PG8_LDA(At, 0, 1); PG8_STAGE(PG8_SB(0, 0), b2, voffB); PG8_STAGE(PG8_SB(0, 1), b2 + hstep, voffB); PG8_STAGE(PG8_SA(0, 0), a2, voffA);
            PG8_WAIT_V(8); PG8_WAIT_L(0); PG8_BAR; PG8_MMA(1, 0, At, B0); PG8_MMA(1, 1, At, B1); PG8_BAR; PG8_SCHED;
            PG8_LDB(B0, 1, 0); PG8_LDB(B1, 1, 1); PG8_SCHED; PG8_LDA(At, 1, 0); PG8_STAGE(PG8_SA(0, 1), a2 + hstep, voffA);
            PG8_WAIT_V(8); PG8_WAIT_L(0); PG8_BAR; PG8_MMA(0, 0, At, B0); PG8_MMA(0, 1, At, B1); PG8_BAR; PG8_SCHED;
            PG8_LDA(At, 1, 1); PG8_STAGE(PG8_SB(1, 0), b3, voffB); PG8_STAGE(PG8_SB(1, 1), b3 + hstep, voffB); PG8_STAGE(PG8_SA(1, 0), a3, voffA);
            PG8_WAIT_V(8); PG8_WAIT_L(0); PG8_BAR; PG8_MMA(1, 0, At, B0); PG8_MMA(1, 1, At, B1); PG8_BAR; PG8_SCHED;
            } else {
            PG8_LDB(B0, 0, 0); PG8_SCHED; PG8_LDA(At, 0, 0); PG8_STAGE(PG8_SA(1, 1), a1 + hstep, voffA);
            PG8_WAIT_L(8); PG8_BAR; PG8_WAIT_L(0); PG8_MMA(0, 0, At, B0); PG8_BAR; PG8_SCHED;
            PG8_LDB(B1, 0, 1); PG8_STAGE(PG8_SB(0, 0), b2, voffB);
            PG8_BAR; PG8_WAIT_L(0); PG8_MMA(0, 1, At, B1); PG8_BAR;
            PG8_LDA(At, 0, 1); PG8_STAGE(PG8_SA(0, 0), a2, voffA);
            PG8_BAR; PG8_WAIT_L(0); PG8_MMA(1, 0, At, B0); PG8_BAR; PG8_SCHED;
            PG8_STAGE(PG8_SB(0, 1), b2 + hstep, voffB);
            PG8_WAIT_V(6); PG8_BAR; PG8_MMA(1, 1, At, B1); PG8_BAR;
            PG8_LDB(B0, 1, 0); PG8_SCHED; PG8_LDA(At, 1, 0); PG8_STAGE(PG8_SA(0, 1), a2 + hstep, voffA);
            PG8_WAIT_L(8); PG8_BAR; PG8_WAIT_L(0); PG8_MMA(0, 0, At, B0); PG8_BAR; PG8_SCHED;
            PG8_LDB(B1, 1, 1); PG8_STAGE(PG8_SB(1, 0), b3, voffB);
            PG8_BAR; PG8_WAIT_L(0); PG8_MMA(0, 1, At, B1); PG8_BAR;
            PG8_LDA(At, 1, 1); PG8_STAGE(PG8_SA(1, 0), a3, voffA);
            PG8_BAR; PG8_WAIT_L(0); PG8_MMA(1, 0, At, B0); PG8_BAR; PG8_SCHED;
            PG8_STAGE(PG8_SB(1, 1), b3 + hstep, voffB);
            PG8_WAIT_V(6); PG8_BAR; PG8_MMA(1, 1, At, B1); PG8_BAR;
            }
        }
        if constexpr (ALIGN_EPI) { if (wr == 0) PG8_BAR; }
        if constexpr (!Epi::AFTER_DRAIN) { E(acc, cur, wr, wc, fr, fq); S.done(cur); }
        if (!has_next) break;
#pragma unroll
        for (int a = 0; a < 2; ++a)
#pragma unroll
            for (int b = 0; b < 2; ++b)
#pragma unroll
                for (int m = 0; m < 4; ++m)
#pragma unroll
                    for (int n = 0; n < 2; ++n) acc[a][b][m][n] = (f32x4){0.f, 0.f, 0.f, 0.f};
        cur = nxt; cA = nA; cB = nB; ++ui;
        if constexpr (ALIGN_EPI) { if (wr == 1) PG8_BAR; }
    }
    PG8_WAIT_V(0);
    if constexpr (!ALIGN_EPI) { if (wr == 0) PG8_BAR; }
    PG8_BAR;
#undef PG8_SA
#undef PG8_SB
#undef PG8_STAGE
#undef PG8_LDA
#undef PG8_LDB
#undef PG8_MMA
#undef PG8_WAIT_V
#undef PG8_WAIT_L
#undef PG8_BAR
#undef PG8_SCHED
}
}

constexpr int NWAVES = 8;
constexpr int DM = 4096, BATCH = 4, SEQ = 4096, MROWS = BATCH * SEQ;
constexpr int FF = 11008, HGW = 2048, NAW = 2048, HD = 128, NHEAD = 16;
constexpr int PROJ_W = 14336;
constexpr int C_Q = 0, C_GF = 2048, C_GB = 4096, C_I = 6144, C_GATE = 8192, C_NQ = 10240, C_NK = 12288;
constexpr int GRID_W = 64, NROWS = 64, WIN_R = 8, WIN_C = 16;
constexpr float EPS = 1e-6f;
constexpr int N_PHASES = 12;

constexpr size_t MiB = 1u << 20;
constexpr size_t WS_CTL = 0, CTL_ZERO_BYTES = 1 * MiB;
constexpr size_t WS_LB = 1 * MiB;
constexpr size_t WS_WGU1 = 2 * MiB, WS_WD1 = 174 * MiB, WS_WIN = 260 * MiB, WS_WOUT = 388 * MiB, WS_WGU2 = 420 * MiB, WS_WD2 = 592 * MiB;
constexpr size_t WS_R1 = 678 * MiB;
constexpr size_t WS_VT = WS_R1 + 448 * MiB;
constexpr size_t WS_R2 = 1190 * MiB;
constexpr size_t WS_R3 = 1446 * MiB;
constexpr size_t WS_END = 1574 * MiB;
static_assert((size_t)2 * FF * DM * 2 <= 172 * MiB && (size_t)FF * DM * 2 <= 86 * MiB, "weights");
static_assert((size_t)MROWS * PROJ_W * 2 == 448 * MiB && (size_t)MROWS * FF * 2 <= 512 * MiB, "R1");
constexpr int CW_TMO = 0, CW_CODE = 1;
constexpr int CW_BAR = 4096;
constexpr int CW_QUEUE = 8192;

constexpr int RING_OFF = 0, RING_BYTES = 131072;
constexpr int LDSCTL_OFF = RING_BYTES, MISC_OFF = LDSCTL_OFF + 320;
constexpr int LDS_BYTES = 147456;

#define GAS __attribute__((address_space(1)))
#define LAS __attribute__((address_space(3)))
typedef unsigned short bf16;
typedef unsigned v4u __attribute__((ext_vector_type(4)));
typedef unsigned v2u __attribute__((ext_vector_type(2)));
typedef float f32x4 __attribute__((ext_vector_type(4)));
typedef GAS unsigned gu32;
#define RLX_AGENT __ATOMIC_RELAXED, __HIP_MEMORY_SCOPE_AGENT
#define LDS_WAIT() asm volatile("s_waitcnt lgkmcnt(0)" ::: "memory")
#define VM_WAIT() asm volatile("s_waitcnt vmcnt(0)" ::: "memory")
__device__ __forceinline__ unsigned f2bf(float f) { unsigned u = __builtin_bit_cast(unsigned, f); return (u + 0x7fffu + ((u >> 16) & 1u)) >> 16; }
__device__ __forceinline__ unsigned pk2(float lo, float hi) { return f2bf(lo) | (f2bf(hi) << 16); }
__device__ __forceinline__ float bf2f(unsigned short b) { return __builtin_bit_cast(float, (unsigned)b << 16); }
__device__ __forceinline__ float bflo(unsigned w) { return __builtin_bit_cast(float, w << 16); }
__device__ __forceinline__ float bfhi(unsigned w) { return __builtin_bit_cast(float, w & 0xffff0000u); }
__device__ __forceinline__ float h2f(unsigned short b) { return (float)__builtin_bit_cast(_Float16, b); }

#define XB_TMO      128
#define XB_XCNT(j)  (256  + 64 * (j))
#define XB_XSUB(j)  (1280 + 64 * (j))
#define XB_XGEN(j)  (2304 + 64 * (j))
#define XB_TOP      3328
#define XB_TOPGEN   3392
#define XCD_BAR_WORDS 3456
#define XB_SPIN_CAP (1u << 18)
__device__ __forceinline__ unsigned xb_ld(unsigned* p)              { return __hip_atomic_load(p, __ATOMIC_RELAXED, __HIP_MEMORY_SCOPE_AGENT); }
__device__ __forceinline__ unsigned xb_add(unsigned* p, unsigned v) { return __hip_atomic_fetch_add(p, v, __ATOMIC_RELAXED, __HIP_MEMORY_SCOPE_AGENT); }
__device__ __forceinline__ unsigned xb_xcc_id() { return (unsigned)__builtin_amdgcn_s_getreg((3 << 11) | 20) & 0xFu; }
#define XB_SPIN(cond, bar) do { unsigned _sp = 0; while (cond) { __builtin_amdgcn_s_sleep(1); \
    if ((++_sp & 255u) == 0u) { if (xb_ld(&(bar)[XB_TMO])) break; if (_sp > XB_SPIN_CAP) { atomicAdd(&(bar)[XB_TMO], 1u); break; } } } } while (0)
struct XcdBarrier { unsigned* bar; unsigned x; volatile LAS unsigned* st; };
__device__ __forceinline__ XcdBarrier xcd_barrier_post(unsigned* bar, volatile LAS unsigned* st) {
    XcdBarrier b; b.bar = bar; b.x = xb_xcc_id(); b.st = st;
    if (threadIdx.x == 0) (void)xb_add(&bar[XB_XCNT(b.x)], 1u);
    return b;
}
__device__ __forceinline__ void xcd_barrier_complete(unsigned* bar, unsigned x, unsigned& nloc, unsigned& nx) {
    const unsigned G = gridDim.x * gridDim.y * gridDim.z;
    unsigned sum, cnt, mine, sp = 0u;
    for (;;) {
        sum = 0u; cnt = 0u; mine = 0u;
#pragma unroll
        for (unsigned j = 0; j < 16; ++j) { const unsigned c = xb_ld(&bar[XB_XCNT(j)]); sum += c; cnt += (c > 0u) ? 1u : 0u; mine = (j == x) ? c : mine; }
        if (sum == G) break;
        __builtin_amdgcn_s_sleep(1);
        if ((++sp & 255u) == 0u) { if (xb_ld(&bar[XB_TMO])) break; if (sp > XB_SPIN_CAP) { atomicAdd(&bar[XB_TMO], 1u); break; } }
    }
    nloc = mine > 0u ? mine : 1u; nx = cnt > 0u ? cnt : 1u;
}
__device__ __forceinline__ void xcd_barrier(const XcdBarrier& b) {
    asm volatile("s_waitcnt vmcnt(0)" ::: "memory");
    __syncthreads();
    if (threadIdx.x == 0) {
        unsigned* bar = b.bar;
        __builtin_amdgcn_s_waitcnt(0);
        unsigned nloc = b.st[0], nx = b.st[1];
        if (nloc == 0u) { xcd_barrier_complete(bar, b.x, nloc, nx); b.st[0] = nloc; b.st[1] = nx; }
        const unsigned old = xb_add(&bar[XB_XSUB(b.x)], 1u);
        const unsigned gen = old / nloc;
        if (old + 1u == (gen + 1u) * nloc) {
            __builtin_amdgcn_fence(__ATOMIC_RELEASE, "agent");
            asm volatile("s_waitcnt vmcnt(0)" ::: "memory");
            const unsigned og = xb_add(&bar[XB_TOP], 1u);
            const unsigned tg = og / nx;
            if (og + 1u == (tg + 1u) * nx) xb_add(&bar[XB_TOPGEN], 1u);
            else XB_SPIN(xb_ld(&bar[XB_TOPGEN]) == tg, bar);
            __builtin_amdgcn_fence(__ATOMIC_ACQUIRE, "agent");
            xb_add(&bar[XB_XGEN(b.x)], 1u);
            asm volatile("s_waitcnt vmcnt(0)" ::: "memory");
        } else {
            XB_SPIN(xb_ld(&bar[XB_XGEN(b.x)]) == gen, bar);
            __builtin_amdgcn_fence(__ATOMIC_ACQUIRE, "agent");
            asm volatile("s_waitcnt vmcnt(0)" ::: "memory");
        }
    }
    __syncthreads();
}

__device__ __forceinline__ float wave_sum(float v) {
#pragma unroll
    for (int o = 1; o < 64; o <<= 1) v += __shfl_xor(v, o);
    return v;
}
__device__ __forceinline__ float wave_max(float v) {
#pragma unroll
    for (int o = 1; o < 64; o <<= 1) v = fmaxf(v, __shfl_xor(v, o));
    return v;
}
__device__ __forceinline__ void transpose_item(const float* W, int K, int N, bf16* WT, int mode, LAS float* scr, int item, int lane) {
    const int nblk = N / 32, kb = item / nblk, nb = item % nblk, k0 = 64 * kb, n0 = 32 * nb;
    const int rbase = (mode == 0) ? n0 : (256 * (n0 >> 7) + (n0 & 127) + (mode == 2 ? 128 : 0));
#pragma unroll 8
    for (int i = 0; i < 32; ++i) { const int kk = 2 * i + (lane >> 5); scr[kk * 33 + (lane & 31)] = W[(size_t)(k0 + kk) * N + n0 + (lane & 31)]; }
    LDS_WAIT(); asm volatile("" ::: "memory");
    const int c = lane & 7;
#pragma unroll
    for (int j = 0; j < 4; ++j) { const int n = (lane >> 3) + 8 * j; const LAS float* s = scr + (8 * c) * 33 + n;
        v4u o; o.x = pk2(s[0 * 33], s[1 * 33]); o.y = pk2(s[2 * 33], s[3 * 33]); o.z = pk2(s[4 * 33], s[5 * 33]); o.w = pk2(s[6 * 33], s[7 * 33]);
        *(GAS v4u*)(WT + (size_t)(rbase + n) * K + k0 + 8 * c) = o; }
    LDS_WAIT(); asm volatile("" ::: "memory");
}
__device__ __forceinline__ void rms_row_to_bf16(const float* xrow, const float* gain, bf16* orow, int lane) {
    const GAS f32x4* xr = (const GAS f32x4*)xrow + lane; const GAS f32x4* gr = (const GAS f32x4*)gain + lane;
    f32x4 v[16]; float ss = 0.f;
#pragma unroll
    for (int j = 0; j < 16; ++j) { v[j] = xr[64 * j]; ss += (v[j].x * v[j].x + v[j].y * v[j].y) + (v[j].z * v[j].z + v[j].w * v[j].w); }
    const float rs = 1.0f / sqrtf(wave_sum(ss) * (1.0f / DM) + EPS);
    GAS v2u* o8 = (GAS v2u*)orow + lane;
#pragma unroll
    for (int j = 0; j < 16; ++j) { const f32x4 g = gr[64 * j]; v2u w; w.x = pk2(v[j].x * rs * g.x, v[j].y * rs * g.y); w.y = pk2(v[j].z * rs * g.z, v[j].w * rs * g.w); o8[64 * j] = w; }
}
__device__ __forceinline__ void norm_res_row(const float* ffrow, const float* baserow, float* hrow, float w, const float* gpost, const float* g2, bf16* urow, int lane) {
    const GAS f32x4* fr = (const GAS f32x4*)ffrow + lane; const GAS f32x4* br = (const GAS f32x4*)baserow + lane; const GAS f32x4* gp = (const GAS f32x4*)gpost + lane;
    f32x4 v[16]; float ss = 0.f;
#pragma unroll
    for (int j = 0; j < 16; ++j) { v[j] = fr[64 * j]; ss += (v[j].x * v[j].x + v[j].y * v[j].y) + (v[j].z * v[j].z + v[j].w * v[j].w); }
    const float rs = w / sqrtf(wave_sum(ss) * (1.0f / DM) + EPS);
    GAS f32x4* ho = (GAS f32x4*)hrow + lane; float s2 = 0.f;
#pragma unroll
    for (int j = 0; j < 16; ++j) { const f32x4 g = gp[64 * j]; const f32x4 b = br[64 * j]; v[j] = b + v[j] * rs * g; ho[64 * j] = v[j];
        s2 += (v[j].x * v[j].x + v[j].y * v[j].y) + (v[j].z * v[j].z + v[j].w * v[j].w); }
    if (urow) {
        const float r2 = 1.0f / sqrtf(wave_sum(s2) * (1.0f / DM) + EPS);
        const GAS f32x4* gq = (const GAS f32x4*)g2 + lane; GAS v2u* o8 = (GAS v2u*)urow + lane;
#pragma unroll
        for (int j = 0; j < 16; ++j) { const f32x4 g = gq[64 * j]; v2u o; o.x = pk2(v[j].x * r2 * g.x, v[j].y * r2 * g.y); o.y = pk2(v[j].z * r2 * g.z, v[j].w * r2 * g.w); o8[64 * j] = o; }
    }
}

__device__ __forceinline__ void hgrn_scan_unit(LAS unsigned char* lds, const bf16* proj, float* obuf, int b, int h, int dir, int tid) {
    LAS float* Fs = (LAS float*)lds; LAS float* Ks = Fs + 4096; LAS float* Qs = Ks + 4096; LAS float* Vs = Qs + 4096; LAS float* Ps = Vs + 4096;
    const int v = tid & 127, kg = tid >> 7;
    float S[32];
#pragma unroll
    for (int i = 0; i < 32; ++i) S[i] = 0.f;
    const size_t rowbase = (size_t)b * SEQ;
    for (int c = 0; c < SEQ / 32; ++c) {
        for (int e = tid; e < 32 * 128; e += 512) { const int il = e >> 7, k = e & 127; const int i = 32 * c + il; const int t = dir ? (SEQ - 1 - i) : i;
            const bf16* pr = proj + (rowbase + t) * (size_t)PROJ_W + h * HD + k;
            const float q = bf2f(pr[C_Q]); const float g = h2f(pr[dir ? C_GB : C_GF]); const float vv = bf2f(pr[C_I]);
            const float kk = -expm1f(g);
            Fs[e] = 1.0f - kk; Ks[e] = kk; Qs[e] = q; Vs[e] = vv; }
        __syncthreads();
        for (int il = 0; il < 32; ++il) {
            const float vv = Vs[il * 128 + v]; float p = 0.f;
#pragma unroll
            for (int k4 = 0; k4 < 8; ++k4) {
                const f32x4 f4 = *(const LAS f32x4*)&Fs[il * 128 + kg * 32 + 4 * k4], k4v = *(const LAS f32x4*)&Ks[il * 128 + kg * 32 + 4 * k4], q4 = *(const LAS f32x4*)&Qs[il * 128 + kg * 32 + 4 * k4];
#pragma unroll
                for (int e = 0; e < 4; ++e) { S[4 * k4 + e] = f4[e] * S[4 * k4 + e] + k4v[e] * vv; p += S[4 * k4 + e] * q4[e]; }
            }
            Ps[(kg * 32 + il) * 128 + v] = p;
        }
        __syncthreads();
        for (int e = tid; e < 32 * 128; e += 512) { const int il = e >> 7, vv = e & 127; const int i = 32 * c + il; const int t = dir ? (SEQ - 1 - i) : i;
            obuf[(rowbase + t) * (size_t)HGW + h * HD + vv] = (Ps[e] + Ps[4096 + e]) + (Ps[8192 + e] + Ps[12288 + e]); }
    }
    __syncthreads();
}

typedef short bf16x8 __attribute__((ext_vector_type(8)));
__device__ __forceinline__ void na_unit_mfma(const LAS float* tbl, const bf16* proj, const bf16* vt, bf16* mix, int b, int h, int rp, int wave, int lane) {
    const int r = 2 * rp + (wave >> 2), cb = wave & 3;
    const int cbase = (cb == 0) ? 0 : (cb == 1) ? 8 : (cb == 2) ? 24 : 32;
    const int rs = min(max(r - WIN_R / 2, 0), NROWS - WIN_R);
    const int i = lane & 15, g = lane >> 4;
    const int c = 16 * cb + i, cs = min(max(c - WIN_C / 2, 0), GRID_W - WIN_C);
    const size_t tok0 = (size_t)b * SEQ;
    const bf16* qp = proj + (tok0 + r * GRID_W + c) * PROJ_W + C_NQ + h * HD + 8 * g;
    bf16x8 qf[4];
#pragma unroll
    for (int ks = 0; ks < 4; ++ks) qf[ks] = *(const GAS bf16x8*)(qp + 32 * ks);
    const int kco = 8 * (i >> 2) + (i & 3);
    const bf16* kp0 = proj + (tok0 + rs * GRID_W + cbase + kco) * PROJ_W + C_NK + h * HD + 8 * g;
    f32x4 s[8][2];
#pragma unroll
    for (int kr = 0; kr < 8; ++kr)
#pragma unroll
        for (int t = 0; t < 2; ++t) { f32x4 a = (f32x4){0.f, 0.f, 0.f, 0.f}; const bf16* kp = kp0 + (size_t)(kr * GRID_W + 4 * t) * PROJ_W;
#pragma unroll
            for (int ks = 0; ks < 4; ++ks) a = __builtin_amdgcn_mfma_f32_16x16x32_bf16(*(const GAS bf16x8*)(kp + 32 * ks), qf[ks], a, 0, 0, 0);
            s[kr][t] = a; }
    const LAS float* tb = tbl + h * (15 * 31);
    float m = -3.0e38f;
#pragma unroll
    for (int kr = 0; kr < 8; ++kr) { const int dr = rs + kr - r + WIN_R - 1;
#pragma unroll
        for (int t = 0; t < 2; ++t)
#pragma unroll
            for (int e = 0; e < 4; ++e) { const int kcol = cbase + 8 * g + 4 * t + e; const bool ok = (kcol >= cs) && (kcol < cs + WIN_C); const int dc = min(max(kcol - c + WIN_C - 1, 0), 30);
                const float v = ok ? s[kr][t][e] + tb[dr * 31 + dc] : -3.0e38f; s[kr][t][e] = v; m = fmaxf(m, v); } }
    m = fmaxf(m, __shfl_xor(m, 16)); m = fmaxf(m, __shfl_xor(m, 32));
    float l = 0.f; bf16x8 pf[8];
#pragma unroll
    for (int kr = 0; kr < 8; ++kr) { float p[8];
#pragma unroll
        for (int t = 0; t < 2; ++t)
#pragma unroll
            for (int e = 0; e < 4; ++e) { p[4 * t + e] = __builtin_amdgcn_exp2f((s[kr][t][e] - m) * 1.4426950408889634f); l += p[4 * t + e]; }
        v4u w; w.x = pg8::cvt_pk_bf16(p[0], p[1]); w.y = pg8::cvt_pk_bf16(p[2], p[3]); w.z = pg8::cvt_pk_bf16(p[4], p[5]); w.w = pg8::cvt_pk_bf16(p[6], p[7]);
        pf[kr] = __builtin_bit_cast(bf16x8, w); }
    l += __shfl_xor(l, 16); l += __shfl_xor(l, 32);
    const bf16* vp0 = vt + (size_t)(h * HD + i) * MROWS + tok0 + rs * GRID_W + cbase + 8 * g;
    f32x4 acc[8];
#pragma unroll
    for (int dt = 0; dt < 8; ++dt) acc[dt] = (f32x4){0.f, 0.f, 0.f, 0.f};
#pragma unroll
    for (int kr = 0; kr < 8; ++kr)
#pragma unroll
        for (int dt = 0; dt < 8; ++dt) acc[dt] = __builtin_amdgcn_mfma_f32_16x16x32_bf16(*(const GAS bf16x8*)(vp0 + (size_t)(16 * dt) * MROWS + kr * GRID_W), pf[kr], acc[dt], 0, 0, 0);
    const float inv = 1.0f / l;
    bf16* op = mix + (tok0 + r * GRID_W + c) * DM + HGW + h * HD + 4 * g;
#pragma unroll
    for (int dt = 0; dt < 8; ++dt) { v2u w; w.x = pg8::cvt_pk_bf16(acc[dt][0] * inv, acc[dt][1] * inv); w.y = pg8::cvt_pk_bf16(acc[dt][2] * inv, acc[dt][3] * inv); *(GAS v2u*)(op + 16 * dt) = w; }
}

__device__ __forceinline__ void hgrn_combine_row(const float* of, const float* ob, const bf16* gaterow, const float* hn, bf16* orow, int lane) {
    const GAS f32x4* a = (const GAS f32x4*)of + lane; const GAS f32x4* bq = (const GAS f32x4*)ob + lane; const GAS v2u* gr = (const GAS v2u*)gaterow + lane;
    const f32x4 hg = *((const GAS f32x4*)hn + (lane & 31));
    GAS v2u* o8 = (GAS v2u*)orow + lane;
#pragma unroll
    for (int j = 0; j < 8; ++j) {
        f32x4 v = a[64 * j] + bq[64 * j];
        float ss = (v.x * v.x + v.y * v.y) + (v.z * v.z + v.w * v.w);
#pragma unroll
        for (int o = 1; o < 32; o <<= 1) ss += __shfl_xor(ss, o);
        const float rs = 1.0f / sqrtf(ss * (1.0f / HD) + EPS);
        const v2u g = gr[64 * j];
        v2u w; w.x = pk2(v.x * rs * hg.x * bflo(g.x), v.y * rs * hg.y * bfhi(g.x)); w.y = pk2(v.z * rs * hg.z * bflo(g.y), v.w * rs * hg.w * bfhi(g.y));
        o8[64 * j] = w;
    }
}

struct Args { const float* in[18]; float* out; unsigned char* ws; int ph_lo, ph_hi; };
__global__ void __launch_bounds__(NWAVES * 64, 2) fwd_kernel(Args args) {
    extern __shared__ __attribute__((aligned(16))) unsigned char lds_raw[];
    LAS unsigned char* lds = (LAS unsigned char*)lds_raw;
    volatile LAS unsigned* MISC = (volatile LAS unsigned*)(lds + MISC_OFF);
    const int G = gridDim.x, bx = blockIdx.x;
    const int vcu = (G % 8 == 0) ? (bx % 8) * (G / 8) + bx / 8 : bx;
    gu32* ctl = (gu32*)(args.ws + WS_CTL);
    for (int u = threadIdx.x; u < (LDS_BYTES - LDSCTL_OFF) / 4; u += NWAVES * 64) ((LAS unsigned*)(lds + LDSCTL_OFF))[u] = 0u;
    __syncthreads();
    XcdBarrier bar; bar.bar = (unsigned*)(args.ws + WS_CTL) + CW_BAR; bar.x = 0; bar.st = nullptr;
#if !MK_PER_PHASE
    bar = xcd_barrier_post((unsigned*)(args.ws + WS_CTL) + CW_BAR, MISC + 8);
#endif
    const int lo = args.ph_lo, hi = args.ph_hi;
#define IN(k) (lo <= (k) && (k) < hi)
#define BOTH(k) (IN(k) && IN((k) + 1))
#if MK_PER_PHASE
#define GRID_BAR() do { if (threadIdx.x == 0) __hip_atomic_store(ctl + CW_TMO, 0xBADBA0u, RLX_AGENT); } while (0)
#else
#define GRID_BAR() xcd_barrier(bar)
#endif
#define WGU1 ((bf16*)(args.ws + WS_WGU1))
#define WGU2 ((bf16*)(args.ws + WS_WGU2))
#define WD1 ((bf16*)(args.ws + WS_WD1))
#define WD2 ((bf16*)(args.ws + WS_WD2))
#define WIN ((bf16*)(args.ws + WS_WIN))
#define WOUT ((bf16*)(args.ws + WS_WOUT))
#define R1 ((bf16*)(args.ws + WS_R1))
#define VT ((bf16*)(args.ws + WS_VT))
#define R2 ((float*)(args.ws + WS_R2))
#define R3 ((bf16*)(args.ws + WS_R3))
#define LB ((float*)(args.ws + WS_LB))
#define PHASE_IDS() int tid = threadIdx.x; asm volatile("" : "+v"(tid)); const int lane = tid & 63, wave = __builtin_amdgcn_readfirstlane(tid >> 6); \
    const int gw = vcu * NWAVES + wave, NGW = G * NWAVES; (void)lane; (void)gw; (void)NGW
#define PHASE_GATEUP(k, W) if (IN(k)) { _Pragma("unroll") for (int rr_ = 0; rr_ < NREP(k); ++rr_) { \
        pg8::Gemm g{R3, (W), MROWS, 2 * FF, DM}; pg8::StaticOrder S; S.init(MROWS, 2 * FF, G, bx); \
        pg8::EpiSwiGLU E{R1, FF}; \
        pg8::gemm_phase<pg8::EpiSwiGLU, pg8::StaticOrder, true, true>(lds + RING_OFF, g, S, E); } \
        if (BOTH(k)) GRID_BAR(); }
#define PHASE_DOWN(k, W) if (IN(k)) { _Pragma("unroll") for (int rr_ = 0; rr_ < NREP(k); ++rr_) { \
        pg8::Gemm g{R1, (W), MROWS, DM, FF}; pg8::StaticOrder S; S.init(MROWS, DM, G, bx); \
        pg8::EpiF32 E{R2, DM}; \
        pg8::gemm_phase<pg8::EpiF32, pg8::StaticOrder, true, true>(lds + RING_OFF, g, S, E); } \
        if (BOTH(k)) GRID_BAR(); }
#define PHASE_NORM(k, BASE, WGT, GPOST, G2, HASU) if (IN(k)) { PHASE_IDS(); \
        _Pragma("unroll") for (int rr_ = 0; rr_ < NREP(k); ++rr_) for (int m = gw; m < MROWS; m += NGW) \
            norm_res_row(R2 + (size_t)m * DM, (BASE) + (size_t)m * DM, args.out + (size_t)m * DM, (WGT), (GPOST), (G2), (HASU) ? R3 + (size_t)m * DM : (bf16*)nullptr, lane); \
        if (BOTH(k)) GRID_BAR(); }

    if (IN(0)) { PHASE_IDS();
        LAS float* scr = (LAS float*)(lds + RING_OFF + wave * 16384);
        constexpr int I_GU = (DM / 64) * (FF / 32), I_D = (FF / 64) * (DM / 32), I_IN = (DM / 64) * (16384 / 32), I_OUT = (DM / 64) * (DM / 32);
        constexpr int NITEMS = 6 * I_GU + I_IN + I_OUT;
        static_assert(I_GU == I_D, "items");
        for (int rr_ = 0; rr_ < NREP(0); ++rr_)
        for (int it = gw; it < NITEMS; it += NGW) {
            int r = it; const float* W; bf16* WT; int K = DM, N = FF, mode = 0;
            if (r < I_GU) { W = args.in[2]; WT = WGU1; mode = 1; }
            else if ((r -= I_GU) < I_GU) { W = args.in[3]; WT = WGU1; mode = 2; }
            else if ((r -= I_GU) < I_D) { W = args.in[4]; WT = WD1; K = FF; N = DM; }
            else if ((r -= I_D) < I_IN) { W = args.in[7]; WT = WIN; N = 16384; }
            else if ((r -= I_IN) < I_OUT) { W = args.in[11]; WT = WOUT; N = DM; }
            else if ((r -= I_OUT) < I_GU) { W = args.in[14]; WT = WGU2; mode = 1; }
            else if ((r -= I_GU) < I_GU) { W = args.in[15]; WT = WGU2; mode = 2; }
            else { r -= I_GU; W = args.in[16]; WT = WD2; K = FF; N = DM; }
            transpose_item(W, K, N, WT, mode, scr, r, lane);
        }
        for (int m = gw; m < MROWS; m += NGW) rms_row_to_bf16(args.in[0] + (size_t)m * DM, args.in[1], R3 + (size_t)m * DM, lane);
        for (int i = bx * 512 + tid; i < 2 * HGW; i += G * 512) { const float l0 = args.in[8][i], l1 = args.in[8][2 * HGW + i]; LB[i] = 1.0f / (1.0f + expf(l1 - l0)); }
        if (BOTH(0)) GRID_BAR();
    }
    PHASE_GATEUP(1, WGU1)
    PHASE_DOWN(2, WD1)
    PHASE_NORM(3, args.in[0], 0.5f, args.in[5], args.in[6], true)
    if (IN(4)) {
#pragma unroll
        for (int rr_ = 0; rr_ < NREP(4); ++rr_) {
        { pg8::Gemm g{R3, WIN, MROWS, PROJ_W, DM}; pg8::StaticOrder S; S.init(MROWS, PROJ_W, G, bx);
          pg8::EpiProj E{R1, PROJ_W, LB};
          pg8::gemm_phase<pg8::EpiProj, pg8::StaticOrder, true, true>(lds + RING_OFF, g, S, E); }
        { pg8::Gemm g{WIN + (size_t)PROJ_W * DM, R3, NAW, MROWS, DM}; pg8::StaticOrder S; S.init(NAW, MROWS, G, bx);
          pg8::EpiBf16Plain E{VT, MROWS};
          pg8::gemm_phase<pg8::EpiBf16Plain, pg8::StaticOrder, true, true>(lds + RING_OFF, g, S, E); }
        }
        if (BOTH(4)) GRID_BAR();
    }
    if (IN(5)) { PHASE_IDS();
        for (int rr_ = 0; rr_ < NREP(5); ++rr_)
        if (bx < 2 * BATCH * NHEAD) { const int dir = bx & 1, h = (bx >> 1) & 15, b = bx >> 5;
            hgrn_scan_unit(lds + RING_OFF, R1, R2 + (size_t)dir * MROWS * HGW, b, h, dir, tid); }
        { LAS float* tbl = (LAS float*)(lds + RING_OFF);
          for (int q = tid; q < NHEAD * 15 * 31; q += 512) tbl[q] = args.in[10][q];
          __syncthreads();
          for (int rr_ = 0; rr_ < NREP(12); ++rr_)
          for (;;) {
            if (tid == 0) MISC[16] = __hip_atomic_fetch_add(ctl + CW_QUEUE + 64 * rr_, 1u, RLX_AGENT);
            __syncthreads();
            const int wu = (int)MISC[16];
            __syncthreads();
            if (wu >= BATCH * NHEAD * (NROWS / 2)) break;
            const int rp = wu & 31, h = (wu >> 5) & 15, b = wu >> 9;
            na_unit_mfma(tbl, R1, VT, R3, b, h, rp, wave, lane);
          }
        }
        if (BOTH(5)) GRID_BAR();
    }
    if (IN(6)) { PHASE_IDS();
        for (int rr_ = 0; rr_ < NREP(6); ++rr_)
        for (int m = gw; m < MROWS; m += NGW)
            hgrn_combine_row(R2 + (size_t)m * HGW, R2 + (size_t)MROWS * HGW + (size_t)m * HGW, R1 + (size_t)m * PROJ_W + C_GATE, args.in[9], R3 + (size_t)m * DM, lane);
        if (BOTH(6)) GRID_BAR();
    }
    if (IN(7)) {
#pragma unroll
        for (int rr_ = 0; rr_ < NREP(7); ++rr_) {
        pg8::Gemm g{R3, WOUT, MROWS, DM, DM}; pg8::StaticOrder S; S.init(MROWS, DM, G, bx);
        pg8::EpiF32 E{R2, DM};
        pg8::gemm_phase<pg8::EpiF32, pg8::StaticOrder, true, true>(lds + RING_OFF, g, S, E); }
        if (BOTH(7)) GRID_BAR();
    }
    PHASE_NORM(8, args.out, 1.0f, args.in[12], args.in[13], true)
    PHASE_GATEUP(9, WGU2)
    PHASE_DOWN(10, WD2)
    PHASE_NORM(11, args.out, 0.5f, args.in[17], args.in[17], false)
#if !MK_PER_PHASE
    if (IN(11)) { if (xb_ld((unsigned*)(args.ws + WS_CTL) + CW_BAR + XB_TMO) != 0u) { const float q = __builtin_nanf(""); for (int m = bx; m < MROWS; m += G) for (int c = threadIdx.x; c < DM; c += 512) args.out[(size_t)m * DM + c] = q; } }
#endif
#undef IN
#undef BOTH
}

extern "C" void kernel_launch(void* const* d_in, const int* in_sizes, int n_in, void* d_out, int out_size, void* d_ws, size_t ws_size, hipStream_t stream) {
    static int grid = 0;
    if (grid == 0) {
        if (n_in != 18 || in_sizes[0] != MROWS * DM || out_size != MROWS * DM || ws_size < WS_END) {
            fprintf(stderr, "kernel_launch: unexpected shapes (n_in %d, in0 %d, out %d, ws %zu need %zu); nothing launched\n", n_in, n_in > 0 ? in_sizes[0] : -1, out_size, ws_size, (size_t)WS_END); grid = -1; return; }
        int dev = 0, cus = 0;
        if (hipGetDevice(&dev) != hipSuccess || hipDeviceGetAttribute(&cus, hipDeviceAttributeMultiprocessorCount, dev) != hipSuccess) { grid = -1; return; }
        if (hipFuncSetAttribute((const void*)fwd_kernel, hipFuncAttributeMaxDynamicSharedMemorySize, LDS_BYTES) != hipSuccess) { fprintf(stderr, "kernel_launch: hipFuncSetAttribute failed\n"); grid = -1; return; }
        int per_cu = 0;
        if (hipOccupancyMaxActiveBlocksPerMultiprocessor(&per_cu, (const void*)fwd_kernel, NWAVES * 64, LDS_BYTES) != hipSuccess || per_cu < 1)
            fprintf(stderr, "kernel_launch: note: occupancy query reports %d workgroups per CU\n", per_cu);
        (void)hipGetLastError();
        grid = cus;
    }
    if (grid < 0) return;
    if (hipMemsetAsync((char*)d_ws + WS_CTL, 0, CTL_ZERO_BYTES, stream) != hipSuccess) { fprintf(stderr, "kernel_launch: memset failed\n"); return; }
    Args a{};
    for (int i = 0; i < 18; ++i) a.in[i] = (const float*)d_in[i];
    a.out = (float*)d_out; a.ws = (unsigned char*)d_ws;
#if MK_PER_PHASE
    for (int p = 0; p < N_PHASES; ++p) { a.ph_lo = p; a.ph_hi = p + 1; hipLaunchKernelGGL(fwd_kernel, dim3(grid), dim3(NWAVES * 64), LDS_BYTES, stream, a); }
#else
    a.ph_lo = 0; a.ph_hi = N_PHASES;
    hipLaunchKernelGGL(fwd_kernel, dim3(grid), dim3(NWAVES * 64), LDS_BYTES, stream, a);
#endif
    const hipError_t le = hipPeekAtLastError();
    if (le != hipSuccess) fprintf(stderr, "kernel_launch: launch failed: %s\n", hipGetErrorName(le));
}
```

```cpp
#include <hip/hip_runtime.h>
#include <cstdio>
#include <cstdint>

#ifndef REPEAT_MASK
#define REPEAT_MASK 0
#endif
#define NREP(k) (1 + ((REPEAT_MASK >> (k)) & 1))
#ifndef MK_PER_PHASE
#define MK_PER_PHASE 0
#endif

namespace pg8 {
#define PG8_LAS __attribute__((address_space(3)))
typedef unsigned short bf16_t;
typedef short bf16x8 __attribute__((ext_vector_type(8)));
typedef float f32x4 __attribute__((ext_vector_type(4)));
typedef unsigned u32x4 __attribute__((ext_vector_type(4)));
constexpr int BM = 256, BK = 64, HALF = 128, HTB = HALF * BK * 2  , STAGE_BYTES = 8 * HTB, NXCD = 8, WGM = 8;

__host__ __device__ __forceinline__ int lds_byte(int r, int c) { const int st = (r >> 4) * 2 + (c >> 5), rr = r & 15, cc = c & 31, ob = rr * 64 + cc * 2; return st * 1024 + (ob ^ (((ob >> 9) & 1) << 5)); }
__host__ __device__ __forceinline__ void stage_rc(int b, int& R, int& C) { const int st = b / 1024, sb = b % 1024, swz = sb ^ (((sb >> 9) & 1) << 5); R = (st >> 1) * 16 + swz / 64; C = (st & 1) * 32 + (swz % 64) / 2; }
__host__ __device__ __forceinline__ int perm32(int rho) { const int n = rho >> 4, i = rho & 15; return 8 * (i >> 2) + 4 * n + (i & 3); }

struct Unit { int pm, pn; };
struct Gemm { const bf16_t* A; const bf16_t* Bt; int M, N, K; };

struct StaticOrder {
    int nM, nN, nwg, G, c;
    __host__ __device__ void init(int M, int N, int G_, int c_) { nM = M / BM; nN = N / BM; nwg = nM * nN; G = G_; c = c_; }
    __host__ __device__ bool next(int i, Unit& u) const {
        const long L = (long)i * G + c; if (L >= nwg) return false;
        int wgid = (int)L; { const int q = nwg / NXCD, r = nwg % NXCD, xcd = wgid % NXCD, off = wgid / NXCD; wgid = (xcd < r ? xcd * (q + 1) : r * (q + 1) + (xcd - r) * q) + off; }
        const int nig = WGM * nN, gid = wgid / nig, fm = gid * WGM, gsz = (nM - fm) < WGM ? (nM - fm) : WGM;
        u.pm = fm + ((wgid % nig) % gsz); u.pn = (wgid % nig) / gsz; return true;
    }
    __device__ __forceinline__ void a_ready(const Unit&) const {}
    __device__ __forceinline__ void done(const Unit&) const {}
};

__device__ __forceinline__ unsigned cvt_pk_bf16(float lo, float hi) { unsigned r; asm volatile("v_cvt_pk_bf16_f32 %0, %1, %2" : "=v"(r) : "v"(lo), "v"(hi)); return r; }
__device__ __forceinline__ unsigned cvt_pk_f16(float lo, float hi) { typedef _Float16 h2 __attribute__((ext_vector_type(2))); h2 v; v.x = (_Float16)lo; v.y = (_Float16)hi; return __builtin_bit_cast(unsigned, v); }
__device__ __forceinline__ float sigmoidf_fast(float v) { return __builtin_amdgcn_rcpf(1.0f + __builtin_amdgcn_exp2f(-1.4426950408889634f * v)); }

struct EpiF32 {
    static constexpr bool PERM = false, AFTER_DRAIN = false;
    float* C; int ldc;
    __device__ __forceinline__ void operator()(const f32x4 (&acc)[2][2][4][2], const Unit& u, int wr, int wc, int fr, int fq) const {
        const int row0 = u.pm * BM + wr * 64 + fr, col0 = u.pn * BM + wc * 32 + 4 * fq;
#pragma unroll
        for (int ai = 0; ai < 2; ++ai)
#pragma unroll
            for (int m = 0; m < 4; ++m) { float* rowp = C + (size_t)(row0 + ai * HALF + m * 16) * ldc + col0;
#pragma unroll
                for (int bj = 0; bj < 2; ++bj)
#pragma unroll
                    for (int n = 0; n < 2; ++n) *(f32x4*)(rowp + bj * HALF + n * 16) = acc[ai][bj][m][n]; }
    }
};
struct EpiBf16Plain {
    static constexpr bool PERM = true, AFTER_DRAIN = false;
    bf16_t* O; int ldc;
    __device__ __forceinline__ void operator()(const f32x4 (&acc)[2][2][4][2], const Unit& u, int wr, int wc, int fr, int fq) const {
        const int row0 = u.pm * BM + wr * 64 + fr, col0 = u.pn * BM + wc * 32 + 8 * fq;
#pragma unroll
        for (int ai = 0; ai < 2; ++ai)
#pragma unroll
            for (int m = 0; m < 4; ++m) { bf16_t* rowp = O + (size_t)(row0 + ai * HALF + m * 16) * ldc + col0;
#pragma unroll
                for (int bj = 0; bj < 2; ++bj) { const f32x4 v0 = acc[ai][bj][m][0], v1 = acc[ai][bj][m][1];
                    u32x4 w; w.x = cvt_pk_bf16(v0[0], v0[1]); w.y = cvt_pk_bf16(v0[2], v0[3]); w.z = cvt_pk_bf16(v1[0], v1[1]); w.w = cvt_pk_bf16(v1[2], v1[3]);
                    *(u32x4*)(rowp + bj * HALF) = w; } }
    }
};
struct EpiSwiGLU {
    static constexpr bool PERM = true, AFTER_DRAIN = false;
    bf16_t* H; int ldc;
    __device__ __forceinline__ void operator()(const f32x4 (&acc)[2][2][4][2], const Unit& u, int wr, int wc, int fr, int fq) const {
        const int row0 = u.pm * BM + wr * 64 + fr, col0 = u.pn * HALF + wc * 32 + 8 * fq;
#pragma unroll
        for (int ai = 0; ai < 2; ++ai)
#pragma unroll
            for (int m = 0; m < 4; ++m) { bf16_t* rowp = H + (size_t)(row0 + ai * HALF + m * 16) * ldc + col0;
                float h[8];
#pragma unroll
                for (int n = 0; n < 2; ++n)
#pragma unroll
                    for (int e = 0; e < 4; ++e) { const float g = acc[ai][0][m][n][e], up = acc[ai][1][m][n][e]; h[4 * n + e] = g * sigmoidf_fast(g) * up; }
                u32x4 w; w.x = cvt_pk_bf16(h[0], h[1]); w.y = cvt_pk_bf16(h[2], h[3]); w.z = cvt_pk_bf16(h[4], h[5]); w.w = cvt_pk_bf16(h[6], h[7]);
                *(u32x4*)rowp = w; }
    }
};
struct EpiProj {
    static constexpr bool PERM = true, AFTER_DRAIN = false;
    bf16_t* P; int ldc; const float* lb;
    __device__ __forceinline__ void operator()(const f32x4 (&acc)[2][2][4][2], const Unit& u, int wr, int wc, int fr, int fq) const {
        const int sec = u.pn >> 3;
        const int row0 = u.pm * BM + wr * 64 + fr, col0 = u.pn * BM + wc * 32 + 8 * fq;
        const bool isg = (sec == 1 || sec == 2), act = (sec == 0 || sec == 3); const float sc = (sec == 4) ? 0.08838834764831845f : 1.0f;
        const float* lbp = lb + (isg ? (col0 - 2048) : 0);
#pragma unroll
        for (int ai = 0; ai < 2; ++ai)
#pragma unroll
            for (int m = 0; m < 4; ++m) { bf16_t* rowp = P + (size_t)(row0 + ai * HALF + m * 16) * ldc + col0;
#pragma unroll
                for (int bj = 0; bj < 2; ++bj) { float g[8]; u32x4 w;
                    if (isg) {
                        const f32x4 la = *(const f32x4*)(lbp + bj * HALF), lc = *(const f32x4*)(lbp + bj * HALF + 4);
#pragma unroll
                        for (int e = 0; e < 4; ++e) { const float f0 = la[e] + (1.0f - la[e]) * sigmoidf_fast(acc[ai][bj][m][0][e]), f1 = lc[e] + (1.0f - lc[e]) * sigmoidf_fast(acc[ai][bj][m][1][e]);
                            g[e] = __builtin_amdgcn_logf(f0) * 0.6931471805599453f; g[4 + e] = __builtin_amdgcn_logf(f1) * 0.6931471805599453f; }
                        w.x = cvt_pk_f16(g[0], g[1]); w.y = cvt_pk_f16(g[2], g[3]); w.z = cvt_pk_f16(g[4], g[5]); w.w = cvt_pk_f16(g[6], g[7]);
                    } else {
#pragma unroll
                        for (int n = 0; n < 2; ++n)
#pragma unroll
                            for (int e = 0; e < 4; ++e) { const float v = acc[ai][bj][m][n][e]; g[4 * n + e] = act ? v * sigmoidf_fast(v) : v * sc; }
                        w.x = cvt_pk_bf16(g[0], g[1]); w.y = cvt_pk_bf16(g[2], g[3]); w.z = cvt_pk_bf16(g[4], g[5]); w.w = cvt_pk_bf16(g[6], g[7]);
                    }
                    *(u32x4*)(rowp + bj * HALF) = w; }
                asm volatile("" ::: "memory"); }
    }
};

template <class Epi, class Sched, bool ALIGN_EPI = false, bool SP2 = false>
__device__ __forceinline__ void gemm_phase(PG8_LAS unsigned char* lds, const Gemm g, const Sched& S, const Epi& E) {
    int tid_ = threadIdx.x; asm volatile("" : "+v"(tid_));
    const int tid = tid_, wid = __builtin_amdgcn_readfirstlane(tid >> 6), lane = tid & 63, wr = wid >> 2, wc = wid & 3, fr = lane & 15, fq = lane >> 4;
    const int K = g.K, nt = K / BK;
    unsigned voffA[2], voffB[2];
#pragma unroll
    for (int i = 0; i < 2; ++i) { int R, C; stage_rc(tid * 16 + i * 8192, R, C); const int Rb = Epi::PERM ? ((R & ~31) + perm32(R & 31)) : R;
        voffA[i] = (unsigned)(R * K + C) * 2u; voffB[i] = (unsigned)(Rb * K + C) * 2u; }
    const size_t kstep = (size_t)(BK * 2);
    const size_t hstep = (size_t)HALF * K * 2;
    const size_t tstep = 2 * hstep;
    const unsigned ldsw = (unsigned)wid * 1024u;
    const int aoff = lds_byte(wr * 64 + fr, fq * 8), boff = lds_byte(wc * 32 + fr, fq * 8);
#define PG8_SA(b, h) (((b) * 2 + (h)) * HTB)
#define PG8_SB(b, h) ((4 + (b) * 2 + (h)) * HTB)
#define PG8_STAGE(bufoff, gbase, voff) do { _Pragma("unroll") for (int _i = 0; _i < 2; ++_i) \
        __builtin_amdgcn_global_load_lds((const unsigned*)((const char*)(gbase) + (voff)[_i]), (PG8_LAS unsigned*)(lds + (bufoff) + ldsw + _i * 8192), 16, 0, 0); } while (0)
#define PG8_LDA(dst, b, h) do { _Pragma("unroll") for (int m = 0; m < 4; ++m) _Pragma("unroll") for (int k = 0; k < 2; ++k) dst[m][k] = *(const PG8_LAS bf16x8*)(lds + PG8_SA(b, h) + aoff + m * 2048 + k * 1024); } while (0)
#define PG8_LDB(dst, b, h) do { _Pragma("unroll") for (int n = 0; n < 2; ++n) _Pragma("unroll") for (int k = 0; k < 2; ++k) dst[n][k] = *(const PG8_LAS bf16x8*)(lds + PG8_SB(b, h) + boff + n * 2048 + k * 1024); } while (0)
#define PG8_MMA(ai, bj, At, Bt) do { __builtin_amdgcn_s_setprio(1); _Pragma("unroll") for (int m = 0; m < 4; ++m) _Pragma("unroll") for (int n = 0; n < 2; ++n) _Pragma("unroll") for (int k = 0; k < 2; ++k) \
        acc[ai][bj][m][n] = __builtin_amdgcn_mfma_f32_16x16x32_bf16(Bt[n][k], At[m][k], acc[ai][bj][m][n], 0, 0, 0); __builtin_amdgcn_s_setprio(0); } while (0)
#define PG8_WAIT_V(n) asm volatile("s_waitcnt vmcnt(" #n ")" ::: "memory")
#define PG8_WAIT_L(n) asm volatile("s_waitcnt lgkmcnt(" #n ")" ::: "memory")
#define PG8_BAR __builtin_amdgcn_s_barrier()
#define PG8_SCHED __builtin_amdgcn_sched_barrier(0)
    Unit cur, nxt; int ui = 0;
    if (!S.next(0, cur)) return;
    f32x4 acc[2][2][4][2];
#pragma unroll
    for (int a = 0; a < 2; ++a)
#pragma unroll
        for (int b = 0; b < 2; ++b)
#pragma unroll
            for (int m = 0; m < 4; ++m)
#pragma unroll
                for (int n = 0; n < 2; ++n) acc[a][b][m][n] = (f32x4){0.f, 0.f, 0.f, 0.f};
    bf16x8 At[4][2], B0[2][2], B1[2][2];
    const char* cA = (const char*)g.A + (size_t)cur.pm * tstep; const char* cB = (const char*)g.Bt + (size_t)cur.pn * tstep;
    S.a_ready(cur);
    if constexpr (SP2) {
        PG8_STAGE(PG8_SB(0, 0), cB, voffB); PG8_STAGE(PG8_SB(0, 1), cB + hstep, voffB); PG8_STAGE(PG8_SA(0, 0), cA, voffA); PG8_STAGE(PG8_SA(0, 1), cA + hstep, voffA);
        if (wr == 1) PG8_BAR;
        PG8_WAIT_V(2); PG8_BAR;
        PG8_STAGE(PG8_SB(1, 0), cB + kstep, voffB); PG8_STAGE(PG8_SA(1, 0), cA + kstep, voffA); PG8_STAGE(PG8_SB(1, 1), cB + hstep + kstep, voffB);
        PG8_WAIT_V(6); PG8_BAR;
    } else {
        PG8_STAGE(PG8_SB(0, 0), cB, voffB); PG8_STAGE(PG8_SA(0, 0), cA, voffA); PG8_STAGE(PG8_SB(0, 1), cB + hstep, voffB); PG8_STAGE(PG8_SA(0, 1), cA + hstep, voffA);
        if (wr == 1) PG8_BAR;
        PG8_WAIT_V(4); PG8_BAR;
        PG8_STAGE(PG8_SB(1, 0), cB + kstep, voffB); PG8_STAGE(PG8_SA(1, 0), cA + kstep, voffA); PG8_STAGE(PG8_SB(1, 1), cB + hstep + kstep, voffB);
        PG8_WAIT_V(6); PG8_BAR;
    }
    for (;;) {
        const bool has_next = S.next(ui + 1, nxt);
        const char* nA = has_next ? (const char*)g.A + (size_t)nxt.pm * tstep : cA; const char* nB = has_next ? (const char*)g.Bt + (size_t)nxt.pn * tstep : cB;
        for (int t = 0; t < nt; t += 2) {
            const bool last = (t == nt - 2);
            const char* a1 = cA + (size_t)(t + 1) * kstep;
            const char* a2 = last ? nA : cA + (size_t)(t + 2) * kstep; const char* b2 = last ? nB : cB + (size_t)(t + 2) * kstep;
            const char* a3 = a2 + kstep; const char* b3 = b2 + kstep;
            if (last && has_next) S.a_ready(nxt);
            if constexpr (SP2) {
            PG8_LDB(B0, 0, 0); PG8_LDB(B1, 0, 1); PG8_SCHED; PG8_LDA(At, 0, 0); PG8_STAGE(PG8_SA(1, 1), a1 + hstep, voffA);
            PG8_WAIT_V(8); PG8_WAIT_L(0); PG8_BAR; PG8_MMA(0, 0, At, B0); PG8_MMA(0, 1, At, B1); PG8_BAR; PG8_SCHED;
            PG8_LDA(At, 0, 1); PG8_STAGE(PG8_SB(0, 0), b2, voffB); PG8_STAGE(PG8_SB(0, 1), b2 + hstep, voffB); PG8_STAGE(PG8_SA(0, 0), a2, voffA);
            PG8_WAIT_V(8); PG8_WAIT_L(0); PG8_BAR; PG8_MMA(1, 0, At, B0); PG8_MMA(1, 1, At, B1); PG8_BAR; PG8_SCHED;
            PG8_LDB(B0, 1, 0); PG8_LDB(B1, 1, 1); PG8_SCHED; PG8_LDA(At, 1, 0); PG8_STAGE(PG8_SA(0, 1), a2 + hstep, voffA);
            PG8_WAIT_V(8); PG8_WAIT_L(0); PG8_BAR; PG8_MMA(0, 0, At, B0); PG8_MMA(0, 1, At, B1); PG8_BAR; PG8_SCHED;
            PG8_LDA(At, 1, 1); PG8_STAGE(PG8_SB(1, 0), b3, voffB); PG8_STAGE(PG8_SB(1, 1), b3 + hstep, voffB); PG8_STAGE(PG8_SA(1, 0), a3, voffA);
            PG8_WAIT_V(8); PG8_WAIT_L(0); PG8_BAR; PG8_MMA(1, 0, At, B0); PG8_MMA(1, 1, At, B1); PG8_BAR; PG8_SCHED;
            } else {
            PG8_LDB(B0, 0, 0); PG8_SCHED; PG8_LDA(At, 0, 0); PG8_STAGE(PG8_SA(1, 1), a1 + hstep, voffA);
            PG8_WAIT_L(8); PG8_BAR; PG8_WAIT_L(0); PG8_MMA(0, 0, At, B0); PG8_BAR; PG8_SCHED;
            PG8_LDB(B1, 0, 1); PG8_STAGE(PG8_SB(0, 0), b2, voffB);
            PG8_BAR; PG8_WAIT_L(0); PG8_MMA(0, 1, At, B1); PG8_BAR;
            PG8_LDA(At, 0, 1); PG8_STAGE(PG8_SA(0, 0), a2, voffA);
            PG8_BAR; PG8_WAIT_L(0); PG8_MMA(1, 0, At, B0); PG8_BAR; PG8_SCHED;
            PG8_STAGE(PG8_SB(0, 1), b2 + hstep, voffB);
            PG8_WAIT_V(6); PG8_BAR; PG8_MMA(1, 1, At, B1); PG8_BAR;
            PG8_LDB(B0, 1, 0); PG8_SCHED; PG8_LDA(At, 1, 0); PG8_STAGE(PG8_SA(0, 1), a2 + hstep, voffA);
            PG8_WAIT_L(8); PG8_BAR; PG8_WAIT_L(0); PG8_MMA(0, 0, At, B0); PG8_BAR; PG8_SCHED;
            PG8_LDB(B1, 1, 1); PG8_STAGE(PG8_SB(1, 0), b3, voffB);
            PG8_BAR; PG8_WAIT_L(0); PG8_MMA(0, 1, At, B1); PG8_BAR;
            PG8_LDA(At, 1, 1); PG8_STAGE(PG8_SA(1, 0), a3, voffA);
            PG8_BAR; PG8_WAIT_L(0); PG8_MMA(1, 0, At, B0); PG8_BAR; PG8_SCHED;
            PG8_STAGE(PG8_SB(1, 1), b3 + hstep, voffB);
            PG8_WAIT_V(6); PG8_BAR; PG8_MMA(1, 1, At, B1); PG8_BAR;
            }
        }
        if constexpr (ALIGN_EPI) { if (wr == 0) PG8_BAR; }
        if constexpr (!Epi::AFTER_DRAIN) { E(acc, cur, wr, wc, fr, fq); S.done(cur); }
        if (!has_next) break;
#pragma unroll
        for (int a = 0; a < 2; ++a)
#pragma unroll
            for (int b = 0; b < 2; ++b)
#pragma unroll
                for (int m = 0; m < 4; ++m)
#pragma unroll
                    for (int n = 0; n < 2; ++n) acc[a][b][m][n] = (f32x4){0.f, 0.f, 0.f, 0.f};
        cur = nxt; cA = nA; cB = nB; ++ui;
        if constexpr (ALIGN_EPI) { if (wr == 1) PG8_BAR; }
    }
    PG8_WAIT_V(0);
    if constexpr (!ALIGN_EPI) { if (wr == 0) PG8_BAR; }
    PG8_BAR;
#undef PG8_SA
#undef PG8_SB
#undef PG8_STAGE
#undef PG8_LDA
#undef PG8_LDB
#undef PG8_MMA
#undef PG8_WAIT_V
#undef PG8_WAIT_L
#undef PG8_BAR
#undef PG8_SCHED
}
}

constexpr int NWAVES = 8;
constexpr int DM = 4096, BATCH = 4, SEQ = 4096, MROWS = BATCH * SEQ;
constexpr int FF = 11008, HGW = 2048, NAW = 2048, HD = 128, NHEAD = 16;
constexpr int PROJ_W = 12288;
constexpr int C_Q = 0, C_GF = 2048, C_GB = 4096, C_GATE = 6144, C_NQ = 8192, C_NK = 10240;
constexpr int GRID_W = 64, NROWS = 64, WIN_R = 8, WIN_C = 16;
constexpr float EPS = 1e-6f;
constexpr int N_PHASES = 12;

constexpr size_t MiB = 1u << 20;
constexpr size_t WS_CTL = 0, CTL_ZERO_BYTES = 1 * MiB;
constexpr size_t WS_LB = 1 * MiB;
constexpr size_t WS_WGU1 = 2 * MiB, WS_WD1 = 174 * MiB, WS_WIN = 260 * MiB, WS_WOUT = 388 * MiB, WS_WGU2 = 420 * MiB, WS_WD2 = 592 * MiB;
constexpr size_t WS_R1 = 678 * MiB;
constexpr size_t WS_TT = WS_R1 + 384 * MiB;
constexpr size_t WS_R2 = 1190 * MiB;
constexpr size_t WS_R3 = 1446 * MiB;
constexpr size_t WS_END = 1574 * MiB;
static_assert((size_t)2 * FF * DM * 2 <= 172 * MiB && (size_t)FF * DM * 2 <= 86 * MiB, "weights");
static_assert((size_t)MROWS * PROJ_W * 2 == 384 * MiB && (size_t)MROWS * FF * 2 <= 512 * MiB, "R1");
constexpr int CW_TMO = 0, CW_CODE = 1;
constexpr int CW_BAR = 4096;
constexpr int CW_QUEUE = 8192;

constexpr int RING_OFF = 0, RING_BYTES = 131072;
constexpr int LDSCTL_OFF = RING_BYTES, MISC_OFF = LDSCTL_OFF + 320;
constexpr int LDS_BYTES = 147456;

#define GAS __attribute__((address_space(1)))
#define LAS __attribute__((address_space(3)))
typedef unsigned short bf16;
typedef unsigned v4u __attribute__((ext_vector_type(4)));
typedef unsigned v2u __attribute__((ext_vector_type(2)));
typedef float f32x4 __attribute__((ext_vector_type(4)));
typedef GAS unsigned gu32;
#define RLX_AGENT __ATOMIC_RELAXED, __HIP_MEMORY_SCOPE_AGENT
#define LDS_WAIT() asm volatile("s_waitcnt lgkmcnt(0)" ::: "memory")
#define VM_WAIT() asm volatile("s_waitcnt vmcnt(0)" ::: "memory")
__device__ __forceinline__ unsigned f2bf(float f) { unsigned u = __builtin_bit_cast(unsigned, f); return (u + 0x7fffu + ((u >> 16) & 1u)) >> 16; }
__device__ __forceinline__ unsigned pk2(float lo, float hi) { return f2bf(lo) | (f2bf(hi) << 16); }
__device__ __forceinline__ float bf2f(unsigned short b) { return __builtin_bit_cast(float, (unsigned)b << 16); }
__device__ __forceinline__ float bflo(unsigned w) { return __builtin_bit_cast(float, w << 16); }
__device__ __forceinline__ float bfhi(unsigned w) { return __builtin_bit_cast(float, w & 0xffff0000u); }
__device__ __forceinline__ float h2f(unsigned short b) { return (float)__builtin_bit_cast(_Float16, b); }

#define XB_TMO      128
#define XB_XCNT(j)  (256  + 64 * (j))
#define XB_XSUB(j)  (1280 + 64 * (j))
#define XB_XGEN(j)  (2304 + 64 * (j))
#define XB_TOP      3328
#define XB_TOPGEN   3392
#define XCD_BAR_WORDS 3456
#define XB_SPIN_CAP (1u << 18)
__device__ __forceinline__ unsigned xb_ld(unsigned* p)              { return __hip_atomic_load(p, __ATOMIC_RELAXED, __HIP_MEMORY_SCOPE_AGENT); }
__device__ __forceinline__ unsigned xb_add(unsigned* p, unsigned v) { return __hip_atomic_fetch_add(p, v, __ATOMIC_RELAXED, __HIP_MEMORY_SCOPE_AGENT); }
__device__ __forceinline__ unsigned xb_xcc_id() { return (unsigned)__builtin_amdgcn_s_getreg((3 << 11) | 20) & 0xFu; }
#define XB_SPIN(cond, bar) do { unsigned _sp = 0; while (cond) { __builtin_amdgcn_s_sleep(1); \
    if ((++_sp & 255u) == 0u) { if (xb_ld(&(bar)[XB_TMO])) break; if (_sp > XB_SPIN_CAP) { atomicAdd(&(bar)[XB_TMO], 1u); break; } } } } while (0)
struct XcdBarrier { unsigned* bar; unsigned x; volatile LAS unsigned* st; };
__device__ __forceinline__ XcdBarrier xcd_barrier_post(unsigned* bar, volatile LAS unsigned* st) {
    XcdBarrier b; b.bar = bar; b.x = xb_xcc_id(); b.st = st;
    if (threadIdx.x == 0) (void)xb_add(&bar[XB_XCNT(b.x)], 1u);
    return b;
}
__device__ __forceinline__ void xcd_barrier_complete(unsigned* bar, unsigned x, unsigned& nloc, unsigned& nx) {
    const unsigned G = gridDim.x * gridDim.y * gridDim.z;
    unsigned sum, cnt, mine, sp = 0u;
    for (;;) {
        sum = 0u; cnt = 0u; mine = 0u;
#pragma unroll
        for (unsigned j = 0; j < 16; ++j) { const unsigned c = xb_ld(&bar[XB_XCNT(j)]); sum += c; cnt += (c > 0u) ? 1u : 0u; mine = (j == x) ? c : mine; }
        if (sum == G) break;
        __builtin_amdgcn_s_sleep(1);
        if ((++sp & 255u) == 0u) { if (xb_ld(&bar[XB_TMO])) break; if (sp > XB_SPIN_CAP) { atomicAdd(&bar[XB_TMO], 1u); break; } }
    }
    nloc = mine > 0u ? mine : 1u; nx = cnt > 0u ? cnt : 1u;
}
__device__ __forceinline__ void xcd_barrier(const XcdBarrier& b) {
    asm volatile("s_waitcnt vmcnt(0)" ::: "memory");
    __syncthreads();
    if (threadIdx.x == 0) {
        unsigned* bar = b.bar;
        __builtin_amdgcn_s_waitcnt(0);
        unsigned nloc = b.st[0], nx = b.st[1];
        if (nloc == 0u) { xcd_barrier_complete(bar, b.x, nloc, nx); b.st[0] = nloc; b.st[1] = nx; }
        const unsigned old = xb_add(&bar[XB_XSUB(b.x)], 1u);
        const unsigned gen = old / nloc;
        if (old + 1u == (gen + 1u) * nloc) {
            __builtin_amdgcn_fence(__ATOMIC_RELEASE, "agent");
            asm volatile("s_waitcnt vmcnt(0)" ::: "memory");
            const unsigned og = xb_add(&bar[XB_TOP], 1u);
            const unsigned tg = og / nx;
            if (og + 1u == (tg + 1u) * nx) xb_add(&bar[XB_TOPGEN], 1u);
            else XB_SPIN(xb_ld(&bar[XB_TOPGEN]) == tg, bar);
            __builtin_amdgcn_fence(__ATOMIC_ACQUIRE, "agent");
            xb_add(&bar[XB_XGEN(b.x)], 1u);
            asm volatile("s_waitcnt vmcnt(0)" ::: "memory");
        } else {
            XB_SPIN(xb_ld(&bar[XB_XGEN(b.x)]) == gen, bar);
            __builtin_amdgcn_fence(__ATOMIC_ACQUIRE, "agent");
            asm volatile("s_waitcnt vmcnt(0)" ::: "memory");
        }
    }
    __syncthreads();
}

__device__ __forceinline__ float wave_sum(float v) {
#pragma unroll
    for (int o = 1; o < 64; o <<= 1) v += __shfl_xor(v, o);
    return v;
}
__device__ __forceinline__ float wave_max(float v) {
#pragma unroll
    for (int o = 1; o < 64; o <<= 1) v = fmaxf(v, __shfl_xor(v, o));
    return v;
}
__device__ __forceinline__ void transpose_item(const float* W, int K, int N, bf16* WT, int mode, LAS float* scr, int item, int lane) {
    const int nblk = N / 32, kb = item / nblk, nb = item % nblk, k0 = 64 * kb, n0 = 32 * nb;
    const int rbase = (mode == 0) ? n0 : (mode == 3) ? (((0x75436210u >> (4 * (n0 >> 11))) & 7u) * 2048 + (n0 & 2047)) : (256 * (n0 >> 7) + (n0 & 127) + (mode == 2 ? 128 : 0));
#pragma unroll 8
    for (int i = 0; i < 32; ++i) { const int kk = 2 * i + (lane >> 5); scr[kk * 33 + (lane & 31)] = W[(size_t)(k0 + kk) * N + n0 + (lane & 31)]; }
    LDS_WAIT(); asm volatile("" ::: "memory");
    const int c = lane & 7;
#pragma unroll
    for (int j = 0; j < 4; ++j) { const int n = (lane >> 3) + 8 * j; const LAS float* s = scr + (8 * c) * 33 + n;
        v4u o; o.x = pk2(s[0 * 33], s[1 * 33]); o.y = pk2(s[2 * 33], s[3 * 33]); o.z = pk2(s[4 * 33], s[5 * 33]); o.w = pk2(s[6 * 33], s[7 * 33]);
        *(GAS v4u*)(WT + (size_t)(rbase + n) * K + k0 + 8 * c) = o; }
    LDS_WAIT(); asm volatile("" ::: "memory");
}
__device__ __forceinline__ void rms_row_to_bf16(const float* xrow, const float* gain, bf16* orow, int lane) {
    const GAS f32x4* xr = (const GAS f32x4*)xrow + lane; const GAS f32x4* gr = (const GAS f32x4*)gain + lane;
    f32x4 v[16]; float ss = 0.f;
#pragma unroll
    for (int j = 0; j < 16; ++j) { v[j] = xr[64 * j]; ss += (v[j].x * v[j].x + v[j].y * v[j].y) + (v[j].z * v[j].z + v[j].w * v[j].w); }
    const float rs = 1.0f / sqrtf(wave_sum(ss) * (1.0f / DM) + EPS);
    GAS v2u* o8 = (GAS v2u*)orow + lane;
#pragma unroll
    for (int j = 0; j < 16; ++j) { const f32x4 g = gr[64 * j]; v2u w; w.x = pk2(v[j].x * rs * g.x, v[j].y * rs * g.y); w.y = pk2(v[j].z * rs * g.z, v[j].w * rs * g.w); o8[64 * j] = w; }
}
__device__ __forceinline__ void norm_res_row(const float* ffrow, const float* baserow, float* hrow, float w, const float* gpost, const float* g2, bf16* urow, int lane) {
    const GAS f32x4* fr = (const GAS f32x4*)ffrow + lane; const GAS f32x4* br = (const GAS f32x4*)baserow + lane; const GAS f32x4* gp = (const GAS f32x4*)gpost + lane;
    f32x4 v[16]; float ss = 0.f;
#pragma unroll
    for (int j = 0; j < 16; ++j) { v[j] = fr[64 * j]; ss += (v[j].x * v[j].x + v[j].y * v[j].y) + (v[j].z * v[j].z + v[j].w * v[j].w); }
    const float rs = w / sqrtf(wave_sum(ss) * (1.0f / DM) + EPS);
    GAS f32x4* ho = (GAS f32x4*)hrow + lane; float s2 = 0.f;
#pragma unroll
    for (int j = 0; j < 16; ++j) { const f32x4 g = gp[64 * j]; const f32x4 b = br[64 * j]; v[j] = b + v[j] * rs * g; ho[64 * j] = v[j];
        s2 += (v[j].x * v[j].x + v[j].y * v[j].y) + (v[j].z * v[j].z + v[j].w * v[j].w); }
    if (urow) {
        const float r2 = 1.0f / sqrtf(wave_sum(s2) * (1.0f / DM) + EPS);
        const GAS f32x4* gq = (const GAS f32x4*)g2 + lane; GAS v2u* o8 = (GAS v2u*)urow + lane;
#pragma unroll
        for (int j = 0; j < 16; ++j) { const f32x4 g = gq[64 * j]; v2u o; o.x = pk2(v[j].x * r2 * g.x, v[j].y * r2 * g.y); o.y = pk2(v[j].z * r2 * g.z, v[j].w * r2 * g.w); o8[64 * j] = o; }
    }
}

constexpr int HG_QB = 0, HG_KT = 8704, HG_KTT = 17408, HG_SC = 27648, HG_EL = 30208, HG_QT = 30720;
typedef short bf16x8 __attribute__((ext_vector_type(8)));
typedef short bf16x4 __attribute__((ext_vector_type(4)));
__device__ __forceinline__ void hgrn_mfma_unit(LAS unsigned char* lds, const bf16* proj, const bf16* it, float* obuf, int b, int h, int dir, int tid) {
    const int lane = tid & 63, wave = __builtin_amdgcn_readfirstlane(tid >> 6), i16 = lane & 15, g = lane >> 4;
    const int k = tid & 127, qd = tid >> 7;
    const size_t rowbase = (size_t)b * SEQ;
    const int gcol = (dir ? C_GB : C_GF) + h * HD + k, qcol = C_Q + h * HD + k;
    f32x4 S[8];
#pragma unroll
    for (int kt = 0; kt < 8; ++kt) S[kt] = (f32x4){0.f, 0.f, 0.f, 0.f};
    LAS float* QT = (LAS float*)(lds + HG_QT); LAS float* EL = (LAS float*)(lds + HG_EL);
    const bf16* vbase = it + (size_t)(h * HD + 16 * wave + i16) * MROWS + rowbase + 8 * g;
    for (int cc = 0; cc < SEQ / 32; ++cc) {
        const int t0 = dir ? (SEQ - 32 * (cc + 1)) : 32 * cc;
        const bf16x8 vfrag = *(const GAS bf16x8*)(vbase + t0);
        float qv[8], gv[8];
        { const bf16* pr = proj + (rowbase + t0 + 8 * qd) * (size_t)PROJ_W;
#pragma unroll
          for (int j = 0; j < 8; ++j) { qv[j] = bf2f(pr[(size_t)j * PROJ_W + qcol]); gv[j] = h2f(pr[(size_t)j * PROJ_W + gcol]); } }
        float cs[8]; float tot = 0.f;
        if (dir == 0) {
#pragma unroll
            for (int j = 0; j < 8; ++j) { tot += gv[j]; cs[j] = tot; }
        } else {
#pragma unroll
            for (int j = 7; j >= 0; --j) { tot += gv[j]; cs[j] = tot; }
        }
        QT[qd * 128 + k] = tot;
        __syncthreads();
        { const float t0q = QT[k], t1q = QT[128 + k], t2q = QT[256 + k], t3q = QT[384 + k];
          float off;
          if (dir == 0) off = (qd > 0 ? t0q : 0.f) + (qd > 1 ? t1q : 0.f) + (qd > 2 ? t2q : 0.f);
          else          off = (qd < 3 ? t3q : 0.f) + (qd < 2 ? t2q : 0.f) + (qd < 1 ? t1q : 0.f);
          if (qd == 0) EL[k] = __expf((t0q + t1q) + (t2q + t3q));
          unsigned kt8[8];
#pragma unroll
          for (int j = 0; j < 8; ++j) { const float bb = cs[j] + off; const float kk = -expm1f(gv[j]);
              const float qb = qv[j] * __expf(bb), ktv = kk * __expf(fminf(-bb, 80.f));
              const unsigned short qh = (unsigned short)f2bf(qb), kh = (unsigned short)f2bf(ktv);
              *(LAS unsigned short*)(lds + HG_QB + (8 * qd + j) * 272 + 2 * k) = qh;
              *(LAS unsigned short*)(lds + HG_KT + (8 * qd + j) * 272 + 2 * k) = kh;
              kt8[j] = kh; }
          v4u w; w.x = kt8[0] | (kt8[1] << 16); w.y = kt8[2] | (kt8[3] << 16); w.z = kt8[4] | (kt8[5] << 16); w.w = kt8[6] | (kt8[7] << 16);
          *(LAS v4u*)(lds + HG_KTT + k * 80 + 16 * qd) = w; }
        __syncthreads();
        if (wave < 4) { const int ti = wave >> 1, ts = wave & 1; f32x4 a = (f32x4){0.f, 0.f, 0.f, 0.f};
#pragma unroll
            for (int ks = 0; ks < 4; ++ks) { const bf16x8 af = *(const LAS bf16x8*)(lds + HG_QB + (16 * ti + i16) * 272 + (32 * ks + 8 * g) * 2), bfr = *(const LAS bf16x8*)(lds + HG_KT + (16 * ts + i16) * 272 + (32 * ks + 8 * g) * 2);
                a = __builtin_amdgcn_mfma_f32_16x16x32_bf16(af, bfr, a, 0, 0, 0); }
            const int ss = 16 * ts + i16;
#pragma unroll
            for (int e = 0; e < 4; ++e) { const int si = 16 * ti + 4 * g + e; const bool keep = dir ? (ss >= si) : (ss <= si);
                *(LAS unsigned short*)(lds + HG_SC + si * 80 + 2 * ss) = (unsigned short)f2bf(keep ? a[e] : 0.f); } }
        __syncthreads();
        f32x4 o[2]; o[0] = (f32x4){0.f, 0.f, 0.f, 0.f}; o[1] = o[0];
#pragma unroll
        for (int s4 = 0; s4 < 4; ++s4) {
            v4u sw; sw.x = pg8::cvt_pk_bf16(S[2 * s4][0], S[2 * s4][1]); sw.y = pg8::cvt_pk_bf16(S[2 * s4][2], S[2 * s4][3]); sw.z = pg8::cvt_pk_bf16(S[2 * s4 + 1][0], S[2 * s4 + 1][1]); sw.w = pg8::cvt_pk_bf16(S[2 * s4 + 1][2], S[2 * s4 + 1][3]);
            const bf16x8 sb = __builtin_bit_cast(bf16x8, sw);
#pragma unroll
            for (int itl = 0; itl < 2; ++itl) { const LAS unsigned char* qr = lds + HG_QB + (16 * itl + i16) * 272 + (32 * s4 + 4 * g) * 2;
                const v2u lo = *(const LAS v2u*)qr, hi = *(const LAS v2u*)(qr + 32);
                v4u aw; aw.x = lo.x; aw.y = lo.y; aw.z = hi.x; aw.w = hi.y;
                o[itl] = __builtin_amdgcn_mfma_f32_16x16x32_bf16(__builtin_bit_cast(bf16x8, aw), sb, o[itl], 0, 0, 0); }
        }
#pragma unroll
        for (int itl = 0; itl < 2; ++itl) { const bf16x8 af = *(const LAS bf16x8*)(lds + HG_SC + (16 * itl + i16) * 80 + 16 * g);
            o[itl] = __builtin_amdgcn_mfma_f32_16x16x32_bf16(af, vfrag, o[itl], 0, 0, 0); }
#pragma unroll
        for (int itl = 0; itl < 2; ++itl)
#pragma unroll
            for (int e = 0; e < 4; ++e) obuf[(rowbase + t0 + 16 * itl + 4 * g + e) * (size_t)HGW + h * HD + 16 * wave + i16] = o[itl][e];
#pragma unroll
        for (int kt = 0; kt < 8; ++kt) { const bf16x8 af = *(const LAS bf16x8*)(lds + HG_KTT + (16 * kt + i16) * 80 + 16 * g);
            S[kt] = __builtin_amdgcn_mfma_f32_16x16x32_bf16(af, vfrag, S[kt], 0, 0, 0);
            const f32x4 el = *(const LAS f32x4*)(EL + 16 * kt + 4 * g);
            S[kt] = S[kt] * el; }
        __syncthreads();
    }
}

__device__ __forceinline__ void na_unit_mfma(const LAS float* tbl, const bf16* proj, const bf16* vt, bf16* mix, int b, int h, int rp, int wave, int lane) {
    const int r = 2 * rp + (wave >> 2), cb = wave & 3;
    const int cbase = (cb == 0) ? 0 : (cb == 1) ? 8 : (cb == 2) ? 24 : 32;
    const int rs = min(max(r - WIN_R / 2, 0), NROWS - WIN_R);
    const int i = lane & 15, g = lane >> 4;
    const int c = 16 * cb + i, cs = min(max(c - WIN_C / 2, 0), GRID_W - WIN_C);
    const size_t tok0 = (size_t)b * SEQ;
    const bf16* qp = proj + (tok0 + r * GRID_W + c) * PROJ_W + C_NQ + h * HD + 8 * g;
    bf16x8 qf[4];
#pragma unroll
    for (int ks = 0; ks < 4; ++ks) qf[ks] = *(const GAS bf16x8*)(qp + 32 * ks);
    const int kco = 8 * (i >> 2) + (i & 3);
    const bf16* kp0 = proj + (tok0 + rs * GRID_W + cbase + kco) * PROJ_W + C_NK + h * HD + 8 * g;
    f32x4 s[8][2];
#pragma unroll
    for (int kr = 0; kr < 8; ++kr)
#pragma unroll
        for (int t = 0; t < 2; ++t) { f32x4 a = (f32x4){0.f, 0.f, 0.f, 0.f}; const bf16* kp = kp0 + (size_t)(kr * GRID_W + 4 * t) * PROJ_W;
#pragma unroll
            for (int ks = 0; ks < 4; ++ks) a = __builtin_amdgcn_mfma_f32_16x16x32_bf16(*(const GAS bf16x8*)(kp + 32 * ks), qf[ks], a, 0, 0, 0);
            s[kr][t] = a; }
    const LAS float* tb = tbl + h * (15 * 31);
    float m = -3.0e38f;
#pragma unroll
    for (int kr = 0; kr < 8; ++kr) { const int dr = rs + kr - r + WIN_R - 1;
#pragma unroll
        for (int t = 0; t < 2; ++t)
#pragma unroll
            for (int e = 0; e < 4; ++e) { const int kcol = cbase + 8 * g + 4 * t + e; const bool ok = (kcol >= cs) && (kcol < cs + WIN_C); const int dc = min(max(kcol - c + WIN_C - 1, 0), 30);
                const float v = ok ? s[kr][t][e] + tb[dr * 31 + dc] : -3.0e38f; s[kr][t][e] = v; m = fmaxf(m, v); } }
    m = fmaxf(m, __shfl_xor(m, 16)); m = fmaxf(m, __shfl_xor(m, 32));
    float l = 0.f; bf16x8 pf[8];
#pragma unroll
    for (int kr = 0; kr < 8; ++kr) { float p[8];
#pragma unroll
        for (int t = 0; t < 2; ++t)
#pragma unroll
            for (int e = 0; e < 4; ++e) { p[4 * t + e] = __builtin_amdgcn_exp2f((s[kr][t][e] - m) * 1.4426950408889634f); l += p[4 * t + e]; }
        v4u w; w.x = pg8::cvt_pk_bf16(p[0], p[1]); w.y = pg8::cvt_pk_bf16(p[2], p[3]); w.z = pg8::cvt_pk_bf16(p[4], p[5]); w.w = pg8::cvt_pk_bf16(p[6], p[7]);
        pf[kr] = __builtin_bit_cast(bf16x8, w); }
    l += __shfl_xor(l, 16); l += __shfl_xor(l, 32);
    const bf16* vp0 = vt + (size_t)(h * HD + i) * MROWS + tok0 + rs * GRID_W + cbase + 8 * g;
    f32x4 acc[8];
#pragma unroll
    for (int dt = 0; dt < 8; ++dt) acc[dt] = (f32x4){0.f, 0.f, 0.f, 0.f};
#pragma unroll
    for (int kr = 0; kr < 8; ++kr)
#pragma unroll
        for (int dt = 0; dt < 8; ++dt) acc[dt] = __builtin_amdgcn_mfma_f32_16x16x32_bf16(*(const GAS bf16x8*)(vp0 + (size_t)(16 * dt) * MROWS + kr * GRID_W), pf[kr], acc[dt], 0, 0, 0);
    const float inv = 1.0f / l;
    bf16* op = mix + (tok0 + r * GRID_W + c) * DM + HGW + h * HD + 4 * g;
#pragma unroll
    for (int dt = 0; dt < 8; ++dt) { v2u w; w.x = pg8::cvt_pk_bf16(acc[dt][0] * inv, acc[dt][1] * inv); w.y = pg8::cvt_pk_bf16(acc[dt][2] * inv, acc[dt][3] * inv); *(GAS v2u*)(op + 16 * dt) = w; }
}

__device__ __forceinline__ void hgrn_combine_row(const float* of, const float* ob, const bf16* gaterow, const float* hn, bf16* orow, int lane) {
    const GAS f32x4* a = (const GAS f32x4*)of + lane; const GAS f32x4* bq = (const GAS f32x4*)ob + lane; const GAS v2u* gr = (const GAS v2u*)gaterow + lane;
    const f32x4 hg = *((const GAS f32x4*)hn + (lane & 31));
    GAS v2u* o8 = (GAS v2u*)orow + lane;
#pragma unroll
    for (int j = 0; j < 8; ++j) {
        f32x4 v = a[64 * j] + bq[64 * j];
        float ss = (v.x * v.x + v.y * v.y) + (v.z * v.z + v.w * v.w);
#pragma unroll
        for (int o = 1; o < 32; o <<= 1) ss += __shfl_xor(ss, o);
        const float rs = 1.0f / sqrtf(ss * (1.0f / HD) + EPS);
        const v2u g = gr[64 * j];
        v2u w; w.x = pk2(v.x * rs * hg.x * bflo(g.x), v.y * rs * hg.y * bfhi(g.x)); w.y = pk2(v.z * rs * hg.z * bflo(g.y), v.w * rs * hg.w * bfhi(g.y));
        o8[64 * j] = w;
    }
}

struct Args { const float* in[18]; float* out; unsigned char* ws; int ph_lo, ph_hi; };
__global__ void __launch_bounds__(NWAVES * 64, 2) fwd_kernel(Args args) {
    extern __shared__ __attribute__((aligned(16))) unsigned char lds_raw[];
    LAS unsigned char* lds = (LAS unsigned char*)lds_raw;
    volatile LAS unsigned* MISC = (volatile LAS unsigned*)(lds + MISC_OFF);
    const int G = gridDim.x, bx = blockIdx.x;
    const int vcu = (G % 8 == 0) ? (bx % 8) * (G / 8) + bx / 8 : bx;
    gu32* ctl = (gu32*)(args.ws + WS_CTL);
    for (int u = threadIdx.x; u < (LDS_BYTES - LDSCTL_OFF) / 4; u += NWAVES * 64) ((LAS unsigned*)(lds + LDSCTL_OFF))[u] = 0u;
    __syncthreads();
    XcdBarrier bar; bar.bar = (unsigned*)(args.ws + WS_CTL) + CW_BAR; bar.x = 0; bar.st = nullptr;
#if !MK_PER_PHASE
    bar = xcd_barrier_post((unsigned*)(args.ws + WS_CTL) + CW_BAR, MISC + 8);
#endif
    const int lo = args.ph_lo, hi = args.ph_hi;
#define IN(k) (lo <= (k) && (k) < hi)
#define BOTH(k) (IN(k) && IN((k) + 1))
#if MK_PER_PHASE
#define GRID_BAR() do { if (threadIdx.x == 0) __hip_atomic_store(ctl + CW_TMO, 0xBADBA0u, RLX_AGENT); } while (0)
#else
#define GRID_BAR() xcd_barrier(bar)
#endif
#define WGU1 ((bf16*)(args.ws + WS_WGU1))
#define WGU2 ((bf16*)(args.ws + WS_WGU2))
#define WD1 ((bf16*)(args.ws + WS_WD1))
#define WD2 ((bf16*)(args.ws + WS_WD2))
#define WIN ((bf16*)(args.ws + WS_WIN))
#define WOUT ((bf16*)(args.ws + WS_WOUT))
#define R1 ((bf16*)(args.ws + WS_R1))
#define IT ((bf16*)(args.ws + WS_TT))
#define VT ((bf16*)(args.ws + WS_TT) + (size_t)HGW * MROWS)
#define R2 ((float*)(args.ws + WS_R2))
#define R3 ((bf16*)(args.ws + WS_R3))
#define LB ((float*)(args.ws + WS_LB))
#define PHASE_IDS() int tid = threadIdx.x; asm volatile("" : "+v"(tid)); const int lane = tid & 63, wave = __builtin_amdgcn_readfirstlane(tid >> 6); \
    const int gw = vcu * NWAVES + wave, NGW = G * NWAVES; (void)lane; (void)gw; (void)NGW
#define PHASE_GATEUP(k, W) if (IN(k)) { _Pragma("unroll") for (int rr_ = 0; rr_ < NREP(k); ++rr_) { \
        pg8::Gemm g{R3, (W), MROWS, 2 * FF, DM}; pg8::StaticOrder S; S.init(MROWS, 2 * FF, G, bx); \
        pg8::EpiSwiGLU E{R1, FF}; \
        pg8::gemm_phase<pg8::EpiSwiGLU, pg8::StaticOrder, true, true>(lds + RING_OFF, g, S, E); } \
        if (BOTH(k)) GRID_BAR(); }
#define PHASE_DOWN(k, W) if (IN(k)) { _Pragma("unroll") for (int rr_ = 0; rr_ < NREP(k); ++rr_) { \
        pg8::Gemm g{R1, (W), MROWS, DM, FF}; pg8::StaticOrder S; S.init(MROWS, DM, G, bx); \
        pg8::EpiF32 E{R2, DM}; \
        pg8::gemm_phase<pg8::EpiF32, pg8::StaticOrder, true, true>(lds + RING_OFF, g, S, E); } \
        if (BOTH(k)) GRID_BAR(); }
#define PHASE_NORM(k, BASE, WGT, GPOST, G2, HASU) if (IN(k)) { PHASE_IDS(); \
        _Pragma("unroll") for (int rr_ = 0; rr_ < NREP(k); ++rr_) for (int m = gw; m < MROWS; m += NGW) \
            norm_res_row(R2 + (size_t)m * DM, (BASE) + (size_t)m * DM, args.out + (size_t)m * DM, (WGT), (GPOST), (G2), (HASU) ? R3 + (size_t)m * DM : (bf16*)nullptr, lane); \
        if (BOTH(k)) GRID_BAR(); }

    if (IN(0)) { PHASE_IDS();
        LAS float* scr = (LAS float*)(lds + RING_OFF + wave * 16384);
        constexpr int I_GU = (DM / 64) * (FF / 32), I_D = (FF / 64) * (DM / 32), I_IN = (DM / 64) * (16384 / 32), I_OUT = (DM / 64) * (DM / 32);
        constexpr int NITEMS = 6 * I_GU + I_IN + I_OUT;
        static_assert(I_GU == I_D, "items");
        for (int rr_ = 0; rr_ < NREP(0); ++rr_)
        for (int it = gw; it < NITEMS; it += NGW) {
            int r = it; const float* W; bf16* WT; int K = DM, N = FF, mode = 0;
            if (r < I_GU) { W = args.in[2]; WT = WGU1; mode = 1; }
            else if ((r -= I_GU) < I_GU) { W = args.in[3]; WT = WGU1; mode = 2; }
            else if ((r -= I_GU) < I_D) { W = args.in[4]; WT = WD1; K = FF; N = DM; }
            else if ((r -= I_D) < I_IN) { W = args.in[7]; WT = WIN; N = 16384; mode = 3; }
            else if ((r -= I_IN) < I_OUT) { W = args.in[11]; WT = WOUT; N = DM; }
            else if ((r -= I_OUT) < I_GU) { W = args.in[14]; WT = WGU2; mode = 1; }
            else if ((r -= I_GU) < I_GU) { W = args.in[15]; WT = WGU2; mode = 2; }
            else { r -= I_GU; W = args.in[16]; WT = WD2; K = FF; N = DM; }
            transpose_item(W, K, N, WT, mode, scr, r, lane);
        }
        for (int m = gw; m < MROWS; m += NGW) rms_row_to_bf16(args.in[0] + (size_t)m * DM, args.in[1], R3 + (size_t)m * DM, lane);
        for (int i = bx * 512 + tid; i < 2 * HGW; i += G * 512) { const float l0 = args.in[8][i], l1 = args.in[8][2 * HGW + i]; LB[i] = 1.0f / (1.0f + expf(l1 - l0)); }
        if (BOTH(0)) GRID_BAR();
    }
    PHASE_GATEUP(1, WGU1)
    PHASE_DOWN(2, WD1)
    PHASE_NORM(3, args.in[0], 0.5f, args.in[5], args.in[6], true)
    if (IN(4)) {
#pragma unroll
        for (int rr_ = 0; rr_ < NREP(4); ++rr_) {
        { pg8::Gemm g{R3, WIN, MROWS, PROJ_W, DM}; pg8::StaticOrder S; S.init(MROWS, PROJ_W, G, bx);
          pg8::EpiProj E{R1, PROJ_W, LB};
          pg8::gemm_phase<pg8::EpiProj, pg8::StaticOrder, true, true>(lds + RING_OFF, g, S, E); }
        { pg8::Gemm g{WIN + (size_t)PROJ_W * DM, R3, HGW + NAW, MROWS, DM}; pg8::StaticOrder S; S.init(HGW + NAW, MROWS, G, bx);
          pg8::EpiBf16Plain E{IT, MROWS};
          pg8::gemm_phase<pg8::EpiBf16Plain, pg8::StaticOrder, true, true>(lds + RING_OFF, g, S, E); }
        }
        if (BOTH(4)) GRID_BAR();
    }
    if (IN(5)) { PHASE_IDS();
        for (int rr_ = 0; rr_ < NREP(5); ++rr_)
        if (bx < 2 * BATCH * NHEAD) { const int dir = bx & 1, h = (bx >> 1) & 15, b = bx >> 5;
            hgrn_mfma_unit(lds + RING_OFF, R1, IT, R2 + (size_t)dir * MROWS * HGW, b, h, dir, tid); }
        { LAS float* tbl = (LAS float*)(lds + RING_OFF);
          for (int q = tid; q < NHEAD * 15 * 31; q += 512) tbl[q] = args.in[10][q];
          __syncthreads();
          for (int rr_ = 0; rr_ < NREP(12); ++rr_)
          for (;;) {
            if (tid == 0) MISC[16] = __hip_atomic_fetch_add(ctl + CW_QUEUE + 64 * rr_, 1u, RLX_AGENT);
            __syncthreads();
            const int wu = (int)MISC[16];
            __syncthreads();
            if (wu >= BATCH * NHEAD * (NROWS / 2)) break;
            const int rp = wu & 31, h = (wu >> 5) & 15, b = wu >> 9;
            na_unit_mfma(tbl, R1, VT, R3, b, h, rp, wave, lane);
          }
        }
        if (BOTH(5)) GRID_BAR();
    }
    if (IN(6)) { PHASE_IDS();
        for (int rr_ = 0; rr_ < NREP(6); ++rr_)
        for (int m = gw; m < MROWS; m += NGW)
            hgrn_combine_row(R2 + (size_t)m * HGW, R2 + (size_t)MROWS * HGW + (size_t)m * HGW, R1 + (size_t)m * PROJ_W + C_GATE, args.in[9], R3 + (size_t)m * DM, lane);
        if (BOTH(6)) GRID_BAR();
    }
    if (IN(7)) {
#pragma unroll
        for (int rr_ = 0; rr_ < NREP(7); ++rr_) {
        pg8::Gemm g{R3, WOUT, MROWS, DM, DM}; pg8::StaticOrder S; S.init(MROWS, DM, G, bx);
        pg8::EpiF32 E{R2, DM};
        pg8::gemm_phase<pg8::EpiF32, pg8::StaticOrder, true, true>(lds + RING_OFF, g, S, E); }
        if (BOTH(7)) GRID_BAR();
    }
    PHASE_NORM(8, args.out, 1.0f, args.in[12], args.in[13], true)
    PHASE_GATEUP(9, WGU2)
    PHASE_DOWN(10, WD2)
    PHASE_NORM(11, args.out, 0.5f, args.in[17], args.in[17], false)
#if !MK_PER_PHASE
    if (IN(11)) { if (xb_ld((unsigned*)(args.ws + WS_CTL) + CW_BAR + XB_TMO) != 0u) { const float q = __builtin_nanf(""); for (int m = bx; m < MROWS; m += G) for (int c = threadIdx.x; c < DM; c += 512) args.out[(size_t)m * DM + c] = q; } }
#endif
#undef IN
#undef BOTH
}

extern "C" void kernel_launch(void* const* d_in, const int* in_sizes, int n_in, void* d_out, int out_size, void* d_ws, size_t ws_size, hipStream_t stream) {
    static int grid = 0;
    if (grid == 0) {
        if (n_in != 18 || in_sizes[0] != MROWS * DM || out_size != MROWS * DM || ws_size < WS_END) {
            fprintf(stderr, "kernel_launch: unexpected shapes (n_in %d, in0 %d, out %d, ws %zu need %zu); nothing launched\n", n_in, n_in > 0 ? in_sizes[0] : -1, out_size, ws_size, (size_t)WS_END); grid = -1; return; }
        int dev = 0, cus = 0;
        if (hipGetDevice(&dev) != hipSuccess || hipDeviceGetAttribute(&cus, hipDeviceAttributeMultiprocessorCount, dev) != hipSuccess) { grid = -1; return; }
        if (hipFuncSetAttribute((const void*)fwd_kernel, hipFuncAttributeMaxDynamicSharedMemorySize, LDS_BYTES) != hipSuccess) { fprintf(stderr, "kernel_launch: hipFuncSetAttribute failed\n"); grid = -1; return; }
        int per_cu = 0;
        if (hipOccupancyMaxActiveBlocksPerMultiprocessor(&per_cu, (const void*)fwd_kernel, NWAVES * 64, LDS_BYTES) != hipSuccess || per_cu < 1)
            fprintf(stderr, "kernel_launch: note: occupancy query reports %d workgroups per CU\n", per_cu);
        (void)hipGetLastError();
        grid = cus;
    }
    if (grid < 0) return;
    if (hipMemsetAsync((char*)d_ws + WS_CTL, 0, CTL_ZERO_BYTES, stream) != hipSuccess) { fprintf(stderr, "kernel_launch: memset failed\n"); return; }
    Args a{};
    for (int i = 0; i < 18; ++i) a.in[i] = (const float*)d_in[i];
    a.out = (float*)d_out; a.ws = (unsigned char*)d_ws;
#if MK_PER_PHASE
    for (int p = 0; p < N_PHASES; ++p) { a.ph_lo = p; a.ph_hi = p + 1; hipLaunchKernelGGL(fwd_kernel, dim3(grid), dim3(NWAVES * 64), LDS_BYTES, stream, a); }
#else
    a.ph_lo = 0; a.ph_hi = N_PHASES;
    hipLaunchKernelGGL(fwd_kernel, dim3(grid), dim3(NWAVES * 64), LDS_BYTES, stream, a);
#endif
    const hipError_t le = hipPeekAtLastError();
    if (le != hipSuccess) fprintf(stderr, "kernel_launch: launch failed: %s\n", hipGetErrorName(le));
}
```

```cpp
#include <hip/hip_runtime.h>
#include <cstdio>
#include <cstdint>

#ifndef REPEAT_MASK
#define REPEAT_MASK 0
#endif
#define NREP(k) (1 + ((REPEAT_MASK >> (k)) & 1))
#ifndef G_SP2
#define G_SP2 true
#endif
#ifndef G_ALIGN
#define G_ALIGN true
#endif
#ifndef EPI_TWICE
#define EPI_TWICE 0
#endif
#ifndef MK_PER_PHASE
#define MK_PER_PHASE 0
#endif

namespace pg8 {
#define PG8_LAS __attribute__((address_space(3)))
typedef unsigned short bf16_t;
typedef short bf16x8 __attribute__((ext_vector_type(8)));
typedef float f32x4 __attribute__((ext_vector_type(4)));
typedef unsigned u32x4 __attribute__((ext_vector_type(4)));
constexpr int BM = 256, BK = 64, HALF = 128, HTB = HALF * BK * 2  , STAGE_BYTES = 8 * HTB, NXCD = 8, WGM = 8;

__host__ __device__ __forceinline__ int lds_byte(int r, int c) { const int st = (r >> 4) * 2 + (c >> 5), rr = r & 15, cc = c & 31, ob = rr * 64 + cc * 2; return st * 1024 + (ob ^ (((ob >> 9) & 1) << 5)); }
__host__ __device__ __forceinline__ void stage_rc(int b, int& R, int& C) { const int st = b / 1024, sb = b % 1024, swz = sb ^ (((sb >> 9) & 1) << 5); R = (st >> 1) * 16 + swz / 64; C = (st & 1) * 32 + (swz % 64) / 2; }
__host__ __device__ __forceinline__ int perm32(int rho) { const int n = rho >> 4, i = rho & 15; return 8 * (i >> 2) + 4 * n + (i & 3); }

struct Unit { int pm, pn; };
struct Gemm { const bf16_t* A; const bf16_t* Bt; int M, N, K; };

struct StaticOrder {
    int nM, nN, nwg, G, c;
    __host__ __device__ void init(int M, int N, int G_, int c_) { nM = M / BM; nN = N / BM; nwg = nM * nN; G = G_; c = c_; }
    __host__ __device__ bool next(int i, Unit& u) const {
        const long L = (long)i * G + c; if (L >= nwg) return false;
        int wgid = (int)L; { const int q = nwg / NXCD, r = nwg % NXCD, xcd = wgid % NXCD, off = wgid / NXCD; wgid = (xcd < r ? xcd * (q + 1) : r * (q + 1) + (xcd - r) * q) + off; }
        const int nig = WGM * nN, gid = wgid / nig, fm = gid * WGM, gsz = (nM - fm) < WGM ? (nM - fm) : WGM;
        u.pm = fm + ((wgid % nig) % gsz); u.pn = (wgid % nig) / gsz; return true;
    }
    __device__ __forceinline__ void a_ready(const Unit&) const {}
    __device__ __forceinline__ void done(const Unit&) const {}
};

__device__ __forceinline__ unsigned cvt_pk_bf16(float lo, float hi) { unsigned r; asm volatile("v_cvt_pk_bf16_f32 %0, %1, %2" : "=v"(r) : "v"(lo), "v"(hi)); return r; }
__device__ __forceinline__ unsigned cvt_pk_f16(float lo, float hi) { typedef _Float16 h2 __attribute__((ext_vector_type(2))); h2 v; v.x = (_Float16)lo; v.y = (_Float16)hi; return __builtin_bit_cast(unsigned, v); }
__device__ __forceinline__ float sigmoidf_fast(float v) { return __builtin_amdgcn_rcpf(1.0f + __builtin_amdgcn_exp2f(-1.4426950408889634f * v)); }

struct EpiF32 {
    static constexpr bool PERM = false, AFTER_DRAIN = false;
    float* C; int ldc;
    __device__ __forceinline__ void operator()(const f32x4 (&acc)[2][2][4][2], const Unit& u, int wr, int wc, int fr, int fq) const {
        const int row0 = u.pm * BM + wr * 64 + fr, col0 = u.pn * BM + wc * 32 + 4 * fq;
#pragma unroll
        for (int ai = 0; ai < 2; ++ai)
#pragma unroll
            for (int m = 0; m < 4; ++m) { float* rowp = C + (size_t)(row0 + ai * HALF + m * 16) * ldc + col0;
#pragma unroll
                for (int bj = 0; bj < 2; ++bj)
#pragma unroll
                    for (int n = 0; n < 2; ++n) *(f32x4*)(rowp + bj * HALF + n * 16) = acc[ai][bj][m][n]; }
    }
};
struct EpiBf16Plain {
    static constexpr bool PERM = true, AFTER_DRAIN = false;
    bf16_t* O; int ldc;
    __device__ __forceinline__ void operator()(const f32x4 (&acc)[2][2][4][2], const Unit& u, int wr, int wc, int fr, int fq) const {
        const int row0 = u.pm * BM + wr * 64 + fr, col0 = u.pn * BM + wc * 32 + 8 * fq;
#pragma unroll
        for (int ai = 0; ai < 2; ++ai)
#pragma unroll
            for (int m = 0; m < 4; ++m) { bf16_t* rowp = O + (size_t)(row0 + ai * HALF + m * 16) * ldc + col0;
#pragma unroll
                for (int bj = 0; bj < 2; ++bj) { const f32x4 v0 = acc[ai][bj][m][0], v1 = acc[ai][bj][m][1];
                    u32x4 w; w.x = cvt_pk_bf16(v0[0], v0[1]); w.y = cvt_pk_bf16(v0[2], v0[3]); w.z = cvt_pk_bf16(v1[0], v1[1]); w.w = cvt_pk_bf16(v1[2], v1[3]);
                    *(u32x4*)(rowp + bj * HALF) = w; } }
    }
};
struct EpiSwiGLU {
    static constexpr bool PERM = true, AFTER_DRAIN = false;
    bf16_t* H; int ldc;
    __device__ __forceinline__ void operator()(const f32x4 (&acc)[2][2][4][2], const Unit& u, int wr, int wc, int fr, int fq) const {
        const int row0 = u.pm * BM + wr * 64 + fr, col0 = u.pn * HALF + wc * 32 + 8 * fq;
#pragma unroll
        for (int ai = 0; ai < 2; ++ai)
#pragma unroll
            for (int m = 0; m < 4; ++m) { bf16_t* rowp = H + (size_t)(row0 + ai * HALF + m * 16) * ldc + col0;
                float h[8];
#pragma unroll
                for (int n = 0; n < 2; ++n)
#pragma unroll
                    for (int e = 0; e < 4; ++e) { const float g = acc[ai][0][m][n][e], up = acc[ai][1][m][n][e]; h[4 * n + e] = g * sigmoidf_fast(g) * up; }
                u32x4 w; w.x = cvt_pk_bf16(h[0], h[1]); w.y = cvt_pk_bf16(h[2], h[3]); w.z = cvt_pk_bf16(h[4], h[5]); w.w = cvt_pk_bf16(h[6], h[7]);
                *(u32x4*)rowp = w; }
    }
};
struct EpiProj {
    static constexpr bool PERM = true, AFTER_DRAIN = false;
    bf16_t* P; int ldc; const float* lb;
    __device__ __forceinline__ void operator()(const f32x4 (&acc)[2][2][4][2], const Unit& u, int wr, int wc, int fr, int fq) const {
        const int sec = u.pn >> 3;
        const int row0 = u.pm * BM + wr * 64 + fr, col0 = u.pn * BM + wc * 32 + 8 * fq;
        const bool isg = (sec == 1 || sec == 2), act = (sec == 0 || sec == 3); const float sc = (sec == 4) ? 0.08838834764831845f : 1.0f;
        const float* lbp = lb + (isg ? (col0 - 2048) : 0);
#pragma unroll
        for (int ai = 0; ai < 2; ++ai)
#pragma unroll
            for (int m = 0; m < 4; ++m) { bf16_t* rowp = P + (size_t)(row0 + ai * HALF + m * 16) * ldc + col0;
#pragma unroll
                for (int bj = 0; bj < 2; ++bj) { float g[8]; u32x4 w;
                    if (isg) {
                        const f32x4 la = *(const f32x4*)(lbp + bj * HALF), lc = *(const f32x4*)(lbp + bj * HALF + 4);
#pragma unroll
                        for (int e = 0; e < 4; ++e) { const float f0 = la[e] + (1.0f - la[e]) * sigmoidf_fast(acc[ai][bj][m][0][e]), f1 = lc[e] + (1.0f - lc[e]) * sigmoidf_fast(acc[ai][bj][m][1][e]);
                            g[e] = __builtin_amdgcn_logf(f0) * 0.6931471805599453f; g[4 + e] = __builtin_amdgcn_logf(f1) * 0.6931471805599453f; }
                        w.x = cvt_pk_f16(g[0], g[1]); w.y = cvt_pk_f16(g[2], g[3]); w.z = cvt_pk_f16(g[4], g[5]); w.w = cvt_pk_f16(g[6], g[7]);
                    } else {
#pragma unroll
                        for (int n = 0; n < 2; ++n)
#pragma unroll
                            for (int e = 0; e < 4; ++e) { const float v = acc[ai][bj][m][n][e]; g[4 * n + e] = act ? v * sigmoidf_fast(v) : v * sc; }
                        w.x = cvt_pk_bf16(g[0], g[1]); w.y = cvt_pk_bf16(g[2], g[3]); w.z = cvt_pk_bf16(g[4], g[5]); w.w = cvt_pk_bf16(g[6], g[7]);
                    }
                    *(u32x4*)(rowp + bj * HALF) = w; }
                asm volatile("" ::: "memory"); }
    }
};

template <class Epi, class Sched, bool ALIGN_EPI = false, bool SP2 = false>
__device__ __forceinline__ void gemm_phase(PG8_LAS unsigned char* lds, const Gemm g, const Sched& S, const Epi& E) {
    int tid_ = threadIdx.x; asm volatile("" : "+v"(tid_));
    const int tid = tid_, wid = __builtin_amdgcn_readfirstlane(tid >> 6), lane = tid & 63, wr = wid >> 2, wc = wid & 3, fr = lane & 15, fq = lane >> 4;
    const int K = g.K, nt = K / BK;
    unsigned voffA[2], voffB[2];
#pragma unroll
    for (int i = 0; i < 2; ++i) { int R, C; stage_rc(tid * 16 + i * 8192, R, C); const int Rb = Epi::PERM ? ((R & ~31) + perm32(R & 31)) : R;
        voffA[i] = (unsigned)(R * K + C) * 2u; voffB[i] = (unsigned)(Rb * K + C) * 2u; }
    const size_t kstep = (size_t)(BK * 2);
    const size_t hstep = (size_t)HALF * K * 2;
    const size_t tstep = 2 * hstep;
    const unsigned ldsw = (unsigned)wid * 1024u;
    const int aoff = lds_byte(wr * 64 + fr, fq * 8), boff = lds_byte(wc * 32 + fr, fq * 8);
#define PG8_SA(b, h) (((b) * 2 + (h)) * HTB)
#define PG8_SB(b, h) ((4 + (b) * 2 + (h)) * HTB)
#define PG8_STAGE(bufoff, gbase, voff) do { _Pragma("unroll") for (int _i = 0; _i < 2; ++_i) \
        __builtin_amdgcn_global_load_lds((const unsigned*)((const char*)(gbase) + (voff)[_i]), (PG8_LAS unsigned*)(lds + (bufoff) + ldsw + _i * 8192), 16, 0, 0); } while (0)
#define PG8_LDA(dst, b, h) do { _Pragma("unroll") for (int m = 0; m < 4; ++m) _Pragma("unroll") for (int k = 0; k < 2; ++k) dst[m][k] = *(const PG8_LAS bf16x8*)(lds + PG8_SA(b, h) + aoff + m * 2048 + k * 1024); } while (0)
#define PG8_LDB(dst, b, h) do { _Pragma("unroll") for (int n = 0; n < 2; ++n) _Pragma("unroll") for (int k = 0; k < 2; ++k) dst[n][k] = *(const PG8_LAS bf16x8*)(lds + PG8_SB(b, h) + boff + n * 2048 + k * 1024); } while (0)
#define PG8_MMA(ai, bj, At, Bt) do { __builtin_amdgcn_s_setprio(1); _Pragma("unroll") for (int m = 0; m < 4; ++m) _Pragma("unroll") for (int n = 0; n < 2; ++n) _Pragma("unroll") for (int k = 0; k < 2; ++k) \
        acc[ai][bj][m][n] = __builtin_amdgcn_mfma_f32_16x16x32_bf16(Bt[n][k], At[m][k], acc[ai][bj][m][n], 0, 0, 0); __builtin_amdgcn_s_setprio(0); } while (0)
#define PG8_WAIT_V(n) asm volatile("s_waitcnt vmcnt(" #n ")" ::: "memory")
#define PG8_WAIT_L(n) asm volatile("s_waitcnt lgkmcnt(" #n ")" ::: "memory")
#define PG8_BAR __builtin_amdgcn_s_barrier()
#define PG8_SCHED __builtin_amdgcn_sched_barrier(0)
    Unit cur, nxt; int ui = 0;
    if (!S.next(0, cur)) return;
    f32x4 acc[2][2][4][2];
#pragma unroll
    for (int a = 0; a < 2; ++a)
#pragma unroll
        for (int b = 0; b < 2; ++b)
#pragma unroll
            for (int m = 0; m < 4; ++m)
#pragma unroll
                for (int n = 0; n < 2; ++n) acc[a][b][m][n] = (f32x4){0.f, 0.f, 0.f, 0.f};
    bf16x8 At[4][2], B0[2][2], B1[2][2];
    const char* cA = (const char*)g.A + (size_t)cur.pm * tstep; const char* cB = (const char*)g.Bt + (size_t)cur.pn * tstep;
    S.a_ready(cur);
    if constexpr (SP2) {
        PG8_STAGE(PG8_SB(0, 0), cB, voffB); PG8_STAGE(PG8_SB(0, 1), cB + hstep, voffB); PG8_STAGE(PG8_SA(0, 0), cA, voffA); PG8_STAGE(PG8_SA(0, 1), cA + hstep, voffA);
        if (wr == 1) PG8_BAR;
        PG8_WAIT_V(2); PG8_BAR;
        PG8_STAGE(PG8_SB(1, 0), cB + kstep, voffB); PG8_STAGE(PG8_SA(1, 0), cA + kstep, voffA); PG8_STAGE(PG8_SB(1, 1), cB + hstep + kstep, voffB);
        PG8_WAIT_V(6); PG8_BAR;
    } else {
        PG8_STAGE(PG8_SB(0, 0), cB, voffB); PG8_STAGE(PG8_SA(0, 0), cA, voffA); PG8_STAGE(PG8_SB(0, 1), cB + hstep, voffB); PG8_STAGE(PG8_SA(0, 1), cA + hstep, voffA);
        if (wr == 1) PG8_BAR;
        PG8_WAIT_V(4); PG8_BAR;
        PG8_STAGE(PG8_SB(1, 0), cB + kstep, voffB); PG8_STAGE(PG8_SA(1, 0), cA + kstep, voffA); PG8_STAGE(PG8_SB(1, 1), cB + hstep + kstep, voffB);
        PG8_WAIT_V(6); PG8_BAR;
    }
    for (;;) {
        const bool has_next = S.next(ui + 1, nxt);
        const char* nA = has_next ? (const char*)g.A + (size_t)nxt.pm * tstep : cA; const char* nB = has_next ? (const char*)g.Bt + (size_t)nxt.pn * tstep : cB;
        for (int t = 0; t < nt; t += 2) {
            const bool last = (t == nt - 2);
            const char* a1 = cA + (size_t)(t + 1) * kstep;
            const char* a2 = last ? nA : cA + (size_t)(t + 2) * kstep; const char* b2 = last ? nB : cB + (size_t)(t + 2) * kstep;
            const char* a3 = a2 + kstep; const char* b3 = b2 + kstep;
            if (last && has_next) S.a_ready(nxt);
            if constexpr (SP2) {
            PG8_LDB(B0, 0, 0); PG8_LDB(B1, 0, 1); PG8_SCHED; PG8_LDA(At, 0, 0); PG8_STAGE(PG8_SA(1, 1), a1 + hstep, voffA);
            PG8_WAIT_V(8); PG8_WAIT_L(0); PG8_BAR; PG8_MMA(0, 0, At, B0); PG8_MMA(0, 1, At, B1); PG8_BAR; PG8_SCHED;
            PG8_LDA(At, 0, 1); PG8_STAGE(PG8_SB(0, 0), b2, voffB); PG8_STAGE(PG8_SB(0, 1), b2 + hstep, voffB); PG8_STAGE(PG8_SA(0, 0), a2, voffA);
            PG8_WAIT_V(8); PG8_WAIT_L(0); PG8_BAR; PG8_MMA(1, 0, At, B0); PG8_MMA(1, 1, At, B1); PG8_BAR; PG8_SCHED;
            PG8_LDB(B0, 1, 0); PG8_LDB(B1, 1, 1); PG8_SCHED; PG8_LDA(At, 1, 0); PG8_STAGE(PG8_SA(0, 1), a2 + hstep, voffA);
            PG8_WAIT_V(8); PG8_WAIT_L(0); PG8_BAR; PG8_MMA(0, 0, At, B0); PG8_MMA(0, 1, At, B1); PG8_BAR; PG8_SCHED;
            PG8_LDA(At, 1, 1); PG8_STAGE(PG8_SB(1, 0), b3, voffB); PG8_STAGE(PG8_SB(1, 1), b3 + hstep, voffB); PG8_STAGE(PG8_SA(1, 0), a3, voffA);
            PG8_WAIT_V(8); PG8_WAIT_L(0); PG8_BAR; PG8_MMA(1, 0, At, B0); PG8_MMA(1, 1, At, B1); PG8_BAR; PG8_SCHED;
            } else {
            PG8_LDB(B0, 0, 0); PG8_SCHED; PG8_LDA(At, 0, 0); PG8_STAGE(PG8_SA(1, 1), a1 + hstep, voffA);
            PG8_WAIT_L(8); PG8_BAR; PG8_WAIT_L(0); PG8_MMA(0, 0, At, B0); PG8_BAR; PG8_SCHED;
            PG8_LDB(B1, 0, 1); PG8_STAGE(PG8_SB(0, 0), b2, voffB);
            PG8_BAR; PG8_WAIT_L(0); PG8_MMA(0, 1, At, B1); PG8_BAR;
            PG8_LDA(At, 0, 1); PG8_STAGE(PG8_SA(0, 0), a2, voffA);
            PG8_BAR; PG8_WAIT_L(0); PG8_MMA(1, 0, At, B0); PG8_BAR; PG8_SCHED;
            PG8_STAGE(PG8_SB(0, 1), b2 + hstep, voffB);
            PG8_WAIT_V(6); PG8_BAR; PG8_MMA(1, 1, At, B1); PG8_BAR;
            PG8_LDB(B0, 1, 0); PG8_SCHED; PG8_LDA(At, 1, 0); PG8_STAGE(PG8_SA(0, 1), a2 + hstep, voffA);
            PG8_WAIT_L(8); PG8_BAR; PG8_WAIT_L(0); PG8_MMA(0, 0, At, B0); PG8_BAR; PG8_SCHED;
            PG8_LDB(B1, 1, 1); PG8_STAGE(PG8_SB(1, 0), b3, voffB);
            PG8_BAR; PG8_WAIT_L(0); PG8_MMA(0, 1, At, B1); PG8_BAR;
            PG8_LDA(At, 1, 1); PG8_STAGE(PG8_SA(1, 0), a3, voffA);
            PG8_BAR; PG8_WAIT_L(0); PG8_MMA(1, 0, At, B0); PG8_BAR; PG8_SCHED;
            PG8_STAGE(PG8_SB(1, 1), b3 + hstep, voffB);
            PG8_WAIT_V(6); PG8_BAR; PG8_MMA(1, 1, At, B1); PG8_BAR;
            }
        }
        if constexpr (ALIGN_EPI) { if (wr == 0) PG8_BAR; }
        if constexpr (!Epi::AFTER_DRAIN) { E(acc, cur, wr, wc, fr, fq); if (EPI_TWICE) { asm volatile("" ::: "memory"); E(acc, cur, wr, wc, fr, fq); } S.done(cur); }
        if (!has_next) break;
#pragma unroll
        for (int a = 0; a < 2; ++a)
#pragma unroll
            for (int b = 0; b < 2; ++b)
#pragma unroll
                for (int m = 0; m < 4; ++m)
#pragma unroll
                    for (int n = 0; n < 2; ++n) acc[a][b][m][n] = (f32x4){0.f, 0.f, 0.f, 0.f};
        cur = nxt; cA = nA; cB = nB; ++ui;
        if constexpr (ALIGN_EPI) { if (wr == 1) PG8_BAR; }
    }
    PG8_WAIT_V(0);
    if constexpr (!ALIGN_EPI) { if (wr == 0) PG8_BAR; }
    PG8_BAR;
#undef PG8_SA
#undef PG8_SB
#undef PG8_STAGE
#undef PG8_LDA
#undef PG8_LDB
#undef PG8_MMA
#undef PG8_WAIT_V
#undef PG8_WAIT_L
#undef PG8_BAR
#undef PG8_SCHED
}
}

constexpr int NWAVES = 8;
constexpr int DM = 4096, BATCH = 4, SEQ = 4096, MROWS = BATCH * SEQ;
constexpr int FF = 11008, HGW = 2048, NAW = 2048, HD = 128, NHEAD = 16;
constexpr int PROJ_W = 12288;
constexpr int C_Q = 0, C_GF = 2048, C_GB = 4096, C_GATE = 6144, C_NQ = 8192, C_NK = 10240;
constexpr int GRID_W = 64, NROWS = 64, WIN_R = 8, WIN_C = 16;
constexpr float EPS = 1e-6f;
constexpr int N_PHASES = 12;

constexpr size_t MiB = 1u << 20;
constexpr size_t WS_CTL = 0, CTL_ZERO_BYTES = 1 * MiB;
constexpr size_t WS_LB = 1 * MiB;
constexpr size_t WS_WGU1 = 2 * MiB, WS_WD1 = 174 * MiB, WS_WIN = 260 * MiB, WS_WOUT = 388 * MiB, WS_WGU2 = 420 * MiB, WS_WD2 = 592 * MiB;
constexpr size_t WS_R1 = 678 * MiB;
constexpr size_t WS_TT = WS_R1 + 384 * MiB;
constexpr size_t WS_R2 = 1190 * MiB;
constexpr size_t WS_R3 = 1446 * MiB;
constexpr size_t WS_END = 1574 * MiB;
static_assert((size_t)2 * FF * DM * 2 <= 172 * MiB && (size_t)FF * DM * 2 <= 86 * MiB, "weights");
static_assert((size_t)MROWS * PROJ_W * 2 == 384 * MiB && (size_t)MROWS * FF * 2 <= 512 * MiB, "R1");
constexpr int CW_TMO = 0, CW_CODE = 1;
constexpr int CW_BAR = 4096;
constexpr int CW_QUEUE = 8192;

constexpr int RING_OFF = 0, RING_BYTES = 131072;
constexpr int LDSCTL_OFF = RING_BYTES, MISC_OFF = LDSCTL_OFF + 320;
constexpr int LDS_BYTES = 147456;

#define GAS __attribute__((address_space(1)))
#define LAS __attribute__((address_space(3)))
typedef unsigned short bf16;
typedef unsigned v4u __attribute__((ext_vector_type(4)));
typedef unsigned v2u __attribute__((ext_vector_type(2)));
typedef float f32x4 __attribute__((ext_vector_type(4)));
typedef GAS unsigned gu32;
#define RLX_AGENT __ATOMIC_RELAXED, __HIP_MEMORY_SCOPE_AGENT
#define LDS_WAIT() asm volatile("s_waitcnt lgkmcnt(0)" ::: "memory")
#define VM_WAIT() asm volatile("s_waitcnt vmcnt(0)" ::: "memory")
__device__ __forceinline__ unsigned f2bf(float f) { unsigned u = __builtin_bit_cast(unsigned, f); return (u + 0x7fffu + ((u >> 16) & 1u)) >> 16; }
__device__ __forceinline__ unsigned pk2(float lo, float hi) { return f2bf(lo) | (f2bf(hi) << 16); }
__device__ __forceinline__ float bf2f(unsigned short b) { return __builtin_bit_cast(float, (unsigned)b << 16); }
__device__ __forceinline__ float bflo(unsigned w) { return __builtin_bit_cast(float, w << 16); }
__device__ __forceinline__ float bfhi(unsigned w) { return __builtin_bit_cast(float, w & 0xffff0000u); }
__device__ __forceinline__ float h2f(unsigned short b) { return (float)__builtin_bit_cast(_Float16, b); }

#define XB_TMO      128
#define XB_XCNT(j)  (256  + 64 * (j))
#define XB_XSUB(j)  (1280 + 64 * (j))
#define XB_XGEN(j)  (2304 + 64 * (j))
#define XB_TOP      3328
#define XB_TOPGEN   3392
#define XCD_BAR_WORDS 3456
#define XB_SPIN_CAP (1u << 18)
__device__ __forceinline__ unsigned xb_ld(unsigned* p)              { return __hip_atomic_load(p, __ATOMIC_RELAXED, __HIP_MEMORY_SCOPE_AGENT); }
__device__ __forceinline__ unsigned xb_add(unsigned* p, unsigned v) { return __hip_atomic_fetch_add(p, v, __ATOMIC_RELAXED, __HIP_MEMORY_SCOPE_AGENT); }
__device__ __forceinline__ unsigned xb_xcc_id() { return (unsigned)__builtin_amdgcn_s_getreg((3 << 11) | 20) & 0xFu; }
#define XB_SPIN(cond, bar) do { unsigned _sp = 0; while (cond) { __builtin_amdgcn_s_sleep(1); \
    if ((++_sp & 255u) == 0u) { if (xb_ld(&(bar)[XB_TMO])) break; if (_sp > XB_SPIN_CAP) { atomicAdd(&(bar)[XB_TMO], 1u); break; } } } } while (0)
struct XcdBarrier { unsigned* bar; unsigned x; volatile LAS unsigned* st; };
__device__ __forceinline__ XcdBarrier xcd_barrier_post(unsigned* bar, volatile LAS unsigned* st) {
    XcdBarrier b; b.bar = bar; b.x = xb_xcc_id(); b.st = st;
    if (threadIdx.x == 0) (void)xb_add(&bar[XB_XCNT(b.x)], 1u);
    return b;
}
__device__ __forceinline__ void xcd_barrier_complete(unsigned* bar, unsigned x, unsigned& nloc, unsigned& nx) {
    const unsigned G = gridDim.x * gridDim.y * gridDim.z;
    unsigned sum, cnt, mine, sp = 0u;
    for (;;) {
        sum = 0u; cnt = 0u; mine = 0u;
#pragma unroll
        for (unsigned j = 0; j < 16; ++j) { const unsigned c = xb_ld(&bar[XB_XCNT(j)]); sum += c; cnt += (c > 0u) ? 1u : 0u; mine = (j == x) ? c : mine; }
        if (sum == G) break;
        __builtin_amdgcn_s_sleep(1);
        if ((++sp & 255u) == 0u) { if (xb_ld(&bar[XB_TMO])) break; if (sp > XB_SPIN_CAP) { atomicAdd(&bar[XB_TMO], 1u); break; } }
    }
    nloc = mine > 0u ? mine : 1u; nx = cnt > 0u ? cnt : 1u;
}
__device__ __forceinline__ void xcd_barrier(const XcdBarrier& b) {
    asm volatile("s_waitcnt vmcnt(0)" ::: "memory");
    __syncthreads();
    if (threadIdx.x == 0) {
        unsigned* bar = b.bar;
        __builtin_amdgcn_s_waitcnt(0);
        unsigned nloc = b.st[0], nx = b.st[1];
        if (nloc == 0u) { xcd_barrier_complete(bar, b.x, nloc, nx); b.st[0] = nloc; b.st[1] = nx; }
        const unsigned old = xb_add(&bar[XB_XSUB(b.x)], 1u);
        const unsigned gen = old / nloc;
        if (old + 1u == (gen + 1u) * nloc) {
            __builtin_amdgcn_fence(__ATOMIC_RELEASE, "agent");
            asm volatile("s_waitcnt vmcnt(0)" ::: "memory");
            const unsigned og = xb_add(&bar[XB_TOP], 1u);
            const unsigned tg = og / nx;
            if (og + 1u == (tg + 1u) * nx) xb_add(&bar[XB_TOPGEN], 1u);
            else XB_SPIN(xb_ld(&bar[XB_TOPGEN]) == tg, bar);
            __builtin_amdgcn_fence(__ATOMIC_ACQUIRE, "agent");
            xb_add(&bar[XB_XGEN(b.x)], 1u);
            asm volatile("s_waitcnt vmcnt(0)" ::: "memory");
        } else {
            XB_SPIN(xb_ld(&bar[XB_XGEN(b.x)]) == gen, bar);
            __builtin_amdgcn_fence(__ATOMIC_ACQUIRE, "agent");
            asm volatile("s_waitcnt vmcnt(0)" ::: "memory");
        }
    }
    __syncthreads();
}

__device__ __forceinline__ float wave_sum(float v) {
#pragma unroll
    for (int o = 1; o < 64; o <<= 1) v += __shfl_xor(v, o);
    return v;
}
__device__ __forceinline__ float wave_max(float v) {
#pragma unroll
    for (int o = 1; o < 64; o <<= 1) v = fmaxf(v, __shfl_xor(v, o));
    return v;
}
__device__ __forceinline__ void transpose_item(const float* W, int K, int N, bf16* WT, int mode, LAS float* scr, int item, int lane) {
    const int nblk = N / 32, kb = item / nblk, nb = item % nblk, k0 = 64 * kb, n0 = 32 * nb;
    const int rbase = (mode == 0) ? n0 : (mode == 3) ? (((0x75436210u >> (4 * (n0 >> 11))) & 7u) * 2048 + (n0 & 2047)) : (256 * (n0 >> 7) + (n0 & 127) + (mode == 2 ? 128 : 0));
#pragma unroll 8
    for (int i = 0; i < 32; ++i) { const int kk = 2 * i + (lane >> 5); scr[kk * 33 + (lane & 31)] = W[(size_t)(k0 + kk) * N + n0 + (lane & 31)]; }
    LDS_WAIT(); asm volatile("" ::: "memory");
    const int c = lane & 7;
#pragma unroll
    for (int j = 0; j < 4; ++j) { const int n = (lane >> 3) + 8 * j; const LAS float* s = scr + (8 * c) * 33 + n;
        v4u o; o.x = pk2(s[0 * 33], s[1 * 33]); o.y = pk2(s[2 * 33], s[3 * 33]); o.z = pk2(s[4 * 33], s[5 * 33]); o.w = pk2(s[6 * 33], s[7 * 33]);
        *(GAS v4u*)(WT + (size_t)(rbase + n) * K + k0 + 8 * c) = o; }
    LDS_WAIT(); asm volatile("" ::: "memory");
}
__device__ __forceinline__ void rms_row_to_bf16(const float* xrow, const float* gain, bf16* orow, int lane) {
    const GAS f32x4* xr = (const GAS f32x4*)xrow + lane; const GAS f32x4* gr = (const GAS f32x4*)gain + lane;
    f32x4 v[16]; float ss = 0.f;
#pragma unroll
    for (int j = 0; j < 16; ++j) { v[j] = xr[64 * j]; ss += (v[j].x * v[j].x + v[j].y * v[j].y) + (v[j].z * v[j].z + v[j].w * v[j].w); }
    const float rs = 1.0f / sqrtf(wave_sum(ss) * (1.0f / DM) + EPS);
    GAS v2u* o8 = (GAS v2u*)orow + lane;
#pragma unroll
    for (int j = 0; j < 16; ++j) { const f32x4 g = gr[64 * j]; v2u w; w.x = pk2(v[j].x * rs * g.x, v[j].y * rs * g.y); w.y = pk2(v[j].z * rs * g.z, v[j].w * rs * g.w); o8[64 * j] = w; }
}
__device__ __forceinline__ void norm_res_row(const bf16* ffrow, const float* baserow, float* hrow, float w, const float* gpost, const float* g2, bf16* urow, int lane) {
    const GAS v2u* fr = (const GAS v2u*)ffrow + lane; const GAS f32x4* br = (const GAS f32x4*)baserow + lane; const GAS f32x4* gp = (const GAS f32x4*)gpost + lane;
    f32x4 v[16]; float ss = 0.f;
#pragma unroll
    for (int j = 0; j < 16; ++j) { const v2u r = fr[64 * j]; v[j] = (f32x4){bflo(r.x), bfhi(r.x), bflo(r.y), bfhi(r.y)}; ss += (v[j].x * v[j].x + v[j].y * v[j].y) + (v[j].z * v[j].z + v[j].w * v[j].w); }
    const float rs = w / sqrtf(wave_sum(ss) * (1.0f / DM) + EPS);
    GAS f32x4* ho = (GAS f32x4*)hrow + lane; float s2 = 0.f;
#pragma unroll
    for (int j = 0; j < 16; ++j) { const f32x4 g = gp[64 * j]; const f32x4 b = br[64 * j]; v[j] = b + v[j] * rs * g; ho[64 * j] = v[j];
        s2 += (v[j].x * v[j].x + v[j].y * v[j].y) + (v[j].z * v[j].z + v[j].w * v[j].w); }
    if (urow) {
        const float r2 = 1.0f / sqrtf(wave_sum(s2) * (1.0f / DM) + EPS);
        const GAS f32x4* gq = (const GAS f32x4*)g2 + lane; GAS v2u* o8 = (GAS v2u*)urow + lane;
#pragma unroll
        for (int j = 0; j < 16; ++j) { const f32x4 g = gq[64 * j]; v2u o; o.x = pk2(v[j].x * r2 * g.x, v[j].y * r2 * g.y); o.y = pk2(v[j].z * r2 * g.z, v[j].w * r2 * g.w); o8[64 * j] = o; }
    }
}

constexpr int HG_QB = 0, HG_KT = 8704, HG_KTT = 17408, HG_SC = 27648, HG_EL = 30208, HG_QT = 30720;
typedef short bf16x8 __attribute__((ext_vector_type(8)));
typedef short bf16x4 __attribute__((ext_vector_type(4)));
__device__ __forceinline__ void hgrn_mfma_unit(LAS unsigned char* lds0, const bf16* proj, const bf16* it, float* obuf, int b, int h, int dir, int tid) {
    const int lane = tid & 63, wave = __builtin_amdgcn_readfirstlane(tid >> 6), i16 = lane & 15, g = lane >> 4;
    const int k = 16 * wave + i16, qd = g;
    const size_t rowbase = (size_t)b * SEQ;
    const int gcol = (dir ? C_GB : C_GF) + h * HD + k, qcol = C_Q + h * HD + k;
    f32x4 S[8];
#pragma unroll
    for (int kt = 0; kt < 8; ++kt) S[kt] = (f32x4){0.f, 0.f, 0.f, 0.f};
    const bf16* vbase = it + (size_t)(h * HD + 16 * wave + i16) * MROWS + rowbase + 8 * g;
    const bf16* pbase = proj + (rowbase + 8 * qd) * (size_t)PROJ_W;
    unsigned short qn[8], gn[8]; bf16x8 vn; f32x4 op[2]; op[0] = (f32x4){0.f, 0.f, 0.f, 0.f}; op[1] = op[0];
    { const int t0 = dir ? (SEQ - 32) : 0; vn = *(const GAS bf16x8*)(vbase + t0);
#pragma unroll
      for (int j = 0; j < 8; ++j) { qn[j] = pbase[(size_t)(t0 + j) * PROJ_W + qcol]; gn[j] = pbase[(size_t)(t0 + j) * PROJ_W + gcol]; } }
    for (int cc = 0; cc < SEQ / 32; ++cc) {
        LAS unsigned char* lds = lds0 + (cc & 1) * 32768;
        LAS float* EL = (LAS float*)(lds + HG_EL);
        const int t0 = dir ? (SEQ - 32 * (cc + 1)) : 32 * cc;
        const bf16x8 vfrag = vn;
        float qv[8], gv[8];
#pragma unroll
        for (int j = 0; j < 8; ++j) { qv[j] = bf2f(qn[j]); gv[j] = h2f(gn[j]); }
        if (cc > 0) { const int tp = dir ? (SEQ - 32 * cc) : 32 * (cc - 1);
#pragma unroll
            for (int itl = 0; itl < 2; ++itl)
#pragma unroll
                for (int e = 0; e < 4; ++e) obuf[(rowbase + tp + 16 * itl + 4 * g + e) * (size_t)HGW + h * HD + 16 * wave + i16] = op[itl][e]; }
        asm volatile("" ::: "memory");
        if (cc + 1 < SEQ / 32) {
            const int t1 = dir ? (SEQ - 32 * (cc + 2)) : 32 * (cc + 1); vn = *(const GAS bf16x8*)(vbase + t1);
#pragma unroll
            for (int j = 0; j < 8; ++j) { qn[j] = pbase[(size_t)(t1 + j) * PROJ_W + qcol]; gn[j] = pbase[(size_t)(t1 + j) * PROJ_W + gcol]; } }
        float cs[8]; float tot = 0.f;
        if (dir == 0) {
#pragma unroll
            for (int j = 0; j < 8; ++j) { tot += gv[j]; cs[j] = tot; }
        } else {
#pragma unroll
            for (int j = 7; j >= 0; --j) { tot += gv[j]; cs[j] = tot; }
        }
        { const float t0q = __shfl(tot, i16), t1q = __shfl(tot, i16 + 16), t2q = __shfl(tot, i16 + 32), t3q = __shfl(tot, i16 + 48);
          float off;
          if (dir == 0) off = (qd > 0 ? t0q : 0.f) + (qd > 1 ? t1q : 0.f) + (qd > 2 ? t2q : 0.f);
          else          off = (qd < 3 ? t3q : 0.f) + (qd < 2 ? t2q : 0.f) + (qd < 1 ? t1q : 0.f);
          if (qd == 0) EL[k] = __builtin_amdgcn_exp2f(((t0q + t1q) + (t2q + t3q)) * 1.4426950408889634f);
          unsigned kt8[8];
#pragma unroll
          for (int j = 0; j < 8; ++j) { const float bb = cs[j] + off; const float kk = 1.0f - __builtin_amdgcn_exp2f(gv[j] * 1.4426950408889634f);
              const float qb = qv[j] * __builtin_amdgcn_exp2f(bb * 1.4426950408889634f), ktv = kk * __builtin_amdgcn_exp2f(fminf(-bb, 80.f) * 1.4426950408889634f);
              const unsigned pk = pg8::cvt_pk_bf16(qb, ktv);
              *(LAS unsigned short*)(lds + HG_QB + (8 * qd + j) * 272 + 2 * k) = (unsigned short)(pk & 0xffffu);
              *(LAS unsigned short*)(lds + HG_KT + (8 * qd + j) * 272 + 2 * k) = (unsigned short)(pk >> 16);
              kt8[j] = pk >> 16; }
          v4u w; w.x = kt8[0] | (kt8[1] << 16); w.y = kt8[2] | (kt8[3] << 16); w.z = kt8[4] | (kt8[5] << 16); w.w = kt8[6] | (kt8[7] << 16);
          *(LAS v4u*)(lds + HG_KTT + k * 80 + 16 * qd) = w; }
        __syncthreads();
        if (wave < 4) { const int ti = wave >> 1, ts = wave & 1; f32x4 a = (f32x4){0.f, 0.f, 0.f, 0.f};
#pragma unroll
            for (int ks = 0; ks < 4; ++ks) { const bf16x8 af = *(const LAS bf16x8*)(lds + HG_QB + (16 * ti + i16) * 272 + (32 * ks + 8 * g) * 2), bfr = *(const LAS bf16x8*)(lds + HG_KT + (16 * ts + i16) * 272 + (32 * ks + 8 * g) * 2);
                a = __builtin_amdgcn_mfma_f32_16x16x32_bf16(af, bfr, a, 0, 0, 0); }
            const int ss = 16 * ts + i16;
#pragma unroll
            for (int e = 0; e < 4; ++e) { const int si = 16 * ti + 4 * g + e; const bool keep = dir ? (ss >= si) : (ss <= si);
                *(LAS unsigned short*)(lds + HG_SC + si * 80 + 2 * ss) = (unsigned short)f2bf(keep ? a[e] : 0.f); } }
        f32x4 o[2]; o[0] = (f32x4){0.f, 0.f, 0.f, 0.f}; o[1] = o[0];
#pragma unroll
        for (int s4 = 0; s4 < 4; ++s4) {
            v4u sw; sw.x = pg8::cvt_pk_bf16(S[2 * s4][0], S[2 * s4][1]); sw.y = pg8::cvt_pk_bf16(S[2 * s4][2], S[2 * s4][3]); sw.z = pg8::cvt_pk_bf16(S[2 * s4 + 1][0], S[2 * s4 + 1][1]); sw.w = pg8::cvt_pk_bf16(S[2 * s4 + 1][2], S[2 * s4 + 1][3]);
            const bf16x8 sb = __builtin_bit_cast(bf16x8, sw);
#pragma unroll
            for (int itl = 0; itl < 2; ++itl) { const LAS unsigned char* qr = lds + HG_QB + (16 * itl + i16) * 272 + (32 * s4 + 4 * g) * 2;
                const v2u lo = *(const LAS v2u*)qr, hi = *(const LAS v2u*)(qr + 32);
                v4u aw; aw.x = lo.x; aw.y = lo.y; aw.z = hi.x; aw.w = hi.y;
                o[itl] = __builtin_amdgcn_mfma_f32_16x16x32_bf16(__builtin_bit_cast(bf16x8, aw), sb, o[itl], 0, 0, 0); }
        }
        __syncthreads();
#pragma unroll
        for (int itl = 0; itl < 2; ++itl) { const bf16x8 af = *(const LAS bf16x8*)(lds + HG_SC + (16 * itl + i16) * 80 + 16 * g);
            o[itl] = __builtin_amdgcn_mfma_f32_16x16x32_bf16(af, vfrag, o[itl], 0, 0, 0); }
        op[0] = o[0]; op[1] = o[1];
#pragma unroll
        for (int kt = 0; kt < 8; ++kt) { const bf16x8 af = *(const LAS bf16x8*)(lds + HG_KTT + (16 * kt + i16) * 80 + 16 * g);
            S[kt] = __builtin_amdgcn_mfma_f32_16x16x32_bf16(af, vfrag, S[kt], 0, 0, 0);
            const f32x4 el = *(const LAS f32x4*)(EL + 16 * kt + 4 * g);
            S[kt] = S[kt] * el; }
    }
    { const int tp = dir ? 0 : (SEQ - 32);
#pragma unroll
      for (int itl = 0; itl < 2; ++itl)
#pragma unroll
          for (int e = 0; e < 4; ++e) obuf[(rowbase + tp + 16 * itl + 4 * g + e) * (size_t)HGW + h * HD + 16 * wave + i16] = op[itl][e]; }
    __syncthreads();
}

__device__ __forceinline__ void na_unit_mfma(const LAS float* tbl, const bf16* proj, const bf16* vt, bf16* mix, int b, int h, int rp, int wave, int lane) {
    const int r = 2 * rp + (wave >> 2), cb = wave & 3;
    const int cbase = (cb == 0) ? 0 : (cb == 1) ? 8 : (cb == 2) ? 24 : 32;
    const int rs = min(max(r - WIN_R / 2, 0), NROWS - WIN_R);
    const int i = lane & 15, g = lane >> 4;
    const int c = 16 * cb + i, cs = min(max(c - WIN_C / 2, 0), GRID_W - WIN_C);
    const size_t tok0 = (size_t)b * SEQ;
    const bf16* qp = proj + (tok0 + r * GRID_W + c) * PROJ_W + C_NQ + h * HD + 8 * g;
    bf16x8 qf[4];
#pragma unroll
    for (int ks = 0; ks < 4; ++ks) qf[ks] = *(const GAS bf16x8*)(qp + 32 * ks);
    const int kco = 8 * (i >> 2) + (i & 3);
    const bf16* kp0 = proj + (tok0 + rs * GRID_W + cbase + kco) * PROJ_W + C_NK + h * HD + 8 * g;
    f32x4 s[8][2];
#pragma unroll
    for (int kr = 0; kr < 8; ++kr)
#pragma unroll
        for (int t = 0; t < 2; ++t) { f32x4 a = (f32x4){0.f, 0.f, 0.f, 0.f}; const bf16* kp = kp0 + (size_t)(kr * GRID_W + 4 * t) * PROJ_W;
#pragma unroll
            for (int ks = 0; ks < 4; ++ks) a = __builtin_amdgcn_mfma_f32_16x16x32_bf16(*(const GAS bf16x8*)(kp + 32 * ks), qf[ks], a, 0, 0, 0);
            s[kr][t] = a; }
    const LAS float* tb = tbl + h * (15 * 31);
    float m = -3.0e38f;
#pragma unroll
    for (int kr = 0; kr < 8; ++kr) { const int dr = rs + kr - r + WIN_R - 1;
#pragma unroll
        for (int t = 0; t < 2; ++t)
#pragma unroll
            for (int e = 0; e < 4; ++e) { const int kcol = cbase + 8 * g + 4 * t + e; const bool ok = (kcol >= cs) && (kcol < cs + WIN_C); const int dc = min(max(kcol - c + WIN_C - 1, 0), 30);
                const float v = ok ? s[kr][t][e] + tb[dr * 31 + dc] : -3.0e38f; s[kr][t][e] = v; m = fmaxf(m, v); } }
    m = fmaxf(m, __shfl_xor(m, 16)); m = fmaxf(m, __shfl_xor(m, 32));
    float l = 0.f; bf16x8 pf[8];
#pragma unroll
    for (int kr = 0; kr < 8; ++kr) { float p[8];
#pragma unroll
        for (int t = 0; t < 2; ++t)
#pragma unroll
            for (int e = 0; e < 4; ++e) { p[4 * t + e] = __builtin_amdgcn_exp2f((s[kr][t][e] - m) * 1.4426950408889634f); l += p[4 * t + e]; }
        v4u w; w.x = pg8::cvt_pk_bf16(p[0], p[1]); w.y = pg8::cvt_pk_bf16(p[2], p[3]); w.z = pg8::cvt_pk_bf16(p[4], p[5]); w.w = pg8::cvt_pk_bf16(p[6], p[7]);
        pf[kr] = __builtin_bit_cast(bf16x8, w); }
    l += __shfl_xor(l, 16); l += __shfl_xor(l, 32);
    const bf16* vp0 = vt + (size_t)(h * HD + i) * MROWS + tok0 + rs * GRID_W + cbase + 8 * g;
    f32x4 acc[8];
#pragma unroll
    for (int dt = 0; dt < 8; ++dt) acc[dt] = (f32x4){0.f, 0.f, 0.f, 0.f};
#pragma unroll
    for (int kr = 0; kr < 8; ++kr)
#pragma unroll
        for (int dt = 0; dt < 8; ++dt) acc[dt] = __builtin_amdgcn_mfma_f32_16x16x32_bf16(*(const GAS bf16x8*)(vp0 + (size_t)(16 * dt) * MROWS + kr * GRID_W), pf[kr], acc[dt], 0, 0, 0);
    const float inv = 1.0f / l;
    bf16* op = mix + (tok0 + r * GRID_W + c) * DM + HGW + h * HD + 4 * g;
#pragma unroll
    for (int dt = 0; dt < 8; ++dt) { v2u w; w.x = pg8::cvt_pk_bf16(acc[dt][0] * inv, acc[dt][1] * inv); w.y = pg8::cvt_pk_bf16(acc[dt][2] * inv, acc[dt][3] * inv); *(GAS v2u*)(op + 16 * dt) = w; }
}

__device__ __forceinline__ void hgrn_combine_row(const float* of, const float* ob, const bf16* gaterow, const float* hn, bf16* orow, int lane) {
    const GAS f32x4* a = (const GAS f32x4*)of + lane; const GAS f32x4* bq = (const GAS f32x4*)ob + lane; const GAS v2u* gr = (const GAS v2u*)gaterow + lane;
    const f32x4 hg = *((const GAS f32x4*)hn + (lane & 31));
    GAS v2u* o8 = (GAS v2u*)orow + lane;
#pragma unroll
    for (int j = 0; j < 8; ++j) {
        f32x4 v = a[64 * j] + bq[64 * j];
        float ss = (v.x * v.x + v.y * v.y) + (v.z * v.z + v.w * v.w);
#pragma unroll
        for (int o = 1; o < 32; o <<= 1) ss += __shfl_xor(ss, o);
        const float rs = 1.0f / sqrtf(ss * (1.0f / HD) + EPS);
        const v2u g = gr[64 * j];
        v2u w; w.x = pk2(v.x * rs * hg.x * bflo(g.x), v.y * rs * hg.y * bfhi(g.x)); w.y = pk2(v.z * rs * hg.z * bflo(g.y), v.w * rs * hg.w * bfhi(g.y));
        o8[64 * j] = w;
    }
}

struct Args { const float* in[18]; float* out; unsigned char* ws; int ph_lo, ph_hi; };
__global__ void __launch_bounds__(NWAVES * 64, 2) fwd_kernel(Args args) {
    extern __shared__ __attribute__((aligned(16))) unsigned char lds_raw[];
    LAS unsigned char* lds = (LAS unsigned char*)lds_raw;
    volatile LAS unsigned* MISC = (volatile LAS unsigned*)(lds + MISC_OFF);
    const int G = gridDim.x, bx = blockIdx.x;
    const int vcu = (G % 8 == 0) ? (bx % 8) * (G / 8) + bx / 8 : bx;
    gu32* ctl = (gu32*)(args.ws + WS_CTL);
    for (int u = threadIdx.x; u < (LDS_BYTES - LDSCTL_OFF) / 4; u += NWAVES * 64) ((LAS unsigned*)(lds + LDSCTL_OFF))[u] = 0u;
    __syncthreads();
    XcdBarrier bar; bar.bar = (unsigned*)(args.ws + WS_CTL) + CW_BAR; bar.x = 0; bar.st = nullptr;
#if !MK_PER_PHASE
    bar = xcd_barrier_post((unsigned*)(args.ws + WS_CTL) + CW_BAR, MISC + 8);
#endif
    const int lo = args.ph_lo, hi = args.ph_hi;
#define IN(k) (lo <= (k) && (k) < hi)
#define BOTH(k) (IN(k) && IN((k) + 1))
#if MK_PER_PHASE
#define GRID_BAR() do { if (threadIdx.x == 0) __hip_atomic_store(ctl + CW_TMO, 0xBADBA0u, RLX_AGENT); } while (0)
#else
#define GRID_BAR() xcd_barrier(bar)
#endif
#define WGU1 ((bf16*)(args.ws + WS_WGU1))
#define WGU2 ((bf16*)(args.ws + WS_WGU2))
#define WD1 ((bf16*)(args.ws + WS_WD1))
#define WD2 ((bf16*)(args.ws + WS_WD2))
#define WIN ((bf16*)(args.ws + WS_WIN))
#define WOUT ((bf16*)(args.ws + WS_WOUT))
#define R1 ((bf16*)(args.ws + WS_R1))
#define IT ((bf16*)(args.ws + WS_TT))
#define VT ((bf16*)(args.ws + WS_TT) + (size_t)HGW * MROWS)
#define R2 ((float*)(args.ws + WS_R2))
#define R3 ((bf16*)(args.ws + WS_R3))
#define LB ((float*)(args.ws + WS_LB))
#define PHASE_IDS() int tid = threadIdx.x; asm volatile("" : "+v"(tid)); const int lane = tid & 63, wave = __builtin_amdgcn_readfirstlane(tid >> 6); \
    const int gw = vcu * NWAVES + wave, NGW = G * NWAVES; (void)lane; (void)gw; (void)NGW
#define PHASE_GATEUP(k, W) if (IN(k)) { _Pragma("unroll") for (int rr_ = 0; rr_ < NREP(k); ++rr_) { \
        pg8::Gemm g{R3, (W), MROWS, 2 * FF, DM}; pg8::StaticOrder S; S.init(MROWS, 2 * FF, G, bx); \
        pg8::EpiSwiGLU E{R1, FF}; \
        pg8::gemm_phase<pg8::EpiSwiGLU, pg8::StaticOrder, G_ALIGN, G_SP2>(lds + RING_OFF, g, S, E); } \
        if (BOTH(k)) GRID_BAR(); }
#define PHASE_DOWN(k, W) if (IN(k)) { _Pragma("unroll") for (int rr_ = 0; rr_ < NREP(k); ++rr_) { \
        pg8::Gemm g{R1, (W), MROWS, DM, FF}; pg8::StaticOrder S; S.init(MROWS, DM, G, bx); \
        pg8::EpiBf16Plain E{(bf16*)R2, DM}; \
        pg8::gemm_phase<pg8::EpiBf16Plain, pg8::StaticOrder, G_ALIGN, G_SP2>(lds + RING_OFF, g, S, E); } \
        if (BOTH(k)) GRID_BAR(); }
#define PHASE_NORM(k, BASE, WGT, GPOST, G2, HASU) if (IN(k)) { PHASE_IDS(); \
        _Pragma("unroll") for (int rr_ = 0; rr_ < NREP(k); ++rr_) for (int m = gw; m < MROWS; m += NGW) \
            norm_res_row((const bf16*)R2 + (size_t)m * DM, (BASE) + (size_t)m * DM, args.out + (size_t)m * DM, (WGT), (GPOST), (G2), (HASU) ? R3 + (size_t)m * DM : (bf16*)nullptr, lane); \
        if (BOTH(k)) GRID_BAR(); }

    if (IN(0)) { PHASE_IDS();
        LAS float* scr = (LAS float*)(lds + RING_OFF + wave * 16384);
        constexpr int I_GU = (DM / 64) * (FF / 32), I_D = (FF / 64) * (DM / 32), I_IN = (DM / 64) * (16384 / 32), I_OUT = (DM / 64) * (DM / 32);
        constexpr int NITEMS = 6 * I_GU + I_IN + I_OUT;
        static_assert(I_GU == I_D, "items");
        for (int rr_ = 0; rr_ < NREP(0); ++rr_)
        for (int it = gw; it < NITEMS; it += NGW) {
            int r = it; const float* W; bf16* WT; int K = DM, N = FF, mode = 0;
            if (r < I_GU) { W = args.in[2]; WT = WGU1; mode = 1; }
            else if ((r -= I_GU) < I_GU) { W = args.in[3]; WT = WGU1; mode = 2; }
            else if ((r -= I_GU) < I_D) { W = args.in[4]; WT = WD1; K = FF; N = DM; }
            else if ((r -= I_D) < I_IN) { W = args.in[7]; WT = WIN; N = 16384; mode = 3; }
            else if ((r -= I_IN) < I_OUT) { W = args.in[11]; WT = WOUT; N = DM; }
            else if ((r -= I_OUT) < I_GU) { W = args.in[14]; WT = WGU2; mode = 1; }
            else if ((r -= I_GU) < I_GU) { W = args.in[15]; WT = WGU2; mode = 2; }
            else { r -= I_GU; W = args.in[16]; WT = WD2; K = FF; N = DM; }
            transpose_item(W, K, N, WT, mode, scr, r, lane);
        }
        for (int m = gw; m < MROWS; m += NGW) rms_row_to_bf16(args.in[0] + (size_t)m * DM, args.in[1], R3 + (size_t)m * DM, lane);
        for (int i = bx * 512 + tid; i < 2 * HGW; i += G * 512) { const float l0 = args.in[8][i], l1 = args.in[8][2 * HGW + i]; LB[i] = 1.0f / (1.0f + expf(l1 - l0)); }
        if (BOTH(0)) GRID_BAR();
    }
    PHASE_GATEUP(1, WGU1)
    PHASE_DOWN(2, WD1)
    PHASE_NORM(3, args.in[0], 0.5f, args.in[5], args.in[6], true)
    if (IN(4)) {
#pragma unroll
        for (int rr_ = 0; rr_ < NREP(4); ++rr_) {
        { pg8::Gemm g{R3, WIN, MROWS, PROJ_W, DM}; pg8::StaticOrder S; S.init(MROWS, PROJ_W, G, bx);
          pg8::EpiProj E{R1, PROJ_W, LB};
          pg8::gemm_phase<pg8::EpiProj, pg8::StaticOrder, G_ALIGN, G_SP2>(lds + RING_OFF, g, S, E); }
        { pg8::Gemm g{WIN + (size_t)PROJ_W * DM, R3, HGW + NAW, MROWS, DM}; pg8::StaticOrder S; S.init(HGW + NAW, MROWS, G, bx);
          pg8::EpiBf16Plain E{IT, MROWS};
          pg8::gemm_phase<pg8::EpiBf16Plain, pg8::StaticOrder, G_ALIGN, G_SP2>(lds + RING_OFF, g, S, E); }
        }
        if (BOTH(4)) GRID_BAR();
    }
    if (IN(5)) { PHASE_IDS();
        for (int rr_ = 0; rr_ < NREP(5); ++rr_)
        if (bx < 2 * BATCH * NHEAD) { const int dir = bx & 1, h = (bx >> 1) & 15, b = bx >> 5;
            hgrn_mfma_unit(lds + RING_OFF, R1, IT, R2 + (size_t)dir * MROWS * HGW, b, h, dir, tid); }
        { LAS float* tbl = (LAS float*)(lds + RING_OFF);
          for (int q = tid; q < NHEAD * 15 * 31; q += 512) tbl[q] = args.in[10][q];
          __syncthreads();
          const int xq = (int)(xb_xcc_id() & 7u);
          for (int rr_ = 0; rr_ < NREP(12); ++rr_)
          for (int qq = 0; qq < 8; ++qq) { const int q = (xq + qq) & 7;
            for (;;) {
              if (tid == 0) MISC[16] = __hip_atomic_fetch_add(ctl + CW_QUEUE + 64 * (8 * rr_ + q), 1u, RLX_AGENT);
              __syncthreads();
              const int li = (int)MISC[16];
              __syncthreads();
              if (li >= 256) break;
              const int rp = li & 31, bh = q * 8 + (li >> 5), h = bh & 15, b = bh >> 4;
              na_unit_mfma(tbl, R1, VT, R3, b, h, rp, wave, lane);
            } }
        }
        if (BOTH(5)) GRID_BAR();
    }
    if (IN(6)) { PHASE_IDS();
        for (int rr_ = 0; rr_ < NREP(6); ++rr_)
        for (int m = gw; m < MROWS; m += NGW)
            hgrn_combine_row(R2 + (size_t)m * HGW, R2 + (size_t)MROWS * HGW + (size_t)m * HGW, R1 + (size_t)m * PROJ_W + C_GATE, args.in[9], R3 + (size_t)m * DM, lane);
        if (BOTH(6)) GRID_BAR();
    }
    if (IN(7)) {
#pragma unroll
        for (int rr_ = 0; rr_ < NREP(7); ++rr_) {
        pg8::Gemm g{R3, WOUT, MROWS, DM, DM}; pg8::StaticOrder S; S.init(MROWS, DM, G, bx);
        pg8::EpiBf16Plain E{(bf16*)R2, DM};
        pg8::gemm_phase<pg8::EpiBf16Plain, pg8::StaticOrder, G_ALIGN, G_SP2>(lds + RING_OFF, g, S, E); }
        if (BOTH(7)) GRID_BAR();
    }
    PHASE_NORM(8, args.out, 1.0f, args.in[12], args.in[13], true)
    PHASE_GATEUP(9, WGU2)
    PHASE_DOWN(10, WD2)
    PHASE_NORM(11, args.out, 0.5f, args.in[17], args.in[17], false)
#if !MK_PER_PHASE
    if (IN(11)) { if (xb_ld((unsigned*)(args.ws + WS_CTL) + CW_BAR + XB_TMO) != 0u) { const float q = __builtin_nanf(""); for (int m = bx; m < MROWS; m += G) for (int c = threadIdx.x; c < DM; c += 512) args.out[(size_t)m * DM + c] = q; } }
#endif
#undef IN
#undef BOTH
}

extern "C" void kernel_launch(void* const* d_in, const int* in_sizes, int n_in, void* d_out, int out_size, void* d_ws, size_t ws_size, hipStream_t stream) {
    static int grid = 0;
    if (grid == 0) {
        if (n_in != 18 || in_sizes[0] != MROWS * DM || out_size != MROWS * DM || ws_size < WS_END) {
            fprintf(stderr, "kernel_launch: unexpected shapes (n_in %d, in0 %d, out %d, ws %zu need %zu); nothing launched\n", n_in, n_in > 0 ? in_sizes[0] : -1, out_size, ws_size, (size_t)WS_END); grid = -1; return; }
        int dev = 0, cus = 0;
        if (hipGetDevice(&dev) != hipSuccess || hipDeviceGetAttribute(&cus, hipDeviceAttributeMultiprocessorCount, dev) != hipSuccess) { grid = -1; return; }
        if (hipFuncSetAttribute((const void*)fwd_kernel, hipFuncAttributeMaxDynamicSharedMemorySize, LDS_BYTES) != hipSuccess) { fprintf(stderr, "kernel_launch: hipFuncSetAttribute failed\n"); grid = -1; return; }
        int per_cu = 0;
        if (hipOccupancyMaxActiveBlocksPerMultiprocessor(&per_cu, (const void*)fwd_kernel, NWAVES * 64, LDS_BYTES) != hipSuccess || per_cu < 1)
            fprintf(stderr, "kernel_launch: note: occupancy query reports %d workgroups per CU\n", per_cu);
        (void)hipGetLastError();
        grid = cus;
    }
    if (grid < 0) return;
    if (hipMemsetAsync((char*)d_ws + WS_CTL, 0, CTL_ZERO_BYTES, stream) != hipSuccess) { fprintf(stderr, "kernel_launch: memset failed\n"); return; }
    Args a{};
    for (int i = 0; i < 18; ++i) a.in[i] = (const float*)d_in[i];
    a.out = (float*)d_out; a.ws = (unsigned char*)d_ws;
#if MK_PER_PHASE
    for (int p = 0; p < N_PHASES; ++p) { a.ph_lo = p; a.ph_hi = p + 1; hipLaunchKernelGGL(fwd_kernel, dim3(grid), dim3(NWAVES * 64), LDS_BYTES, stream, a); }
#else
    a.ph_lo = 0; a.ph_hi = N_PHASES;
    hipLaunchKernelGGL(fwd_kernel, dim3(grid), dim3(NWAVES * 64), LDS_BYTES, stream, a);
#endif
    const hipError_t le = hipPeekAtLastError();
    if (le != hipSuccess) fprintf(stderr, "kernel_launch: launch failed: %s\n", hipGetErrorName(le));
}
```

```cpp
#include <hip/hip_runtime.h>
#include <cstdio>
#include <cstdint>

#ifndef REPEAT_MASK
#define REPEAT_MASK 0
#endif
#define NREP(k) (1 + ((REPEAT_MASK >> (k)) & 1))
#ifndef G_SP2
#define G_SP2 true
#endif
#ifndef G_ALIGN
#define G_ALIGN true
#endif
#ifndef EPI_TWICE
#define EPI_TWICE 0
#endif
#ifndef DIAG_BAR
#define DIAG_BAR 0
#endif
#ifndef P7_INNER_REP
#define P7_INNER_REP 1
#endif
#ifndef WGM_GU
#define WGM_GU 8
#endif
#ifndef WGM_IN
#define WGM_IN 8
#endif
#ifndef WGM_OUT
#define WGM_OUT 4
#endif
#ifndef WGM_TT
#define WGM_TT 4
#endif
#ifndef WGM_DOWN
#define WGM_DOWN 4
#endif
#ifndef EXTRA_BARS
#define EXTRA_BARS 0
#endif
#ifndef MK_PER_PHASE
#define MK_PER_PHASE 0
#endif

namespace pg8 {
#define PG8_LAS __attribute__((address_space(3)))
typedef unsigned short bf16_t;
typedef short bf16x8 __attribute__((ext_vector_type(8)));
typedef float f32x4 __attribute__((ext_vector_type(4)));
typedef unsigned u32x4 __attribute__((ext_vector_type(4)));
constexpr int BM = 256, BK = 64, HALF = 128, HTB = HALF * BK * 2  , STAGE_BYTES = 8 * HTB, NXCD = 8, WGM = 8;

__host__ __device__ __forceinline__ int lds_byte(int r, int c) { const int st = (r >> 4) * 2 + (c >> 5), rr = r & 15, cc = c & 31, ob = rr * 64 + cc * 2; return st * 1024 + (ob ^ (((ob >> 9) & 1) << 5)); }
__host__ __device__ __forceinline__ void stage_rc(int b, int& R, int& C) { const int st = b / 1024, sb = b % 1024, swz = sb ^ (((sb >> 9) & 1) << 5); R = (st >> 1) * 16 + swz / 64; C = (st & 1) * 32 + (swz % 64) / 2; }
__host__ __device__ __forceinline__ int perm32(int rho) { const int n = rho >> 4, i = rho & 15; return 8 * (i >> 2) + 4 * n + (i & 3); }

struct Unit { int pm, pn; };
struct Gemm { const bf16_t* A; const bf16_t* Bt; int M, N, K; };

struct StaticOrder {
    int nM, nN, nwg, G, c, nrep = 1, wgm = WGM;
    __host__ __device__ void init(int M, int N, int G_, int c_) { nM = M / BM; nN = N / BM; nwg = nM * nN; G = G_; c = c_; }
    __host__ __device__ bool next(int i, Unit& u) const {
        long L = (long)i * G + c; if (L >= (long)nwg * nrep) return false; L %= nwg;
        int wgid = (int)L; { const int q = nwg / NXCD, r = nwg % NXCD, xcd = wgid % NXCD, off = wgid / NXCD; wgid = (xcd < r ? xcd * (q + 1) : r * (q + 1) + (xcd - r) * q) + off; }
        const int nig = wgm * nN, gid = wgid / nig, fm = gid * wgm, gsz = (nM - fm) < wgm ? (nM - fm) : wgm;
        u.pm = fm + ((wgid % nig) % gsz); u.pn = (wgid % nig) / gsz; return true;
    }
    __device__ __forceinline__ void a_ready(const Unit&) const {}
    __device__ __forceinline__ void done(const Unit&) const {}
};

typedef float f32x2_t __attribute__((ext_vector_type(2)));
typedef __bf16 bf16x2_t __attribute__((ext_vector_type(2)));
__device__ __forceinline__ unsigned cvt_pk_bf16(float lo, float hi) { const f32x2_t v = {lo, hi}; const bf16x2_t b = __builtin_convertvector(v, bf16x2_t); return __builtin_bit_cast(unsigned, b); }
__device__ __forceinline__ unsigned cvt_pk_f16(float lo, float hi) { typedef _Float16 h2 __attribute__((ext_vector_type(2))); h2 v; v.x = (_Float16)lo; v.y = (_Float16)hi; return __builtin_bit_cast(unsigned, v); }
__device__ __forceinline__ float sigmoidf_fast(float v) { return __builtin_amdgcn_rcpf(1.0f + __builtin_amdgcn_exp2f(-1.4426950408889634f * v)); }

struct EpiF32 {
    static constexpr bool PERM = false, AFTER_DRAIN = false;
    float* C; int ldc;
    __device__ __forceinline__ void operator()(const f32x4 (&acc)[2][2][4][2], const Unit& u, int wr, int wc, int fr, int fq) const {
        const int row0 = u.pm * BM + wr * 64 + fr, col0 = u.pn * BM + wc * 32 + 4 * fq;
#pragma unroll
        for (int ai = 0; ai < 2; ++ai)
#pragma unroll
            for (int m = 0; m < 4; ++m) { float* rowp = C + (size_t)(row0 + ai * HALF + m * 16) * ldc + col0;
#pragma unroll
                for (int bj = 0; bj < 2; ++bj)
#pragma unroll
                    for (int n = 0; n < 2; ++n) *(f32x4*)(rowp + bj * HALF + n * 16) = acc[ai][bj][m][n]; }
    }
};
struct EpiBf16Plain {
    static constexpr bool PERM = true, AFTER_DRAIN = false;
    bf16_t* O; int ldc; const float* rs;
    __device__ __forceinline__ void operator()(const f32x4 (&acc)[2][2][4][2], const Unit& u, int wr, int wc, int fr, int fq) const {
        const int row0 = u.pm * BM + wr * 64 + fr, col0 = u.pn * BM + wc * 32 + 8 * fq;
#pragma unroll
        for (int ai = 0; ai < 2; ++ai)
#pragma unroll
            for (int m = 0; m < 4; ++m) { bf16_t* rowp = O + (size_t)(row0 + ai * HALF + m * 16) * ldc + col0;
                const float r = rs ? rs[row0 + ai * HALF + m * 16] : 1.0f;
#pragma unroll
                for (int bj = 0; bj < 2; ++bj) { const f32x4 v0 = acc[ai][bj][m][0] * r, v1 = acc[ai][bj][m][1] * r;
                    u32x4 w; w.x = cvt_pk_bf16(v0[0], v0[1]); w.y = cvt_pk_bf16(v0[2], v0[3]); w.z = cvt_pk_bf16(v1[0], v1[1]); w.w = cvt_pk_bf16(v1[2], v1[3]);
                    *(u32x4*)(rowp + bj * HALF) = w; } }
    }
};
struct EpiBf16ColScaleNP {
    static constexpr bool PERM = false, AFTER_DRAIN = false;
    bf16_t* O; int ldc; const float* cs;
    __device__ __forceinline__ void operator()(const f32x4 (&acc)[2][2][4][2], const Unit& u, int wr, int wc, int fr, int fq) const {
        const int row0 = u.pm * BM + wr * 64 + fr, col0 = u.pn * BM + wc * 32 + 4 * fq;
        f32x4 c[2][2];
#pragma unroll
        for (int bj = 0; bj < 2; ++bj)
#pragma unroll
            for (int n = 0; n < 2; ++n) c[bj][n] = *(const f32x4*)(cs + col0 + bj * HALF + n * 16);
#pragma unroll
        for (int ai = 0; ai < 2; ++ai)
#pragma unroll
            for (int m = 0; m < 4; ++m) { bf16_t* rowp = O + (size_t)(row0 + ai * HALF + m * 16) * ldc + col0;
#pragma unroll
                for (int bj = 0; bj < 2; ++bj)
#pragma unroll
                    for (int n = 0; n < 2; ++n) { const f32x4 v = acc[ai][bj][m][n] * c[bj][n];
                        typedef unsigned u32x2 __attribute__((ext_vector_type(2)));
                        u32x2 w; w.x = cvt_pk_bf16(v[0], v[1]); w.y = cvt_pk_bf16(v[2], v[3]);
                        *(u32x2*)(rowp + bj * HALF + n * 16) = w; } }
    }
};
struct EpiBf16ColScale {
    static constexpr bool PERM = true, AFTER_DRAIN = false;
    bf16_t* O; int ldc; const float* cs;
    __device__ __forceinline__ void operator()(const f32x4 (&acc)[2][2][4][2], const Unit& u, int wr, int wc, int fr, int fq) const {
        const int row0 = u.pm * BM + wr * 64 + fr, col0 = u.pn * BM + wc * 32 + 8 * fq;
        f32x4 c0[2], c1[2];
#pragma unroll
        for (int bj = 0; bj < 2; ++bj) { c0[bj] = *(const f32x4*)(cs + col0 + bj * HALF); c1[bj] = *(const f32x4*)(cs + col0 + bj * HALF + 4); }
#pragma unroll
        for (int ai = 0; ai < 2; ++ai)
#pragma unroll
            for (int m = 0; m < 4; ++m) { bf16_t* rowp = O + (size_t)(row0 + ai * HALF + m * 16) * ldc + col0;
#pragma unroll
                for (int bj = 0; bj < 2; ++bj) { const f32x4 v0 = acc[ai][bj][m][0] * c0[bj], v1 = acc[ai][bj][m][1] * c1[bj];
                    u32x4 w; w.x = cvt_pk_bf16(v0[0], v0[1]); w.y = cvt_pk_bf16(v0[2], v0[3]); w.z = cvt_pk_bf16(v1[0], v1[1]); w.w = cvt_pk_bf16(v1[2], v1[3]);
                    *(u32x4*)(rowp + bj * HALF) = w; } }
    }
};
struct EpiSwiGLU {
    static constexpr bool PERM = true, AFTER_DRAIN = false;
    bf16_t* H; int ldc; const float* rs;
    __device__ __forceinline__ size_t tiled(int hp, int pn, int wr, int wc, int fr, int fq) const {
        return ((size_t)hp * (size_t)(ldc >> 6) + (size_t)(pn * 2 + (wc >> 1))) * 16384u + (size_t)lds_byte(wr * 64 + fr, (wc & 1) * 32 + 8 * fq); }
    __device__ __forceinline__ void operator()(const f32x4 (&acc)[2][2][4][2], const Unit& u, int wr, int wc, int fr, int fq) const {
        const int row0 = u.pm * BM + wr * 64 + fr;
#pragma unroll
        for (int ai = 0; ai < 2; ++ai)
#pragma unroll
            for (int m = 0; m < 4; ++m) { bf16_t* rowp = (bf16_t*)((unsigned char*)H + tiled(u.pm * 2 + ai, u.pn, wr, wc, fr, fq) + m * 2048);
                const float r = rs ? rs[row0 + ai * HALF + m * 16] : 1.0f;
                float h[8], gg[8], tt[8];
#pragma unroll
                for (int n = 0; n < 2; ++n)
#pragma unroll
                    for (int e = 0; e < 4; ++e) gg[4 * n + e] = acc[ai][0][m][n][e] * r;
#pragma unroll
                for (int q = 0; q < 8; ++q) tt[q] = __builtin_amdgcn_exp2f(-gg[q]);
#pragma unroll
                for (int n = 0; n < 2; ++n)
#pragma unroll
                    for (int e = 0; e < 4; ++e) h[4 * n + e] = gg[4 * n + e] * acc[ai][1][m][n][e];
#pragma unroll
                for (int q = 0; q < 8; ++q) tt[q] = 1.0f + tt[q];
#pragma unroll
                for (int q = 0; q < 8; ++q) tt[q] = __builtin_amdgcn_rcpf(tt[q]);
#pragma unroll
                for (int q = 0; q < 8; ++q) h[q] = h[q] * tt[q];
                u32x4 w; w.x = cvt_pk_bf16(h[0], h[1]); w.y = cvt_pk_bf16(h[2], h[3]); w.z = cvt_pk_bf16(h[4], h[5]); w.w = cvt_pk_bf16(h[6], h[7]);
                *(u32x4*)rowp = w; }
    }
    __device__ __forceinline__ void half(const f32x4 (&acc)[2][2][4][2], int pmh, int pn, int wr, int wc, int fr, int fq) const {
        const int row0 = pmh * HALF + wr * 64 + fr;
#pragma unroll
        for (int m = 0; m < 4; ++m) { bf16_t* rowp = (bf16_t*)((unsigned char*)H + tiled(pmh, pn, wr, wc, fr, fq) + m * 2048);
            const float r = rs ? rs[row0 + m * 16] : 1.0f;
            float h[8];
#pragma unroll
            for (int n = 0; n < 2; ++n)
#pragma unroll
                for (int e = 0; e < 4; ++e) { const float g = acc[0][0][m][n][e] * r, up = acc[0][1][m][n][e]; h[4 * n + e] = g * __builtin_amdgcn_rcpf(1.0f + __builtin_amdgcn_exp2f(-g)) * up; }
            u32x4 w; w.x = cvt_pk_bf16(h[0], h[1]); w.y = cvt_pk_bf16(h[2], h[3]); w.z = cvt_pk_bf16(h[4], h[5]); w.w = cvt_pk_bf16(h[6], h[7]);
            *(u32x4*)rowp = w; }
    }
};
struct EpiProj {
    static constexpr bool PERM = true, AFTER_DRAIN = false;
    bf16_t* P; int ldc; const float* lb; const float* rs;
    __device__ __forceinline__ void operator()(const f32x4 (&acc)[2][2][4][2], const Unit& u, int wr, int wc, int fr, int fq) const {
        const int sec = u.pn >> 3;
        const int row0 = u.pm * BM + wr * 64 + fr, col0 = u.pn * BM + wc * 32 + 8 * fq;
        const bool isg = (sec == 1 || sec == 2), act = (sec == 0 || sec == 3); const float sc = (sec == 4) ? 0.08838834764831845f : 1.0f;
        const float* lbp = lb + (isg ? (col0 - 2048) : 0);
#pragma unroll
        for (int ai = 0; ai < 2; ++ai)
#pragma unroll
            for (int m = 0; m < 4; ++m) { bf16_t* rowp = P + (size_t)(row0 + ai * HALF + m * 16) * ldc + col0;
                const float r = rs[row0 + ai * HALF + m * 16];
#pragma unroll
                for (int bj = 0; bj < 2; ++bj) { float g[8]; u32x4 w;
                    if (isg) {
                        const f32x4 la = *(const f32x4*)(lbp + bj * HALF), lc = *(const f32x4*)(lbp + bj * HALF + 4);
#pragma unroll
                        for (int e = 0; e < 4; ++e) { const float f0 = la[e] + (1.0f - la[e]) * sigmoidf_fast(acc[ai][bj][m][0][e] * r), f1 = lc[e] + (1.0f - lc[e]) * sigmoidf_fast(acc[ai][bj][m][1][e] * r);
                            g[e] = __builtin_amdgcn_logf(f0); g[4 + e] = __builtin_amdgcn_logf(f1); }
                        w.x = cvt_pk_f16(g[0], g[1]); w.y = cvt_pk_f16(g[2], g[3]); w.z = cvt_pk_f16(g[4], g[5]); w.w = cvt_pk_f16(g[6], g[7]);
                    } else {
#pragma unroll
                        for (int n = 0; n < 2; ++n)
#pragma unroll
                            for (int e = 0; e < 4; ++e) { const float v = acc[ai][bj][m][n][e] * r; g[4 * n + e] = act ? v * sigmoidf_fast(v) : v * sc; }
                        w.x = cvt_pk_bf16(g[0], g[1]); w.y = cvt_pk_bf16(g[2], g[3]); w.z = cvt_pk_bf16(g[4], g[5]); w.w = cvt_pk_bf16(g[6], g[7]);
                    }
                    *(u32x4*)(rowp + bj * HALF) = w; }
                asm volatile("" ::: "memory"); }
    }
};

template <class Epi, class Sched, bool ALIGN_EPI = false, bool SP2 = false, bool B_TILED = false, bool A_TILED = false>
__device__ __forceinline__ void gemm_phase(PG8_LAS unsigned char* lds, const Gemm g, const Sched& S, const Epi& E) {
    int tid_ = threadIdx.x; asm volatile("" : "+v"(tid_));
    const int tid = tid_, wid = __builtin_amdgcn_readfirstlane(tid >> 6), lane = tid & 63, wr = wid >> 2, wc = wid & 3, fr = lane & 15, fq = lane >> 4;
    const int K = g.K, nt = K / BK;
    unsigned voffA[2], voffB[2];
#pragma unroll
    for (int i = 0; i < 2; ++i) { int R, C; stage_rc(wid * 2048 + lane * 16 + i * 1024, R, C); const int Rb = Epi::PERM ? ((R & ~31) + perm32(R & 31)) : R;
        voffA[i] = A_TILED ? (unsigned)(wid * 2048 + lane * 16 + i * 1024) : (unsigned)(R * K + C) * 2u; voffB[i] = B_TILED ? (unsigned)(wid * 2048 + lane * 16 + i * 1024) : (unsigned)(Rb * K + C) * 2u; }
    const size_t kstep = A_TILED ? (size_t)HTB : (size_t)(BK * 2), kstepB = B_TILED ? (size_t)HTB : (size_t)(BK * 2);
    const size_t hstep = (size_t)HALF * K * 2;
    const size_t tstep = 2 * hstep;
    const unsigned ldsw = (unsigned)wid * 2048u;
    const int aoff = lds_byte(wr * 64 + fr, fq * 8), boff = lds_byte(wc * 32 + fr, fq * 8);
#define PG8_SA(b, h) (((b) * 2 + (h)) * HTB)
#define PG8_SB(b, h) ((4 + (b) * 2 + (h)) * HTB)
#define PG8_STAGE(bufoff, gbase, voff) do { const char* gb_ = (const char*)(gbase); asm volatile("" : "+s"(gb_)); _Pragma("unroll") for (int _i = 0; _i < 2; ++_i) { asm volatile("" : "+v"((voff)[_i])); \
        __builtin_amdgcn_global_load_lds((const unsigned*)(gb_ + (voff)[_i]), (PG8_LAS unsigned*)(lds + (bufoff) + ldsw + _i * 1024), 16, 0, 0); } } while (0)
#define PG8_LDA(dst, b, h) do { _Pragma("unroll") for (int m = 0; m < 4; ++m) _Pragma("unroll") for (int k = 0; k < 2; ++k) dst[m][k] = *(const PG8_LAS bf16x8*)(lds + PG8_SA(b, h) + aoff + m * 2048 + k * 1024); } while (0)
#define PG8_LDB(dst, b, h) do { _Pragma("unroll") for (int n = 0; n < 2; ++n) _Pragma("unroll") for (int k = 0; k < 2; ++k) dst[n][k] = *(const PG8_LAS bf16x8*)(lds + PG8_SB(b, h) + boff + n * 2048 + k * 1024); } while (0)
#define PG8_PRIO_IN(v) ((void)0)
#define PG8_PRIO_BLK(v) __builtin_amdgcn_s_setprio(v)
#define PG8_MMA(ai, bj, At, Bt) do { PG8_PRIO_IN(1); _Pragma("unroll") for (int k = 0; k < 2; ++k) _Pragma("unroll") for (int m = 0; m < 4; ++m) _Pragma("unroll") for (int nn = 0; nn < 2; ++nn) { const int n = (m & 1) ? 1 - nn : nn; \
        acc[ai][bj][m][n] = __builtin_amdgcn_mfma_f32_16x16x32_bf16(Bt[n][k], At[m][k], acc[ai][bj][m][n], 0, 0, 0); } PG8_PRIO_IN(0); } while (0)
#define PG8_MMA0(ai, bj, At, Bt) do { PG8_PRIO_IN(1); _Pragma("unroll") for (int k = 0; k < 2; ++k) _Pragma("unroll") for (int m = 0; m < 4; ++m) _Pragma("unroll") for (int nn = 0; nn < 2; ++nn) { const int n = (m & 1) ? 1 - nn : nn; \
        acc[ai][bj][m][n] = __builtin_amdgcn_mfma_f32_16x16x32_bf16(Bt[n][k], At[m][k], (k == 0) ? (f32x4){0.f, 0.f, 0.f, 0.f} : acc[ai][bj][m][n], 0, 0, 0); } PG8_PRIO_IN(0); } while (0)
#define PG8_WAIT_V(n) asm volatile("s_waitcnt vmcnt(" #n ")" ::: "memory")
#define PG8_WAIT_L(n) asm volatile("s_waitcnt lgkmcnt(" #n ")" ::: "memory")
#define PG8_BAR __builtin_amdgcn_s_barrier()
#define PG8_SCHED __builtin_amdgcn_sched_barrier(0)
    Unit cur, nxt; int ui = 0;
    if (!S.next(0, cur)) return;
    f32x4 acc[2][2][4][2];
    if constexpr (!SP2) {
#pragma unroll
    for (int a = 0; a < 2; ++a)
#pragma unroll
        for (int b = 0; b < 2; ++b)
#pragma unroll
            for (int m = 0; m < 4; ++m)
#pragma unroll
                for (int n = 0; n < 2; ++n) acc[a][b][m][n] = (f32x4){0.f, 0.f, 0.f, 0.f};
    }
    bf16x8 At[4][2], B0[2][2], B1[2][2];
    const char* cA = (const char*)g.A + (size_t)cur.pm * tstep; const char* cB = (const char*)g.Bt + (size_t)cur.pn * tstep;
    S.a_ready(cur);
    if constexpr (SP2) {
        PG8_STAGE(PG8_SB(0, 0), cB, voffB); PG8_STAGE(PG8_SB(0, 1), cB + hstep, voffB); PG8_STAGE(PG8_SA(0, 0), cA, voffA); PG8_STAGE(PG8_SA(0, 1), cA + hstep, voffA);
        if (wr == 1) PG8_BAR;
        PG8_WAIT_V(2); PG8_BAR;
        PG8_STAGE(PG8_SB(1, 0), cB + kstepB, voffB); PG8_STAGE(PG8_SA(1, 0), cA + kstep, voffA); PG8_STAGE(PG8_SB(1, 1), cB + hstep + kstepB, voffB);
        PG8_WAIT_V(6); PG8_BAR;
    } else {
        PG8_STAGE(PG8_SB(0, 0), cB, voffB); PG8_STAGE(PG8_SA(0, 0), cA, voffA); PG8_STAGE(PG8_SB(0, 1), cB + hstep, voffB); PG8_STAGE(PG8_SA(0, 1), cA + hstep, voffA);
        if (wr == 1) PG8_BAR;
        PG8_WAIT_V(4); PG8_BAR;
        PG8_STAGE(PG8_SB(1, 0), cB + kstepB, voffB); PG8_STAGE(PG8_SA(1, 0), cA + kstep, voffA); PG8_STAGE(PG8_SB(1, 1), cB + hstep + kstepB, voffB);
        PG8_WAIT_V(6); PG8_BAR;
    }
    for (;;) {
        const bool has_next = S.next(ui + 1, nxt);
        const char* nA = has_next ? (const char*)g.A + (size_t)nxt.pm * tstep : cA; const char* nB = has_next ? (const char*)g.Bt + (size_t)nxt.pn * tstep : cB;
#define PG8_PTRS() const bool last = (t == nt - 2); \
            const char* a1 = cA + (size_t)(t + 1) * kstep; \
            const char* a2 = last ? nA : cA + (size_t)(t + 2) * kstep; const char* b2 = last ? nB : cB + (size_t)(t + 2) * kstepB; \
            const char* a3 = a2 + kstep; const char* b3 = b2 + kstepB; \
            if (last && has_next) S.a_ready(nxt)
#define PG8_SP2_PAIR(MF) do { PG8_PTRS(); \
            PG8_LDB(B0, 0, 0); PG8_LDB(B1, 0, 1); PG8_SCHED; PG8_LDA(At, 0, 0); PG8_STAGE(PG8_SA(1, 1), a1 + hstep, voffA); \
            PG8_WAIT_V(8); PG8_WAIT_L(0); PG8_BAR; PG8_PRIO_BLK(1); MF(0, 0, At, B0); MF(0, 1, At, B1); PG8_PRIO_BLK(0); PG8_BAR; PG8_SCHED; \
            PG8_LDA(At, 0, 1); PG8_STAGE(PG8_SB(0, 0), b2, voffB); PG8_STAGE(PG8_SB(0, 1), b2 + hstep, voffB); PG8_STAGE(PG8_SA(0, 0), a2, voffA); \
            PG8_WAIT_V(8); PG8_WAIT_L(0); PG8_BAR; PG8_PRIO_BLK(1); MF(1, 0, At, B0); MF(1, 1, At, B1); PG8_PRIO_BLK(0); PG8_BAR; PG8_SCHED; \
            PG8_LDB(B0, 1, 0); PG8_LDB(B1, 1, 1); PG8_SCHED; PG8_LDA(At, 1, 0); PG8_STAGE(PG8_SA(0, 1), a2 + hstep, voffA); \
            PG8_WAIT_V(8); PG8_WAIT_L(0); PG8_BAR; PG8_PRIO_BLK(1); PG8_MMA(0, 0, At, B0); PG8_MMA(0, 1, At, B1); PG8_PRIO_BLK(0); PG8_BAR; PG8_SCHED; \
            PG8_LDA(At, 1, 1); PG8_STAGE(PG8_SB(1, 0), b3, voffB); PG8_STAGE(PG8_SB(1, 1), b3 + hstep, voffB); PG8_STAGE(PG8_SA(1, 0), a3, voffA); \
            PG8_WAIT_V(8); PG8_WAIT_L(0); PG8_BAR; PG8_PRIO_BLK(1); PG8_MMA(1, 0, At, B0); PG8_MMA(1, 1, At, B1); PG8_PRIO_BLK(0); PG8_BAR; PG8_SCHED; } while (0)
        if constexpr (SP2) {
            { const int t = 0; PG8_SP2_PAIR(PG8_MMA0); }
            for (int t = 2; t < nt; t += 2) PG8_SP2_PAIR(PG8_MMA);
        } else {
        for (int t = 0; t < nt; t += 2) {
            PG8_PTRS();
            {
            PG8_LDB(B0, 0, 0); PG8_SCHED; PG8_LDA(At, 0, 0); PG8_STAGE(PG8_SA(1, 1), a1 + hstep, voffA);
            PG8_WAIT_L(8); PG8_BAR; PG8_WAIT_L(0); PG8_MMA(0, 0, At, B0); PG8_BAR; PG8_SCHED;
            PG8_LDB(B1, 0, 1); PG8_STAGE(PG8_SB(0, 0), b2, voffB);
            PG8_BAR; PG8_WAIT_L(0); PG8_MMA(0, 1, At, B1); PG8_BAR;
            PG8_LDA(At, 0, 1); PG8_STAGE(PG8_SA(0, 0), a2, voffA);
            PG8_BAR; PG8_WAIT_L(0); PG8_MMA(1, 0, At, B0); PG8_BAR; PG8_SCHED;
            PG8_STAGE(PG8_SB(0, 1), b2 + hstep, voffB);
            PG8_WAIT_V(6); PG8_BAR; PG8_MMA(1, 1, At, B1); PG8_BAR;
            PG8_LDB(B0, 1, 0); PG8_SCHED; PG8_LDA(At, 1, 0); PG8_STAGE(PG8_SA(0, 1), a2 + hstep, voffA);
            PG8_WAIT_L(8); PG8_BAR; PG8_WAIT_L(0); PG8_MMA(0, 0, At, B0); PG8_BAR; PG8_SCHED;
            PG8_LDB(B1, 1, 1); PG8_STAGE(PG8_SB(1, 0), b3, voffB);
            PG8_BAR; PG8_WAIT_L(0); PG8_MMA(0, 1, At, B1); PG8_BAR;
            PG8_LDA(At, 1, 1); PG8_STAGE(PG8_SA(1, 0), a3, voffA);
            PG8_BAR; PG8_WAIT_L(0); PG8_MMA(1, 0, At, B0); PG8_BAR; PG8_SCHED;
            PG8_STAGE(PG8_SB(1, 1), b3 + hstep, voffB);
            PG8_WAIT_V(6); PG8_BAR; PG8_MMA(1, 1, At, B1); PG8_BAR;
            }
        }
        }
        if constexpr (ALIGN_EPI) { if (wr == 0) PG8_BAR; }
        if constexpr (!Epi::AFTER_DRAIN) { E(acc, cur, wr, wc, fr, fq); if (EPI_TWICE) { asm volatile("" ::: "memory"); E(acc, cur, wr, wc, fr, fq); } S.done(cur); }
        if (!has_next) break;
        if constexpr (!SP2) {
#pragma unroll
        for (int a = 0; a < 2; ++a)
#pragma unroll
            for (int b = 0; b < 2; ++b)
#pragma unroll
                for (int m = 0; m < 4; ++m)
#pragma unroll
                    for (int n = 0; n < 2; ++n) acc[a][b][m][n] = (f32x4){0.f, 0.f, 0.f, 0.f};
        }
        cur = nxt; cA = nA; cB = nB; ++ui;
        if constexpr (ALIGN_EPI) { if (wr == 1) PG8_BAR; }
    }
    PG8_WAIT_V(0);
    if constexpr (!ALIGN_EPI) { if (wr == 0) PG8_BAR; }
    PG8_BAR;
}

template <class Epi, bool B_TILED = false, bool A_TILED = false>
__device__ __forceinline__ void gemm_half_units(PG8_LAS unsigned char* lds, const Gemm g, int pn0, int npn, const Epi& E, int bx, int nwg) {
    int tid_ = threadIdx.x; asm volatile("" : "+v"(tid_));
    const int tid = tid_, wid = __builtin_amdgcn_readfirstlane(tid >> 6), lane = tid & 63, wr = wid >> 2, wc = wid & 3, fr = lane & 15, fq = lane >> 4;
    const int K = g.K, nt = K / BK;
    unsigned voffA[2], voffB[2];
#pragma unroll
    for (int i = 0; i < 2; ++i) { int R, C; stage_rc(wid * 2048 + lane * 16 + i * 1024, R, C); const int Rb = Epi::PERM ? ((R & ~31) + perm32(R & 31)) : R;
        voffA[i] = A_TILED ? (unsigned)(wid * 2048 + lane * 16 + i * 1024) : (unsigned)(R * K + C) * 2u; voffB[i] = B_TILED ? (unsigned)(wid * 2048 + lane * 16 + i * 1024) : (unsigned)(Rb * K + C) * 2u; }
    const size_t kstep = A_TILED ? (size_t)HTB : (size_t)(BK * 2), kstepB = B_TILED ? (size_t)HTB : (size_t)(BK * 2);
    const size_t hstep = (size_t)HALF * K * 2;
    const size_t tstep = 2 * hstep;
    const unsigned ldsw = (unsigned)wid * 2048u;
    const int aoff = lds_byte(wr * 64 + fr, fq * 8), boff = lds_byte(wc * 32 + fr, fq * 8);
    const int nunits = (g.M / HALF) * npn;
    for (int v = bx; v < nunits; v += nwg) {
        const int xcd = v & 7, j = v >> 3, pn = pn0 + j % npn, pmh = (j / npn) * NXCD + xcd;
        f32x4 acc[2][2][4][2];
#pragma unroll
        for (int b = 0; b < 2; ++b)
#pragma unroll
            for (int m = 0; m < 4; ++m)
#pragma unroll
                for (int n = 0; n < 2; ++n) acc[0][b][m][n] = (f32x4){0.f, 0.f, 0.f, 0.f};
        bf16x8 At[4][2], B0[2][2], B1[2][2];
        const char* cA = (const char*)g.A + (size_t)pmh * hstep; const char* cB = (const char*)g.Bt + (size_t)pn * tstep;
        PG8_STAGE(PG8_SB(0, 0), cB, voffB); PG8_STAGE(PG8_SB(0, 1), cB + hstep, voffB); PG8_STAGE(PG8_SA(0, 0), cA, voffA);
        PG8_STAGE(PG8_SB(1, 0), cB + kstepB, voffB); PG8_STAGE(PG8_SB(1, 1), cB + hstep + kstepB, voffB); PG8_STAGE(PG8_SA(1, 0), cA + kstep, voffA);
        PG8_WAIT_V(6); PG8_BAR;
        for (int t = 0; t < nt; t += 2) {
            const int t2 = (t + 2 < nt) ? t + 2 : t;
            const size_t o2 = (size_t)t2 * kstep, o3 = o2 + kstep, p2 = (size_t)t2 * kstepB, p3 = p2 + kstepB;
            PG8_LDB(B0, 0, 0); PG8_LDB(B1, 0, 1); PG8_LDA(At, 0, 0); PG8_WAIT_L(0); PG8_BAR;
            PG8_STAGE(PG8_SB(0, 0), cB + p2, voffB); PG8_STAGE(PG8_SB(0, 1), cB + hstep + p2, voffB); PG8_STAGE(PG8_SA(0, 0), cA + o2, voffA);
            PG8_PRIO_BLK(1); PG8_MMA(0, 0, At, B0); PG8_MMA(0, 1, At, B1); PG8_PRIO_BLK(0);
            PG8_WAIT_V(6); PG8_BAR; PG8_SCHED;
            PG8_LDB(B0, 1, 0); PG8_LDB(B1, 1, 1); PG8_LDA(At, 1, 0); PG8_WAIT_L(0); PG8_BAR;
            PG8_STAGE(PG8_SB(1, 0), cB + p3, voffB); PG8_STAGE(PG8_SB(1, 1), cB + hstep + p3, voffB); PG8_STAGE(PG8_SA(1, 0), cA + o3, voffA);
            PG8_PRIO_BLK(1); PG8_MMA(0, 0, At, B0); PG8_MMA(0, 1, At, B1); PG8_PRIO_BLK(0);
            PG8_WAIT_V(6); PG8_BAR; PG8_SCHED;
        }
        PG8_WAIT_V(0); PG8_BAR;
        E.half(acc, pmh, pn, wr, wc, fr, fq);
    }
    PG8_WAIT_V(0); PG8_BAR;
#undef PG8_SA
#undef PG8_SB
#undef PG8_STAGE
#undef PG8_LDA
#undef PG8_LDB
#undef PG8_MMA
#undef PG8_PRIO_IN
#undef PG8_PRIO_BLK
#undef PG8_MMA0
#undef PG8_PTRS
#undef PG8_SP2_PAIR
#undef PG8_WAIT_V
#undef PG8_WAIT_L
#undef PG8_BAR
#undef PG8_SCHED
}
}

constexpr int NWAVES = 8;
constexpr int DM = 4096, BATCH = 4, SEQ = 4096, MROWS = BATCH * SEQ;
constexpr int FF = 11008, HGW = 2048, NAW = 2048, HD = 128, NHEAD = 16;
constexpr int PROJ_W = 12288;
constexpr int C_Q = 0, C_GF = 2048, C_GB = 4096, C_GATE = 6144, C_NQ = 8192, C_NK = 10240;
constexpr int GRID_W = 64, NROWS = 64, WIN_R = 8, WIN_C = 16;
constexpr float EPS = 1e-6f;
constexpr int N_PHASES = 12;
constexpr int GU_MAIN_N = 84 * 256;
static_assert(GU_MAIN_N % 256 == 0 && (2 * FF - GU_MAIN_N) % 256 == 0 && GU_MAIN_N <= 2 * FF, "gate/up split");

constexpr size_t MiB = 1u << 20;
constexpr size_t WS_CTL = 0, CTL_ZERO_BYTES = 64 * 1024;
constexpr size_t WS_LB = 1 * MiB;
constexpr size_t WS_WGU1 = 2 * MiB, WS_WD1 = 174 * MiB, WS_WIN = 260 * MiB, WS_WOUT = 388 * MiB, WS_WGU2 = 420 * MiB, WS_WD2 = 592 * MiB;
constexpr size_t WS_R1 = 678 * MiB;
constexpr size_t WS_TT = WS_R1 + 384 * MiB;
constexpr size_t WS_R2 = 1190 * MiB;
constexpr size_t WS_R3 = 1446 * MiB;
constexpr size_t WS_END = 1574 * MiB;
static_assert((size_t)2 * FF * DM * 2 <= 172 * MiB && (size_t)FF * DM * 2 <= 86 * MiB, "weights");
static_assert((size_t)MROWS * PROJ_W * 2 == 384 * MiB && (size_t)MROWS * FF * 2 <= 512 * MiB, "R1");
constexpr int CW_TMO = 0, CW_CODE = 1;
constexpr int CW_BAR = 4096;
constexpr int CW_QUEUE = 8192;

constexpr int RING_OFF = 0, RING_BYTES = 131072;
constexpr int LDSCTL_OFF = RING_BYTES, MISC_OFF = LDSCTL_OFF + 320;
constexpr int LDS_BYTES = 147456;

#define GAS __attribute__((address_space(1)))
#define LAS __attribute__((address_space(3)))
typedef unsigned short bf16;
typedef unsigned v4u __attribute__((ext_vector_type(4)));
typedef unsigned v2u __attribute__((ext_vector_type(2)));
typedef float f32x4 __attribute__((ext_vector_type(4)));
typedef GAS unsigned gu32;
#define RLX_AGENT __ATOMIC_RELAXED, __HIP_MEMORY_SCOPE_AGENT
#define LDS_WAIT() asm volatile("s_waitcnt lgkmcnt(0)" ::: "memory")
#define VM_WAIT() asm volatile("s_waitcnt vmcnt(0)" ::: "memory")
__device__ __forceinline__ unsigned f2bf(float f) { unsigned u = __builtin_bit_cast(unsigned, f); return (u + 0x7fffu + ((u >> 16) & 1u)) >> 16; }
__device__ __forceinline__ unsigned pk2(float lo, float hi) { return f2bf(lo) | (f2bf(hi) << 16); }
__device__ __forceinline__ float bf2f(unsigned short b) { return __builtin_bit_cast(float, (unsigned)b << 16); }
__device__ __forceinline__ float bflo(unsigned w) { return __builtin_bit_cast(float, w << 16); }
__device__ __forceinline__ float bfhi(unsigned w) { return __builtin_bit_cast(float, w & 0xffff0000u); }
__device__ __forceinline__ float h2f(unsigned short b) { return (float)__builtin_bit_cast(_Float16, b); }

#define XB_TMO      128
#define XB_XCNT(j)  (256  + 64 * (j))
#define XB_XSUB(j)  (1280 + 64 * (j))
#define XB_XGEN(j)  (2304 + 64 * (j))
#define XB_TOP      3328
#define XB_TOPGEN   3392
#define XCD_BAR_WORDS 3456
#define XB_SPIN_CAP (1u << 18)
__device__ __forceinline__ unsigned xb_ld(unsigned* p)              { return __hip_atomic_load(p, __ATOMIC_RELAXED, __HIP_MEMORY_SCOPE_AGENT); }
__device__ __forceinline__ unsigned xb_add(unsigned* p, unsigned v) { return __hip_atomic_fetch_add(p, v, __ATOMIC_RELAXED, __HIP_MEMORY_SCOPE_AGENT); }
__device__ __forceinline__ unsigned xb_xcc_id() { return (unsigned)__builtin_amdgcn_s_getreg((3 << 11) | 20) & 0xFu; }
#define XB_SPIN(cond, bar) do { unsigned _sp = 0; while (cond) { __builtin_amdgcn_s_sleep(1); \
    if ((++_sp & 255u) == 0u) { if (xb_ld(&(bar)[XB_TMO])) break; if (_sp > XB_SPIN_CAP) { atomicAdd(&(bar)[XB_TMO], 1u); break; } } } } while (0)
struct XcdBarrier { unsigned* bar; unsigned x; volatile LAS unsigned* st; };
__device__ __forceinline__ XcdBarrier xcd_barrier_post(unsigned* bar, volatile LAS unsigned* st) {
    XcdBarrier b; b.bar = bar; b.x = xb_xcc_id(); b.st = st;
    if (threadIdx.x == 0) (void)xb_add(&bar[XB_XCNT(b.x)], 1u);
    return b;
}
__device__ __forceinline__ void xcd_barrier_complete(unsigned* bar, unsigned x, unsigned& nloc, unsigned& nx) {
    const unsigned G = gridDim.x * gridDim.y * gridDim.z;
    unsigned sum, cnt, mine, sp = 0u;
    for (;;) {
        sum = 0u; cnt = 0u; mine = 0u;
#pragma unroll
        for (unsigned j = 0; j < 16; ++j) { const unsigned c = xb_ld(&bar[XB_XCNT(j)]); sum += c; cnt += (c > 0u) ? 1u : 0u; mine = (j == x) ? c : mine; }
        if (sum == G) break;
        __builtin_amdgcn_s_sleep(1);
        if ((++sp & 255u) == 0u) { if (xb_ld(&bar[XB_TMO])) break; if (sp > XB_SPIN_CAP) { atomicAdd(&bar[XB_TMO], 1u); break; } }
    }
    nloc = mine > 0u ? mine : 1u; nx = cnt > 0u ? cnt : 1u;
}
__device__ __forceinline__ void xcd_barrier(const XcdBarrier& b) {
    asm volatile("s_waitcnt vmcnt(0)" ::: "memory");
    __syncthreads();
    if (threadIdx.x == 0) {
        unsigned* bar = b.bar;
        __builtin_amdgcn_s_waitcnt(0);
        unsigned nloc = b.st[0], nx = b.st[1];
        if (nloc == 0u) { xcd_barrier_complete(bar, b.x, nloc, nx); b.st[0] = nloc; b.st[1] = nx; }
        const unsigned old = xb_add(&bar[XB_XSUB(b.x)], 1u);
        const unsigned gen = old / nloc;
        if (old + 1u == (gen + 1u) * nloc) {
            __builtin_amdgcn_fence(__ATOMIC_RELEASE, "agent");
            asm volatile("s_waitcnt vmcnt(0)" ::: "memory");
            const unsigned og = xb_add(&bar[XB_TOP], 1u);
            const unsigned tg = og / nx;
            if (og + 1u == (tg + 1u) * nx) xb_add(&bar[XB_TOPGEN], 1u);
            else XB_SPIN(xb_ld(&bar[XB_TOPGEN]) == tg, bar);
            __builtin_amdgcn_fence(__ATOMIC_ACQUIRE, "agent");
            xb_add(&bar[XB_XGEN(b.x)], 1u);
            asm volatile("s_waitcnt vmcnt(0)" ::: "memory");
        } else {
            XB_SPIN(xb_ld(&bar[XB_XGEN(b.x)]) == gen, bar);
            __builtin_amdgcn_fence(__ATOMIC_ACQUIRE, "agent");
            asm volatile("s_waitcnt vmcnt(0)" ::: "memory");
        }
    }
    __syncthreads();
}

__device__ __forceinline__ float wave_sum(float v) {
#pragma unroll
    for (int o = 1; o < 64; o <<= 1) v += __shfl_xor(v, o);
    return v;
}
__device__ __forceinline__ float wave_max(float v) {
#pragma unroll
    for (int o = 1; o < 64; o <<= 1) v = fmaxf(v, __shfl_xor(v, o));
    return v;
}
__device__ __forceinline__ void transpose_item(const float* W, int K, int N, bf16* WT, int mode, LAS float* scr, int item, int lane, const float* gain, int tiled_rows, float wscale) {
    const int nblk = N / 32, kb = item / nblk, nb = item % nblk, k0 = 64 * kb, n0 = 32 * nb;
    const int rbase = (mode == 0) ? n0 : (mode == 3) ? (((0x75436210u >> (4 * (n0 >> 11))) & 7u) * 2048 + (n0 & 2047)) : (256 * (n0 >> 7) + (n0 & 127) + (mode == 2 ? 128 : 0));
#pragma unroll 8
    for (int i = 0; i < 32; ++i) { const int kk = 2 * i + (lane >> 5); scr[kk * 33 + (lane & 31)] = W[(size_t)(k0 + kk) * N + n0 + (lane & 31)]; }
    LDS_WAIT(); asm volatile("" ::: "memory");
    const int c = lane & 7;
    f32x4 ga = (f32x4){1.f, 1.f, 1.f, 1.f}, gb = ga;
    if (gain) { ga = *(const GAS f32x4*)(gain + k0 + 8 * c); gb = *(const GAS f32x4*)(gain + k0 + 8 * c + 4); }
    ga = ga * wscale; gb = gb * wscale;
#pragma unroll
    for (int j = 0; j < 4; ++j) { const int n = (lane >> 3) + 8 * j; const LAS float* s = scr + (8 * c) * 33 + n;
        v4u o; o.x = pk2(s[0 * 33] * ga.x, s[1 * 33] * ga.y); o.y = pk2(s[2 * 33] * ga.z, s[3 * 33] * ga.w); o.z = pk2(s[4 * 33] * gb.x, s[5 * 33] * gb.y); o.w = pk2(s[6 * 33] * gb.z, s[7 * 33] * gb.w);
        const int r = rbase + n;
        size_t ob;
        if (r < tiled_rows) { const int rr = r & 127, x = rr & 31, R = (rr & ~31) + 16 * ((x >> 2) & 1) + 4 * (x >> 3) + (x & 3);
            ob = ((size_t)(r >> 7) * (size_t)(K >> 6) + (size_t)(k0 >> 6)) * 16384u + (size_t)pg8::lds_byte(R, 8 * c); }
        else ob = ((size_t)r * K + k0 + 8 * c) * 2;
        *(GAS v4u*)((GAS unsigned char*)WT + ob) = o; }
    LDS_WAIT(); asm volatile("" ::: "memory");
}
__device__ __forceinline__ size_t tiled_off(int m, int k, int ktiles) { return ((size_t)(m >> 7) * (size_t)ktiles + (size_t)(k >> 6)) * 16384u + (size_t)pg8::lds_byte(m & 127, k & 63); }
__device__ __forceinline__ void rms_rowpair_to_bf16_tiled(const float* x, bf16* obase, int m0, int lane) {
    const int li = lane & 31, m = m0 + (lane >> 5);
    const GAS f32x4* xr = (const GAS f32x4*)(x + (size_t)m * DM) + li;
    f32x4 v[32]; float ss = 0.f;
#pragma unroll
    for (int j = 0; j < 32; ++j) v[j] = xr[32 * j];
#pragma unroll
    for (int j = 0; j < 32; ++j) ss += (v[j].x * v[j].x + v[j].y * v[j].y) + (v[j].z * v[j].z + v[j].w * v[j].w);
#pragma unroll
    for (int o = 1; o < 32; o <<= 1) ss += __shfl_xor(ss, o);
    const float rs = 1.0f / sqrtf(ss * (1.0f / DM) + EPS);
    GAS unsigned char* o8 = (GAS unsigned char*)obase + tiled_off(m, 4 * li, DM / 64);
#pragma unroll
    for (int j = 0; j < 32; ++j) { const f32x4 a = v[j]; v2u w; w.x = pk2(a.x * rs, a.y * rs); w.y = pk2(a.z * rs, a.w * rs); *(GAS v2u*)(o8 + (size_t)j * 32768u) = w; }
}
__device__ __forceinline__ void rms_row_to_bf16(const float* xrow, const float* gain, bf16* orow, int lane) {
    const GAS f32x4* xr = (const GAS f32x4*)xrow + lane; const GAS f32x4* gr = (const GAS f32x4*)gain + lane;
    f32x4 v[16], gg[16]; float ss = 0.f;
#pragma unroll
    for (int j = 0; j < 16; ++j) { v[j] = xr[64 * j]; gg[j] = gr[64 * j]; }
#pragma unroll
    for (int j = 0; j < 16; ++j) ss += (v[j].x * v[j].x + v[j].y * v[j].y) + (v[j].z * v[j].z + v[j].w * v[j].w);
    const float rs = 1.0f / sqrtf(wave_sum(ss) * (1.0f / DM) + EPS);
    GAS v2u* o8 = (GAS v2u*)orow + lane;
#pragma unroll
    for (int j = 0; j < 16; ++j) { const f32x4 g = gg[j]; v2u w; w.x = pk2(v[j].x * rs * g.x, v[j].y * rs * g.y); w.y = pk2(v[j].z * rs * g.z, v[j].w * rs * g.w); o8[64 * j] = w; }
}
template <bool BASE_TILED, bool OUT_TILED>
__device__ __forceinline__ void norm_res_rowpair(const bf16* ffbuf, const bf16* basebuf, void* outbuf, float w, const LAS float* gl, float* rsout, int m0, int lane) {
    const int li = lane & 31, m = m0 + (lane >> 5);
    const unsigned toff = (unsigned)tiled_off(m, 4 * li, DM / 64), roff2 = (unsigned)((size_t)m * DM * 2 + (size_t)li * 8), roff4 = (unsigned)((size_t)m * DM * 4 + (size_t)li * 16);
    v2u f[32], b[32];
    { unsigned o_ = roff2; asm volatile("" : "+v"(o_));
#pragma unroll
      for (int j = 0; j < 32; ++j) f[j] = *(const GAS v2u*)((const GAS unsigned char*)ffbuf + (size_t)j * 256u + o_); }
    { unsigned o_ = BASE_TILED ? toff : roff2; asm volatile("" : "+v"(o_));
#pragma unroll
      for (int j = 0; j < 32; ++j) b[j] = *(const GAS v2u*)((const GAS unsigned char*)basebuf + (size_t)j * (BASE_TILED ? 32768u : 256u) + o_); }
    float ss = 0.f;
#pragma unroll
    for (int j = 0; j < 32; ++j) { const float a0 = bflo(f[j].x), a1 = bfhi(f[j].x), a2 = bflo(f[j].y), a3 = bfhi(f[j].y); ss += (a0 * a0 + a1 * a1) + (a2 * a2 + a3 * a3); }
#pragma unroll
    for (int o = 1; o < 32; o <<= 1) ss += __shfl_xor(ss, o);
    const float rs = w / sqrtf(ss * (1.0f / DM) + EPS);
    float s2 = 0.f;
    const LAS unsigned char* gl_ = (const LAS unsigned char*)gl + li * 16;
    unsigned o_ = OUT_TILED ? toff : roff4; asm volatile("" : "+v"(o_));
#pragma unroll
    for (int j = 0; j < 32; ++j) { const f32x4 g = *(const LAS f32x4*)(gl_ + j * 512);
        asm volatile("" : "+v"(f[j].x), "+v"(f[j].y), "+v"(b[j].x), "+v"(b[j].y));
        f32x4 h; h.x = bflo(b[j].x) + bflo(f[j].x) * rs * g.x; h.y = bfhi(b[j].x) + bfhi(f[j].x) * rs * g.y; h.z = bflo(b[j].y) + bflo(f[j].y) * rs * g.z; h.w = bfhi(b[j].y) + bfhi(f[j].y) * rs * g.w;
        s2 += (h.x * h.x + h.y * h.y) + (h.z * h.z + h.w * h.w);
        if (OUT_TILED) { v2u o; o.x = pk2(h.x, h.y); o.y = pk2(h.z, h.w); *(GAS v2u*)((GAS unsigned char*)outbuf + (size_t)j * 32768u + o_) = o; }
        else *(GAS f32x4*)((GAS unsigned char*)outbuf + (size_t)j * 512u + o_) = h;
        if ((j & 3) == 3) asm volatile("" ::: "memory"); }
    if (rsout) {
#pragma unroll
        for (int o = 1; o < 32; o <<= 1) s2 += __shfl_xor(s2, o);
        if (li == 0) rsout[m] = 1.0f / sqrtf(s2 * (1.0f / DM) + EPS);
    }
}
__device__ __forceinline__ void norm_res_rowpair_x(const bf16* ffbuf, const float* xbuf, void* outbuf, float w, const LAS float* gl, float* rsout, int m0, int lane) {
    const int li = lane & 31, m = m0 + (lane >> 5);
    const unsigned toff = (unsigned)tiled_off(m, 4 * li, DM / 64), roff2 = (unsigned)((size_t)m * DM * 2 + (size_t)li * 8), roff4 = (unsigned)((size_t)m * DM * 4 + (size_t)li * 16);
    v2u f[32]; f32x4 b[32];
    { unsigned o_ = roff2; asm volatile("" : "+v"(o_));
#pragma unroll
      for (int j = 0; j < 32; ++j) f[j] = *(const GAS v2u*)((const GAS unsigned char*)ffbuf + (size_t)j * 256u + o_); }
    { unsigned o_ = roff4; asm volatile("" : "+v"(o_));
#pragma unroll
      for (int j = 0; j < 32; ++j) b[j] = *(const GAS f32x4*)((const GAS unsigned char*)xbuf + (size_t)j * 512u + o_); }
    float ss = 0.f;
#pragma unroll
    for (int j = 0; j < 32; ++j) { const float a0 = bflo(f[j].x), a1 = bfhi(f[j].x), a2 = bflo(f[j].y), a3 = bfhi(f[j].y); ss += (a0 * a0 + a1 * a1) + (a2 * a2 + a3 * a3); }
#pragma unroll
    for (int o = 1; o < 32; o <<= 1) ss += __shfl_xor(ss, o);
    const float rs = w / sqrtf(ss * (1.0f / DM) + EPS);
    float s2 = 0.f;
    const LAS unsigned char* gl_ = (const LAS unsigned char*)gl + li * 16;
    unsigned o_ = toff; asm volatile("" : "+v"(o_));
#pragma unroll
    for (int j = 0; j < 32; ++j) { const f32x4 g = *(const LAS f32x4*)(gl_ + j * 512);
        asm volatile("" : "+v"(f[j].x), "+v"(f[j].y));
        f32x4 h; h.x = b[j].x + bflo(f[j].x) * rs * g.x; h.y = b[j].y + bfhi(f[j].x) * rs * g.y; h.z = b[j].z + bflo(f[j].y) * rs * g.z; h.w = b[j].w + bfhi(f[j].y) * rs * g.w;
        s2 += (h.x * h.x + h.y * h.y) + (h.z * h.z + h.w * h.w);
        v2u o; o.x = pk2(h.x, h.y); o.y = pk2(h.z, h.w); *(GAS v2u*)((GAS unsigned char*)outbuf + (size_t)j * 32768u + o_) = o;
        if ((j & 3) == 3) asm volatile("" ::: "memory"); }
#pragma unroll
    for (int o = 1; o < 32; o <<= 1) s2 += __shfl_xor(s2, o);
    if (li == 0) rsout[m] = 1.0f / sqrtf(s2 * (1.0f / DM) + EPS);
}
template <bool BASE_BF16, bool OUT_BF16>
__device__ __forceinline__ void norm_res_row(const bf16* ffrow, const void* baserow, void* hrow, float w, const float* gpost, float* rsrow, int lane) {
    const GAS v2u* fr = (const GAS v2u*)ffrow + lane; const GAS f32x4* gp = (const GAS f32x4*)gpost + lane;
    f32x4 v[16]; float ss = 0.f;
    v2u rb16[16]; f32x4 rb32[BASE_BF16 ? 1 : 16];
#pragma unroll
    for (int j = 0; j < 16; ++j) { if (BASE_BF16) rb16[j] = ((const GAS v2u*)baserow + lane)[64 * j]; else rb32[j] = ((const GAS f32x4*)baserow + lane)[64 * j]; }
#pragma unroll
    for (int j = 0; j < 16; ++j) { const v2u r = fr[64 * j]; v[j] = (f32x4){bflo(r.x), bfhi(r.x), bflo(r.y), bfhi(r.y)}; ss += (v[j].x * v[j].x + v[j].y * v[j].y) + (v[j].z * v[j].z + v[j].w * v[j].w); }
    const float rs = w / sqrtf(wave_sum(ss) * (1.0f / DM) + EPS);
    float s2 = 0.f;
#pragma unroll
    for (int j = 0; j < 16; ++j) { const f32x4 g = gp[64 * j]; f32x4 b;
        if (BASE_BF16) { const v2u r = rb16[j]; b = (f32x4){bflo(r.x), bfhi(r.x), bflo(r.y), bfhi(r.y)}; } else b = rb32[j];
        v[j] = b + v[j] * rs * g;
        if (OUT_BF16) { v2u o; o.x = pk2(v[j].x, v[j].y); o.y = pk2(v[j].z, v[j].w); ((GAS v2u*)hrow + lane)[64 * j] = o; } else ((GAS f32x4*)hrow + lane)[64 * j] = v[j];
        s2 += (v[j].x * v[j].x + v[j].y * v[j].y) + (v[j].z * v[j].z + v[j].w * v[j].w); }
    if (rsrow) {
        const float r2 = 1.0f / sqrtf(wave_sum(s2) * (1.0f / DM) + EPS);
        if (lane == 0) *rsrow = r2;
    }
}

constexpr int HG_QB = 0, HG_KT = 8704, HG_KTT = 17408, HG_SC = 27648, HG_EL = 30208, HG_QT = 30720;
typedef short bf16x8 __attribute__((ext_vector_type(8)));
typedef short bf16x4 __attribute__((ext_vector_type(4)));
__device__ __forceinline__ void hgrn_mfma_unit(LAS unsigned char* lds0, const bf16* proj, const bf16* it, bf16* obuf, int b, int h, int dir, int tid) {
    const int lane = tid & 63, wave = __builtin_amdgcn_readfirstlane(tid >> 6), i16 = lane & 15, g = lane >> 4;
    const int k = 16 * wave + i16, qd = g;
    const size_t rowbase = (size_t)b * SEQ;
    const int gcol = (dir ? C_GB : C_GF) + h * HD + k, qcol = C_Q + h * HD + k;
    f32x4 S[8];
#pragma unroll
    for (int kt = 0; kt < 8; ++kt) S[kt] = (f32x4){0.f, 0.f, 0.f, 0.f};
    const GAS unsigned char* vbase = (const GAS unsigned char*)it + ((size_t)(h * HD + 16 * wave) * MROWS + rowbase) * 2;
    const GAS unsigned char* pbase = (const GAS unsigned char*)proj + rowbase * (size_t)(PROJ_W * 2);
    GAS unsigned char* obase = (GAS unsigned char*)obuf + (rowbase * (size_t)HGW + h * HD + 16 * wave) * 2;
    const unsigned lv = (unsigned)(i16 * MROWS + 8 * g) * 2u, lq = (unsigned)(8 * qd * PROJ_W + qcol) * 2u, lg = (unsigned)(8 * qd * PROJ_W + gcol) * 2u, lo_ = (unsigned)(4 * g * HGW + i16) * 2u;
    unsigned short qn[8], gn[8]; bf16x8 vn; f32x4 op[2]; op[0] = (f32x4){0.f, 0.f, 0.f, 0.f}; op[1] = op[0];
    { const int t0 = dir ? (SEQ - 32) : 0; vn = *(const GAS bf16x8*)(vbase + (size_t)t0 * 2 + lv);
#pragma unroll
      for (int j = 0; j < 8; ++j) { const GAS unsigned char* ub = pbase + (size_t)(t0 + j) * (PROJ_W * 2); qn[j] = *(const GAS unsigned short*)(ub + lq); gn[j] = *(const GAS unsigned short*)(ub + lg); } }
    for (int cc = 0; cc < SEQ / 32; ++cc) {
        LAS unsigned char* lds = lds0 + (cc & 1) * 32768;
        LAS float* EL = (LAS float*)(lds + HG_EL);
        const int t0 = dir ? (SEQ - 32 * (cc + 1)) : 32 * cc;
        const bf16x8 vfrag = vn;
        float qv[8], gv[8];
#pragma unroll
        for (int j = 0; j < 8; ++j) { qv[j] = bf2f(qn[j]); gv[j] = h2f(gn[j]); }
        if (cc > 0) { const int tp = dir ? (SEQ - 32 * cc) : 32 * (cc - 1); unsigned lo2 = lo_; asm volatile("" : "+v"(lo2));
#pragma unroll
            for (int itl = 0; itl < 2; ++itl)
#pragma unroll
                for (int e = 0; e < 4; e += 2) { const unsigned pk = pg8::cvt_pk_bf16(op[itl][e], op[itl][e + 1]); GAS unsigned char* ub = obase + (size_t)(tp + 16 * itl + e) * (HGW * 2); GAS unsigned char* ub2 = ub + HGW * 2; asm volatile("" : "+s"(ub2));
                    *(GAS unsigned short*)(ub + lo2) = (unsigned short)(pk & 0xffffu); *(GAS unsigned short*)(ub2 + lo2) = (unsigned short)(pk >> 16); } }
        asm volatile("" ::: "memory");
        if (cc + 1 < SEQ / 32) {
            unsigned lv_ = lv, lq_ = lq, lg_ = lg; asm volatile("" : "+v"(lv_), "+v"(lq_), "+v"(lg_));
            const int t1 = dir ? (SEQ - 32 * (cc + 2)) : 32 * (cc + 1); vn = *(const GAS bf16x8*)(vbase + (size_t)t1 * 2 + lv_);
#pragma unroll
            for (int j = 0; j < 8; ++j) { const GAS unsigned char* ub = pbase + (size_t)(t1 + j) * (PROJ_W * 2); qn[j] = *(const GAS unsigned short*)(ub + lq_); gn[j] = *(const GAS unsigned short*)(ub + lg_); } }
        float cs[8]; float tot = 0.f;
        if (dir == 0) {
#pragma unroll
            for (int j = 0; j < 8; ++j) { tot += gv[j]; cs[j] = tot; }
        } else {
#pragma unroll
            for (int j = 7; j >= 0; --j) { tot += gv[j]; cs[j] = tot; }
        }
        { const float t0q = __shfl(tot, i16), t1q = __shfl(tot, i16 + 16), t2q = __shfl(tot, i16 + 32), t3q = __shfl(tot, i16 + 48);
          float off;
          if (dir == 0) off = (qd > 0 ? t0q : 0.f) + (qd > 1 ? t1q : 0.f) + (qd > 2 ? t2q : 0.f);
          else          off = (qd < 3 ? t3q : 0.f) + (qd < 2 ? t2q : 0.f) + (qd < 1 ? t1q : 0.f);
          if (qd == 0) EL[k] = __builtin_amdgcn_exp2f((t0q + t1q) + (t2q + t3q));
          unsigned kt8[8];
#pragma unroll
          for (int j = 0; j < 8; ++j) { const float bb = cs[j] + off; const float kk = 1.0f - __builtin_amdgcn_exp2f(gv[j]);
              const float qb = qv[j] * __builtin_amdgcn_exp2f(bb), ktv = kk * __builtin_amdgcn_exp2f(fminf(-bb, 115.f));
              const unsigned pk = pg8::cvt_pk_bf16(qb, ktv);
              *(LAS unsigned short*)(lds + HG_QB + (8 * qd + j) * 272 + 2 * k) = (unsigned short)(pk & 0xffffu);
              *(LAS unsigned short*)(lds + HG_KT + (8 * qd + j) * 272 + 2 * k) = (unsigned short)(pk >> 16);
              kt8[j] = pk >> 16; }
          v4u w; w.x = kt8[0] | (kt8[1] << 16); w.y = kt8[2] | (kt8[3] << 16); w.z = kt8[4] | (kt8[5] << 16); w.w = kt8[6] | (kt8[7] << 16);
          *(LAS v4u*)(lds + HG_KTT + k * 80 + 16 * qd) = w; }
        __syncthreads();
        if (wave < 4) { const int ti = wave >> 1, ts = wave & 1; f32x4 a = (f32x4){0.f, 0.f, 0.f, 0.f};
#pragma unroll
            for (int ks = 0; ks < 4; ++ks) { const bf16x8 af = *(const LAS bf16x8*)(lds + HG_QB + (16 * ti + i16) * 272 + (32 * ks + 8 * g) * 2), bfr = *(const LAS bf16x8*)(lds + HG_KT + (16 * ts + i16) * 272 + (32 * ks + 8 * g) * 2);
                a = __builtin_amdgcn_mfma_f32_16x16x32_bf16(af, bfr, a, 0, 0, 0); }
            const int ss = 16 * ts + i16;
#pragma unroll
            for (int e = 0; e < 4; e += 2) { const int si = 16 * ti + 4 * g + e; const bool k0 = dir ? (ss >= si) : (ss <= si), k1 = dir ? (ss >= si + 1) : (ss <= si + 1);
                const unsigned pk = pg8::cvt_pk_bf16(k0 ? a[e] : 0.f, k1 ? a[e + 1] : 0.f);
                *(LAS unsigned short*)(lds + HG_SC + si * 80 + 2 * ss) = (unsigned short)(pk & 0xffffu); *(LAS unsigned short*)(lds + HG_SC + (si + 1) * 80 + 2 * ss) = (unsigned short)(pk >> 16); } }
        f32x4 o[2]; o[0] = (f32x4){0.f, 0.f, 0.f, 0.f}; o[1] = o[0];
#pragma unroll
        for (int s4 = 0; s4 < 4; ++s4) {
            v4u sw; sw.x = pg8::cvt_pk_bf16(S[2 * s4][0], S[2 * s4][1]); sw.y = pg8::cvt_pk_bf16(S[2 * s4][2], S[2 * s4][3]); sw.z = pg8::cvt_pk_bf16(S[2 * s4 + 1][0], S[2 * s4 + 1][1]); sw.w = pg8::cvt_pk_bf16(S[2 * s4 + 1][2], S[2 * s4 + 1][3]);
            const bf16x8 sb = __builtin_bit_cast(bf16x8, sw);
#pragma unroll
            for (int itl = 0; itl < 2; ++itl) { const LAS unsigned char* qr = lds + HG_QB + (16 * itl + i16) * 272 + (32 * s4 + 4 * g) * 2;
                const v2u lo = *(const LAS v2u*)qr, hi = *(const LAS v2u*)(qr + 32);
                v4u aw; aw.x = lo.x; aw.y = lo.y; aw.z = hi.x; aw.w = hi.y;
                o[itl] = __builtin_amdgcn_mfma_f32_16x16x32_bf16(__builtin_bit_cast(bf16x8, aw), sb, o[itl], 0, 0, 0); }
        }
        __syncthreads();
#pragma unroll
        for (int itl = 0; itl < 2; ++itl) { const bf16x8 af = *(const LAS bf16x8*)(lds + HG_SC + (16 * itl + i16) * 80 + 16 * g);
            o[itl] = __builtin_amdgcn_mfma_f32_16x16x32_bf16(af, vfrag, o[itl], 0, 0, 0); }
        op[0] = o[0]; op[1] = o[1];
#pragma unroll
        for (int kt = 0; kt < 8; ++kt) { const bf16x8 af = *(const LAS bf16x8*)(lds + HG_KTT + (16 * kt + i16) * 80 + 16 * g);
            S[kt] = __builtin_amdgcn_mfma_f32_16x16x32_bf16(af, vfrag, S[kt], 0, 0, 0);
            const f32x4 el = *(const LAS f32x4*)(EL + 16 * kt + 4 * g);
            S[kt] = S[kt] * el; }
    }
    { const int tp = dir ? 0 : (SEQ - 32);
#pragma unroll
      for (int itl = 0; itl < 2; ++itl)
#pragma unroll
          for (int e = 0; e < 4; e += 2) { const unsigned pk = pg8::cvt_pk_bf16(op[itl][e], op[itl][e + 1]); GAS unsigned char* ub = obase + (size_t)(tp + 16 * itl + e) * (HGW * 2);
              *(GAS unsigned short*)(ub + lo_) = (unsigned short)(pk & 0xffffu); *(GAS unsigned short*)(ub + HGW * 2 + lo_) = (unsigned short)(pk >> 16); } }
    __syncthreads();
}

constexpr float NA_THR = 8.0f;
__device__ __forceinline__ void na_pair_mfma(const LAS float* tbl, const bf16* proj, const bf16* vt, bf16* mix, int b, int h, int rp, int cb, int lane) {
    const int r0 = 2 * rp;
    const int cbase = (cb == 0) ? 0 : (cb == 1) ? 8 : (cb == 2) ? 24 : 32;
    const int kb = min(max(r0 - WIN_R / 2, 0), NROWS - WIN_R), rs1 = min(max(r0 + 1 - WIN_R / 2, 0), NROWS - WIN_R);
    const int i = lane & 15, g = lane >> 4;
    const int c = 16 * cb + i, cs = min(max(c - WIN_C / 2, 0), GRID_W - WIN_C);
    const size_t tok0 = (size_t)b * SEQ;
    const bf16* qp = proj + (tok0 + r0 * GRID_W + c) * PROJ_W + C_NQ + h * HD + 8 * g;
    bf16x8 qf[2][4];
#pragma unroll
    for (int q = 0; q < 2; ++q)
#pragma unroll
        for (int ks = 0; ks < 4; ++ks) qf[q][ks] = *(const GAS bf16x8*)(qp + (size_t)q * GRID_W * PROJ_W + 32 * ks);
    const int kco = 8 * (i >> 2) + (i & 3);
    const bf16* kp0 = proj + (tok0 + cbase + kco) * PROJ_W + C_NK + h * HD + 8 * g;
    const bf16* vp0 = vt + (size_t)(h * HD + i) * MROWS + tok0 + cbase + 8 * g;
    const LAS float* tb = tbl + h * (15 * 31);
    int dcol[8]; bool okc[8];
#pragma unroll
    for (int j = 0; j < 8; ++j) { const int kcol = cbase + 8 * g + j; okc[j] = (kcol >= cs) && (kcol < cs + WIN_C); dcol[j] = min(max(kcol - c + WIN_C - 1, 0), 30); }
    f32x4 acc[2][8]; float m[2], l[2];
#pragma unroll
    for (int q = 0; q < 2; ++q) { m[q] = -1.0e30f; l[q] = 0.f;
#pragma unroll
        for (int dt = 0; dt < 8; ++dt) acc[q][dt] = (f32x4){0.f, 0.f, 0.f, 0.f}; }
#pragma unroll 1
    for (int kr = 0; kr < 9; ++kr) {
        const int krow = kb + kr, lrow = min(krow, NROWS - 1);
        const bf16* kp = kp0 + (size_t)(lrow * GRID_W) * PROJ_W;
        bf16x8 kf[2][4];
#pragma unroll
        for (int t = 0; t < 2; ++t)
#pragma unroll
            for (int ks = 0; ks < 4; ++ks) kf[t][ks] = *(const GAS bf16x8*)(kp + (size_t)(4 * t) * PROJ_W + 32 * ks);
        bf16x8 vf[8];
#pragma unroll
        for (int dt = 0; dt < 8; ++dt) vf[dt] = *(const GAS bf16x8*)(vp0 + (size_t)(16 * dt) * MROWS + lrow * GRID_W);
#pragma unroll
        for (int q = 0; q < 2; ++q) {
            const int r = r0 + q, rsq = q ? rs1 : kb;
            const bool rowok = (krow >= rsq) && (krow < rsq + WIN_R);
            const int dr = min(max(krow - r + WIN_R - 1, 0), 14);
            f32x4 s0 = (f32x4){0.f, 0.f, 0.f, 0.f}, s1 = s0;
#pragma unroll
            for (int ks = 0; ks < 4; ++ks) { s0 = __builtin_amdgcn_mfma_f32_16x16x32_bf16(kf[0][ks], qf[q][ks], s0, 0, 0, 0); s1 = __builtin_amdgcn_mfma_f32_16x16x32_bf16(kf[1][ks], qf[q][ks], s1, 0, 0, 0); }
            float v[8]; float cmax = -3.0e38f;
#pragma unroll
            for (int j = 0; j < 8; ++j) { const float sv = (j < 4) ? s0[j & 3] : s1[j & 3]; v[j] = (rowok && okc[j]) ? sv + tb[dr * 31 + dcol[j]] : -3.0e38f; cmax = fmaxf(cmax, v[j]); }
            if (__any(cmax > m[q] + NA_THR)) {
                float mx = fmaxf(cmax, __shfl_xor(cmax, 16)); mx = fmaxf(mx, __shfl_xor(mx, 32));
                const float mn = fmaxf(m[q], mx); const float sc = __builtin_amdgcn_exp2f((m[q] - mn) * 1.4426950408889634f);
                l[q] *= sc;
#pragma unroll
                for (int dt = 0; dt < 8; ++dt) acc[q][dt] = acc[q][dt] * sc;
                m[q] = mn; }
            float p[8];
#pragma unroll
            for (int j = 0; j < 8; ++j) { p[j] = __builtin_amdgcn_exp2f((v[j] - m[q]) * 1.4426950408889634f); l[q] += p[j]; }
            v4u w; w.x = pg8::cvt_pk_bf16(p[0], p[1]); w.y = pg8::cvt_pk_bf16(p[2], p[3]); w.z = pg8::cvt_pk_bf16(p[4], p[5]); w.w = pg8::cvt_pk_bf16(p[6], p[7]);
            const bf16x8 pf = __builtin_bit_cast(bf16x8, w);
#pragma unroll
            for (int dt = 0; dt < 8; ++dt) acc[q][dt] = __builtin_amdgcn_mfma_f32_16x16x32_bf16(vf[dt], pf, acc[q][dt], 0, 0, 0);
        }
    }
#pragma unroll
    for (int q = 0; q < 2; ++q) { float lq = l[q]; lq += __shfl_xor(lq, 16); lq += __shfl_xor(lq, 32);
        const float inv = 1.0f / lq;
        bf16* op = mix + (tok0 + (r0 + q) * GRID_W + c) * DM + HGW + h * HD + 4 * g;
#pragma unroll
        for (int dt = 0; dt < 8; ++dt) { v2u w; w.x = pg8::cvt_pk_bf16(acc[q][dt][0] * inv, acc[q][dt][1] * inv); w.y = pg8::cvt_pk_bf16(acc[q][dt][2] * inv, acc[q][dt][3] * inv); *(GAS v2u*)(op + 16 * dt) = w; } }
}

__device__ __forceinline__ void hgrn_combine_row(const bf16* of, const bf16* ob, const bf16* gaterow, const float* hn, bf16* orow, int lane) {
    const GAS v2u* a = (const GAS v2u*)of + lane; const GAS v2u* bq = (const GAS v2u*)ob + lane; const GAS v2u* gr = (const GAS v2u*)gaterow + lane;
    const f32x4 hg = *((const GAS f32x4*)hn + (lane & 31));
    GAS v2u* o8 = (GAS v2u*)orow + lane;
    v2u ra[8], rb[8], rg[8];
#pragma unroll
    for (int j = 0; j < 8; ++j) { ra[j] = a[64 * j]; rb[j] = bq[64 * j]; rg[j] = gr[64 * j]; }
#pragma unroll
    for (int j = 0; j < 8; ++j) {
        f32x4 v = (f32x4){bflo(ra[j].x) + bflo(rb[j].x), bfhi(ra[j].x) + bfhi(rb[j].x), bflo(ra[j].y) + bflo(rb[j].y), bfhi(ra[j].y) + bfhi(rb[j].y)};
        float ss = (v.x * v.x + v.y * v.y) + (v.z * v.z + v.w * v.w);
#pragma unroll
        for (int o = 1; o < 32; o <<= 1) ss += __shfl_xor(ss, o);
        const float rs = 1.0f / sqrtf(ss * (1.0f / HD) + EPS);
        const v2u g = rg[j];
        v2u w; w.x = pk2(v.x * rs * hg.x * bflo(g.x), v.y * rs * hg.y * bfhi(g.x)); w.y = pk2(v.z * rs * hg.z * bflo(g.y), v.w * rs * hg.w * bfhi(g.y));
        o8[64 * j] = w;
    }
}

struct Args { const float* in[18]; float* out; unsigned char* ws; int ph_lo, ph_hi; };
__global__ void __launch_bounds__(NWAVES * 64, 2) fwd_kernel(Args args) {
    extern __shared__ __attribute__((aligned(16))) unsigned char lds_raw[];
    LAS unsigned char* lds = (LAS unsigned char*)lds_raw;
    volatile LAS unsigned* MISC = (volatile LAS unsigned*)(lds + MISC_OFF);
    const int G = gridDim.x, bx = blockIdx.x;
    const int vcu = (G % 8 == 0) ? (bx % 8) * (G / 8) + bx / 8 : bx;
    gu32* ctl = (gu32*)(args.ws + WS_CTL);
    for (int u = threadIdx.x; u < (LDS_BYTES - LDSCTL_OFF) / 4; u += NWAVES * 64) ((LAS unsigned*)(lds + LDSCTL_OFF))[u] = 0u;
    __syncthreads();
    XcdBarrier bar; bar.bar = (unsigned*)(args.ws + WS_CTL) + CW_BAR; bar.x = 0; bar.st = nullptr;
#if !MK_PER_PHASE
    bar = xcd_barrier_post((unsigned*)(args.ws + WS_CTL) + CW_BAR, MISC + 8);
#endif
    const int lo = args.ph_lo, hi = args.ph_hi;
#if DIAG_BAR
    unsigned diag_wait = 0; int diag_nb = 0;
#endif
#define IN(k) (lo <= (k) && (k) < hi)
#define BOTH(k) (IN(k) && IN((k) + 1))
#if MK_PER_PHASE
#define GRID_BAR() do { if (threadIdx.x == 0) __hip_atomic_store(ctl + CW_TMO, 0xBADBA0u, RLX_AGENT); } while (0)
#else
#if DIAG_BAR
#define GRID_BAR() do { const unsigned long long t_a = __builtin_amdgcn_s_memrealtime(); xcd_barrier(bar); const unsigned long long t_b = __builtin_amdgcn_s_memrealtime(); \
        if (DIAG_BAR < 100 || DIAG_BAR - 100 == diag_nb) diag_wait += (unsigned)(t_b - t_a); ++diag_nb; } while (0)
#else
#define GRID_BAR() xcd_barrier(bar)
#endif
#endif
#define WGU1 ((bf16*)(args.ws + WS_WGU1))
#define WGU2 ((bf16*)(args.ws + WS_WGU2))
#define WD1 ((bf16*)(args.ws + WS_WD1))
#define WD2 ((bf16*)(args.ws + WS_WD2))
#define WIN ((bf16*)(args.ws + WS_WIN))
#define WOUT ((bf16*)(args.ws + WS_WOUT))
#define R1 ((bf16*)(args.ws + WS_R1))
#define IT ((bf16*)(args.ws + WS_TT))
#define VT ((bf16*)(args.ws + WS_TT) + (size_t)HGW * MROWS)
#define R2 ((float*)(args.ws + WS_R2))
#define R3 ((bf16*)(args.ws + WS_R3))
#define LB ((float*)(args.ws + WS_LB))
#define RS ((float*)(args.ws + WS_LB + 64 * 1024))
#define PHASE_IDS() int tid = threadIdx.x; asm volatile("" : "+v"(tid)); const int lane = tid & 63, wave = __builtin_amdgcn_readfirstlane(tid >> 6); \
    const int gw = vcu * NWAVES + wave, NGW = G * NWAVES; (void)lane; (void)gw; (void)NGW
#define PHASE_GATEUP(k, W, AP, RSP, ATILED) if (IN(k)) { _Pragma("unroll") for (int rr_ = 0; rr_ < NREP(k); ++rr_) { \
        pg8::Gemm g{(AP), (W), MROWS, 2 * FF, DM}; pg8::StaticOrder S; S.init(MROWS, GU_MAIN_N, G, bx); S.wgm = WGM_GU; \
        pg8::EpiSwiGLU E{R1, FF, (RSP)}; \
        pg8::gemm_phase<pg8::EpiSwiGLU, pg8::StaticOrder, G_ALIGN, G_SP2, true, ATILED>(lds + RING_OFF, g, S, E); \
        pg8::gemm_half_units<pg8::EpiSwiGLU, true, ATILED>(lds + RING_OFF, g, GU_MAIN_N / 256, (2 * FF - GU_MAIN_N) / 256, E, bx, G); } \
        if (BOTH(k)) GRID_BAR(); }
#define PHASE_DOWN(k, W, RSP) if (IN(k)) { _Pragma("unroll") for (int rr_ = 0; rr_ < NREP(k); ++rr_) { \
        pg8::Gemm g{R1, (W), MROWS, DM, FF}; pg8::StaticOrder S; S.init(MROWS, DM, G, bx); S.wgm = WGM_DOWN; \
        pg8::EpiBf16Plain E{(bf16*)R2, DM, (RSP)}; \
        pg8::gemm_phase<pg8::EpiBf16Plain, pg8::StaticOrder, G_ALIGN, G_SP2, true, true>(lds + RING_OFF, g, S, E); } \
        if (BOTH(k)) GRID_BAR(); }
#define PHASE_NORM(k, BBF, OBF, BASE, HOUT, WGT, GPOST, HASU) if (IN(k)) { PHASE_IDS(); \
        _Pragma("unroll") for (int rr_ = 0; rr_ < NREP(k); ++rr_) for (int m = gw; m < MROWS; m += NGW) \
            norm_res_row<BBF, OBF>((const bf16*)R2 + (size_t)m * DM, (const void*)(BASE), (void*)(HOUT), (WGT), (GPOST), (HASU) ? RS + m : (float*)nullptr, lane); \
        if (BOTH(k)) GRID_BAR(); }
#define HB ((bf16*)(args.ws + WS_R2 + 128 * MiB))

    if (IN(0)) { PHASE_IDS();
        LAS float* scr = (LAS float*)(lds + RING_OFF + wave * 16384);
        constexpr int I_GU = (DM / 64) * (FF / 32), I_D = (FF / 64) * (DM / 32), I_IN = (DM / 64) * (16384 / 32), I_OUT = (DM / 64) * (DM / 32);
        constexpr int NITEMS = 6 * I_GU + I_IN + I_OUT;
        static_assert(I_GU == I_D, "items");
        for (int rr_ = 0; rr_ < NREP(0); ++rr_)
        for (int it = gw; it < NITEMS; it += NGW) {
            int r = it; const float* W; bf16* WT; int K = DM, N = FF, mode = 0; const float* gain = nullptr;
            if (r < I_GU) { W = args.in[2]; WT = WGU1; mode = 1; gain = args.in[1]; }
            else if ((r -= I_GU) < I_GU) { W = args.in[3]; WT = WGU1; mode = 2; gain = args.in[1]; }
            else if ((r -= I_GU) < I_D) { W = args.in[4]; WT = WD1; K = FF; N = DM; }
            else if ((r -= I_D) < I_IN) { W = args.in[7]; WT = WIN; N = 16384; mode = 3; gain = args.in[6]; }
            else if ((r -= I_IN) < I_OUT) { W = args.in[11]; WT = WOUT; N = DM; }
            else if ((r -= I_OUT) < I_GU) { W = args.in[14]; WT = WGU2; mode = 1; gain = args.in[13]; }
            else if ((r -= I_GU) < I_GU) { W = args.in[15]; WT = WGU2; mode = 2; gain = args.in[13]; }
            else { r -= I_GU; W = args.in[16]; WT = WD2; K = FF; N = DM; }
            transpose_item(W, K, N, WT, mode, scr, r, lane, gain, (mode == 3) ? PROJ_W : (1 << 30), mode == 1 ? 1.4426950408889634f : mode == 2 ? 0.6931471805599453f : 1.0f);
        }
        for (int mp = gw; mp < MROWS / 2; mp += NGW) rms_rowpair_to_bf16_tiled(args.in[0], R3, 2 * mp, lane);
        for (int i = bx * 512 + tid; i < 2 * HGW; i += G * 512) { const float l0 = args.in[8][i], l1 = args.in[8][2 * HGW + i]; LB[i] = 1.0f / (1.0f + expf(l1 - l0)); }
        if (BOTH(0)) GRID_BAR();
    }
    PHASE_GATEUP(1, WGU1, R3, (const float*)nullptr, true)
    PHASE_DOWN(2, WD1, (const float*)nullptr)
    if (IN(3)) { PHASE_IDS();
        LAS float* gl = (LAS float*)(lds + RING_OFF);
        for (int i = tid; i < DM / 4; i += 512) ((LAS f32x4*)gl)[i] = ((const GAS f32x4*)args.in[5])[i];
        __syncthreads();
        _Pragma("unroll") for (int rr_ = 0; rr_ < NREP(3); ++rr_) for (int mp = gw; mp < MROWS / 2; mp += NGW)
            norm_res_rowpair_x((const bf16*)R2, args.in[0], (void*)HB, 0.5f, gl, RS, 2 * mp, lane);
        if (BOTH(3)) GRID_BAR(); }
    if (IN(3) && IN(4)) { for (int eb = 0; eb < EXTRA_BARS; ++eb) GRID_BAR(); }
    if (IN(4)) {
#pragma unroll
        for (int rr_ = 0; rr_ < NREP(4); ++rr_) {
        { pg8::Gemm g{HB, WIN, MROWS, PROJ_W, DM}; pg8::StaticOrder S; S.init(MROWS, PROJ_W, G, bx); S.wgm = WGM_IN;
          pg8::EpiProj E{R1, PROJ_W, LB, RS};
          pg8::gemm_phase<pg8::EpiProj, pg8::StaticOrder, G_ALIGN, G_SP2, true, true>(lds + RING_OFF, g, S, E); }
        { pg8::Gemm g{WIN + (size_t)PROJ_W * DM, HB, HGW + NAW, MROWS, DM}; pg8::StaticOrder S; S.init(HGW + NAW, MROWS, G, bx); S.wgm = WGM_TT;
          pg8::EpiBf16ColScaleNP E{IT, MROWS, RS};
          pg8::gemm_phase<pg8::EpiBf16ColScaleNP, pg8::StaticOrder, G_ALIGN, G_SP2, true, false>(lds + RING_OFF, g, S, E); }
        }
        if (BOTH(4)) GRID_BAR();
    }
    if (IN(5)) { PHASE_IDS();
        for (int rr_ = 0; rr_ < NREP(5); ++rr_)
        if (bx < 2 * BATCH * NHEAD) { const int dir = bx & 1, h = (bx >> 1) & 15, b = bx >> 5;
            hgrn_mfma_unit(lds + RING_OFF, R1, IT, (bf16*)R2 + (size_t)dir * MROWS * HGW, b, h, dir, tid); }
        { LAS float* tbl = (LAS float*)(lds + RING_OFF);
          for (int q = tid; q < NHEAD * 15 * 31; q += 512) tbl[q] = args.in[10][q];
          __syncthreads();
          const int xq = (int)(xb_xcc_id() & 7u);
          for (int rr_ = 0; rr_ < NREP(12); ++rr_)
          for (int qq = 0; qq < 8; ++qq) { const int q = (xq + qq) & 7;
            for (;;) {
              if (tid == 0) MISC[16] = __hip_atomic_fetch_add(ctl + CW_QUEUE + 64 * (8 * rr_ + q), 1u, RLX_AGENT);
              __syncthreads();
              const int li = (int)MISC[16];
              __syncthreads();
              if (li >= 128) break;
              const int rq = li & 15, bh = q * 8 + (li >> 4), h = bh & 15, b = bh >> 4;
              na_pair_mfma(tbl, R1, VT, R3, b, h, 2 * rq + (wave >> 2), wave & 3, lane);
            } }
        }
        if (BOTH(5)) GRID_BAR();
    }
    if (IN(6)) { PHASE_IDS();
        for (int rr_ = 0; rr_ < NREP(6); ++rr_)
        for (int m = gw; m < MROWS; m += NGW)
            hgrn_combine_row((const bf16*)R2 + (size_t)m * HGW, (const bf16*)R2 + (size_t)MROWS * HGW + (size_t)m * HGW, R1 + (size_t)m * PROJ_W + C_GATE, args.in[9], R3 + (size_t)m * DM, lane);
        if (BOTH(6)) GRID_BAR();
    }
    if (IN(7)) {
#pragma unroll
        for (int rr_ = 0; rr_ < NREP(7); ++rr_) {
        pg8::Gemm g{R3, WOUT, MROWS, DM, DM}; pg8::StaticOrder S; S.init(MROWS, DM, G, bx); S.nrep = P7_INNER_REP; S.wgm = WGM_OUT;
        pg8::EpiBf16Plain E{(bf16*)R2, DM, (const float*)nullptr};
        pg8::gemm_phase<pg8::EpiBf16Plain, pg8::StaticOrder, G_ALIGN, G_SP2, true>(lds + RING_OFF, g, S, E); }
        if (BOTH(7)) GRID_BAR();
    }
    if (IN(8)) { PHASE_IDS();
        LAS float* gl = (LAS float*)(lds + RING_OFF);
        for (int i = tid; i < DM / 4; i += 512) ((LAS f32x4*)gl)[i] = ((const GAS f32x4*)args.in[12])[i];
        __syncthreads();
        _Pragma("unroll") for (int rr_ = 0; rr_ < NREP(8); ++rr_) for (int mp = gw; mp < MROWS / 2; mp += NGW)
            norm_res_rowpair<true, true>((const bf16*)R2, HB, (void*)R3, 1.0f, gl, RS, 2 * mp, lane);
        if (BOTH(8)) GRID_BAR(); }
    PHASE_GATEUP(9, WGU2, R3, RS, true)
    PHASE_DOWN(10, WD2, RS)
    if (IN(11)) { PHASE_IDS();
        LAS float* gl = (LAS float*)(lds + RING_OFF);
        for (int i = tid; i < DM / 4; i += 512) ((LAS f32x4*)gl)[i] = ((const GAS f32x4*)args.in[17])[i];
        __syncthreads();
        for (int mp = gw; mp < MROWS / 2; mp += NGW)
            norm_res_rowpair<true, false>((const bf16*)R2, R3, (void*)args.out, 0.5f, gl, (float*)nullptr, 2 * mp, lane); }
#if DIAG_BAR
    if (threadIdx.x == 0) { gu32* dw = ctl + 12288;
        __hip_atomic_fetch_add(dw, diag_wait, RLX_AGENT); __hip_atomic_fetch_max(dw + 64, diag_wait, RLX_AGENT);
        __threadfence();
        const unsigned prev = __hip_atomic_fetch_add(dw + 128, 1u, RLX_AGENT);
        if (prev == (unsigned)G - 1u) { __threadfence(); const unsigned sum = __hip_atomic_load(dw, RLX_AGENT), mx = __hip_atomic_load(dw + 64, RLX_AGENT);
            const float val = (DIAG_BAR == 2) ? (float)mx * 0.01f : (float)sum * 0.01f / (float)G;
            args.out[0] = 1000.0f + floorf(val * (1.0f / 40.0f)) * 40.0f; } }
#endif
#if !MK_PER_PHASE
    if (IN(11)) { if (xb_ld((unsigned*)(args.ws + WS_CTL) + CW_BAR + XB_TMO) != 0u) { const float q = __builtin_nanf(""); for (int m = bx; m < MROWS; m += G) for (int c = threadIdx.x; c < DM; c += 512) args.out[(size_t)m * DM + c] = q; } }
#endif
#undef IN
#undef BOTH
}

extern "C" void kernel_launch(void* const* d_in, const int* in_sizes, int n_in, void* d_out, int out_size, void* d_ws, size_t ws_size, hipStream_t stream) {
    static int grid = 0;
    if (grid == 0) {
        if (n_in != 18 || in_sizes[0] != MROWS * DM || out_size != MROWS * DM || ws_size < WS_END) {
            fprintf(stderr, "kernel_launch: unexpected shapes (n_in %d, in0 %d, out %d, ws %zu need %zu); nothing launched\n", n_in, n_in > 0 ? in_sizes[0] : -1, out_size, ws_size, (size_t)WS_END); grid = -1; return; }
        int dev = 0, cus = 0;
        if (hipGetDevice(&dev) != hipSuccess || hipDeviceGetAttribute(&cus, hipDeviceAttributeMultiprocessorCount, dev) != hipSuccess) { grid = -1; return; }
        if (hipFuncSetAttribute((const void*)fwd_kernel, hipFuncAttributeMaxDynamicSharedMemorySize, LDS_BYTES) != hipSuccess) { fprintf(stderr, "kernel_launch: hipFuncSetAttribute failed\n"); grid = -1; return; }
        int per_cu = 0;
        if (hipOccupancyMaxActiveBlocksPerMultiprocessor(&per_cu, (const void*)fwd_kernel, NWAVES * 64, LDS_BYTES) != hipSuccess || per_cu < 1)
            fprintf(stderr, "kernel_launch: note: occupancy query reports %d workgroups per CU\n", per_cu);
        (void)hipGetLastError();
        grid = cus;
    }
    if (grid < 0) return;
    if (hipMemsetAsync((char*)d_ws + WS_CTL, 0, CTL_ZERO_BYTES, stream) != hipSuccess) { fprintf(stderr, "kernel_launch: memset failed\n"); return; }
    Args a{};
    for (int i = 0; i < 18; ++i) a.in[i] = (const float*)d_in[i];
    a.out = (float*)d_out; a.ws = (unsigned char*)d_ws;
#if MK_PER_PHASE
    for (int p = 0; p < N_PHASES; ++p) { a.ph_lo = p; a.ph_hi = p + 1; hipLaunchKernelGGL(fwd_kernel, dim3(grid), dim3(NWAVES * 64), LDS_BYTES, stream, a); }
#else
    a.ph_lo = 0; a.ph_hi = N_PHASES;
    hipLaunchKernelGGL(fwd_kernel, dim3(grid), dim3(NWAVES * 64), LDS_BYTES, stream, a);
#endif
    const hipError_t le = hipPeekAtLastError();
    if (le != hipSuccess) fprintf(stderr, "kernel_launch: launch failed: %s\n", hipGetErrorName(le));
}
```

```cpp
#include <hip/hip_runtime.h>
#include <cstdio>
#include <cstdint>

#ifndef REPEAT_MASK
#define REPEAT_MASK 0
#endif
#define NREP(k) (1 + ((REPEAT_MASK >> (k)) & 1))
#ifndef G_SP2
#define G_SP2 true
#endif
#ifndef G_ALIGN
#define G_ALIGN true
#endif
#ifndef EPI_TWICE
#define EPI_TWICE 0
#endif
#ifndef DIAG_BAR
#define DIAG_BAR 0
#endif
#ifndef P7_INNER_REP
#define P7_INNER_REP 1
#endif
#ifndef WGM_GU
#define WGM_GU 8
#endif
#ifndef WGM_IN
#define WGM_IN 8
#endif
#ifndef WGM_OUT
#define WGM_OUT 4
#endif
#ifndef WGM_TT
#define WGM_TT 4
#endif
#ifndef WGM_DOWN
#define WGM_DOWN 4
#endif
#ifndef EXTRA_BARS
#define EXTRA_BARS 0
#endif
#ifndef MK_PER_PHASE
#define MK_PER_PHASE 0
#endif

namespace pg8 {
#define PG8_LAS __attribute__((address_space(3)))
typedef unsigned short bf16_t;
typedef short bf16x8 __attribute__((ext_vector_type(8)));
typedef float f32x4 __attribute__((ext_vector_type(4)));
typedef unsigned u32x4 __attribute__((ext_vector_type(4)));
constexpr int BM = 256, BK = 64, HALF = 128, HTB = HALF * BK * 2  , STAGE_BYTES = 8 * HTB, NXCD = 8, WGM = 8;

__host__ __device__ __forceinline__ int lds_byte(int r, int c) { const int st = (r >> 4) * 2 + (c >> 5), rr = r & 15, cc = c & 31, ob = rr * 64 + cc * 2; return st * 1024 + (ob ^ (((ob >> 9) & 1) << 5)); }
__host__ __device__ __forceinline__ void stage_rc(int b, int& R, int& C) { const int st = b / 1024, sb = b % 1024, swz = sb ^ (((sb >> 9) & 1) << 5); R = (st >> 1) * 16 + swz / 64; C = (st & 1) * 32 + (swz % 64) / 2; }
__host__ __device__ __forceinline__ int perm32(int rho) { const int n = rho >> 4, i = rho & 15; return 8 * (i >> 2) + 4 * n + (i & 3); }

struct Unit { int pm, pn; };
struct Gemm { const bf16_t* A; const bf16_t* Bt; int M, N, K; };

struct StaticOrder {
    int nM, nN, nwg, G, c, nrep = 1, wgm = WGM;
    __host__ __device__ void init(int M, int N, int G_, int c_) { nM = M / BM; nN = N / BM; nwg = nM * nN; G = G_; c = c_; }
    __host__ __device__ bool next(int i, Unit& u) const {
        long L = (long)i * G + c; if (L >= (long)nwg * nrep) return false; L %= nwg;
        int wgid = (int)L; { const int q = nwg / NXCD, r = nwg % NXCD, xcd = wgid % NXCD, off = wgid / NXCD; wgid = (xcd < r ? xcd * (q + 1) : r * (q + 1) + (xcd - r) * q) + off; }
        const int nig = wgm * nN, gid = wgid / nig, fm = gid * wgm, gsz = (nM - fm) < wgm ? (nM - fm) : wgm;
        u.pm = fm + ((wgid % nig) % gsz); u.pn = (wgid % nig) / gsz; return true;
    }
    __device__ __forceinline__ void a_ready(const Unit&) const {}
    __device__ __forceinline__ void done(const Unit&) const {}
};

typedef float f32x2_t __attribute__((ext_vector_type(2)));
typedef __bf16 bf16x2_t __attribute__((ext_vector_type(2)));
__device__ __forceinline__ unsigned cvt_pk_bf16(float lo, float hi) { const f32x2_t v = {lo, hi}; const bf16x2_t b = __builtin_convertvector(v, bf16x2_t); return __builtin_bit_cast(unsigned, b); }
__device__ __forceinline__ unsigned cvt_pk_f16(float lo, float hi) { typedef _Float16 h2 __attribute__((ext_vector_type(2))); h2 v; v.x = (_Float16)lo; v.y = (_Float16)hi; return __builtin_bit_cast(unsigned, v); }
__device__ __forceinline__ float sigmoidf_fast(float v) { return __builtin_amdgcn_rcpf(1.0f + __builtin_amdgcn_exp2f(-1.4426950408889634f * v)); }

struct EpiF32 {
    static constexpr bool PERM = false, AFTER_DRAIN = false;
    float* C; int ldc;
    __device__ __forceinline__ void operator()(const f32x4 (&acc)[2][2][4][2], const Unit& u, int wr, int wc, int fr, int fq) const {
        const int row0 = u.pm * BM + wr * 64 + fr, col0 = u.pn * BM + wc * 32 + 4 * fq;
#pragma unroll
        for (int ai = 0; ai < 2; ++ai)
#pragma unroll
            for (int m = 0; m < 4; ++m) { float* rowp = C + (size_t)(row0 + ai * HALF + m * 16) * ldc + col0;
#pragma unroll
                for (int bj = 0; bj < 2; ++bj)
#pragma unroll
                    for (int n = 0; n < 2; ++n) *(f32x4*)(rowp + bj * HALF + n * 16) = acc[ai][bj][m][n]; }
    }
};
struct EpiBf16Plain {
    static constexpr bool PERM = true, AFTER_DRAIN = false;
    bf16_t* O; int ldc; const float* rs;
    __device__ __forceinline__ void operator()(const f32x4 (&acc)[2][2][4][2], const Unit& u, int wr, int wc, int fr, int fq) const {
        const int row0 = u.pm * BM + wr * 64 + fr, col0 = u.pn * BM + wc * 32 + 8 * fq;
#pragma unroll
        for (int ai = 0; ai < 2; ++ai)
#pragma unroll
            for (int m = 0; m < 4; ++m) { bf16_t* rowp = O + (size_t)(row0 + ai * HALF + m * 16) * ldc + col0;
                const float r = rs ? rs[row0 + ai * HALF + m * 16] : 1.0f;
#pragma unroll
                for (int bj = 0; bj < 2; ++bj) { const f32x4 v0 = acc[ai][bj][m][0] * r, v1 = acc[ai][bj][m][1] * r;
                    u32x4 w; w.x = cvt_pk_bf16(v0[0], v0[1]); w.y = cvt_pk_bf16(v0[2], v0[3]); w.z = cvt_pk_bf16(v1[0], v1[1]); w.w = cvt_pk_bf16(v1[2], v1[3]);
                    *(u32x4*)(rowp + bj * HALF) = w; } }
    }
};
struct EpiBf16ColScale {
    static constexpr bool PERM = true, AFTER_DRAIN = false;
    bf16_t* O; int ldc; const float* cs;
    __device__ __forceinline__ void operator()(const f32x4 (&acc)[2][2][4][2], const Unit& u, int wr, int wc, int fr, int fq) const {
        const int row0 = u.pm * BM + wr * 64 + fr, col0 = u.pn * BM + wc * 32 + 8 * fq;
        f32x4 c0[2], c1[2];
#pragma unroll
        for (int bj = 0; bj < 2; ++bj) { c0[bj] = *(const f32x4*)(cs + col0 + bj * HALF); c1[bj] = *(const f32x4*)(cs + col0 + bj * HALF + 4); }
#pragma unroll
        for (int ai = 0; ai < 2; ++ai)
#pragma unroll
            for (int m = 0; m < 4; ++m) { bf16_t* rowp = O + (size_t)(row0 + ai * HALF + m * 16) * ldc + col0;
#pragma unroll
                for (int bj = 0; bj < 2; ++bj) { const f32x4 v0 = acc[ai][bj][m][0] * c0[bj], v1 = acc[ai][bj][m][1] * c1[bj];
                    u32x4 w; w.x = cvt_pk_bf16(v0[0], v0[1]); w.y = cvt_pk_bf16(v0[2], v0[3]); w.z = cvt_pk_bf16(v1[0], v1[1]); w.w = cvt_pk_bf16(v1[2], v1[3]);
                    *(u32x4*)(rowp + bj * HALF) = w; } }
    }
};
struct EpiSwiGLU {
    static constexpr bool PERM = true, AFTER_DRAIN = false;
    bf16_t* H; int ldc; const float* rs;
    __device__ __forceinline__ size_t tiled(int hp, int pn, int wr, int wc, int fr, int fq) const {
        return ((size_t)hp * (size_t)(ldc >> 6) + (size_t)(pn * 2 + (wc >> 1))) * 16384u + (size_t)lds_byte(wr * 64 + fr, (wc & 1) * 32 + 8 * fq); }
    __device__ __forceinline__ void operator()(const f32x4 (&acc)[2][2][4][2], const Unit& u, int wr, int wc, int fr, int fq) const {
        const int row0 = u.pm * BM + wr * 64 + fr;
#pragma unroll
        for (int ai = 0; ai < 2; ++ai)
#pragma unroll
            for (int m = 0; m < 4; ++m) { bf16_t* rowp = (bf16_t*)((unsigned char*)H + tiled(u.pm * 2 + ai, u.pn, wr, wc, fr, fq) + m * 2048);
                const float r = rs ? rs[row0 + ai * HALF + m * 16] : 1.0f;
                float h[8], gg[8], tt[8];
#pragma unroll
                for (int n = 0; n < 2; ++n)
#pragma unroll
                    for (int e = 0; e < 4; ++e) gg[4 * n + e] = acc[ai][0][m][n][e] * r;
#pragma unroll
                for (int q = 0; q < 8; ++q) tt[q] = __builtin_amdgcn_exp2f(-gg[q]);
#pragma unroll
                for (int n = 0; n < 2; ++n)
#pragma unroll
                    for (int e = 0; e < 4; ++e) h[4 * n + e] = gg[4 * n + e] * acc[ai][1][m][n][e];
#pragma unroll
                for (int q = 0; q < 8; ++q) tt[q] = 1.0f + tt[q];
#pragma unroll
                for (int q = 0; q < 8; ++q) tt[q] = __builtin_amdgcn_rcpf(tt[q]);
#pragma unroll
                for (int q = 0; q < 8; ++q) h[q] = h[q] * tt[q];
                u32x4 w; w.x = cvt_pk_bf16(h[0], h[1]); w.y = cvt_pk_bf16(h[2], h[3]); w.z = cvt_pk_bf16(h[4], h[5]); w.w = cvt_pk_bf16(h[6], h[7]);
                *(u32x4*)rowp = w; }
    }
    __device__ __forceinline__ void half(const f32x4 (&acc)[2][2][4][2], int pmh, int pn, int wr, int wc, int fr, int fq) const {
        const int row0 = pmh * HALF + wr * 64 + fr;
#pragma unroll
        for (int m = 0; m < 4; ++m) { bf16_t* rowp = (bf16_t*)((unsigned char*)H + tiled(pmh, pn, wr, wc, fr, fq) + m * 2048);
            const float r = rs ? rs[row0 + m * 16] : 1.0f;
            float h[8];
#pragma unroll
            for (int n = 0; n < 2; ++n)
#pragma unroll
                for (int e = 0; e < 4; ++e) { const float g = acc[0][0][m][n][e] * r, up = acc[0][1][m][n][e]; h[4 * n + e] = g * __builtin_amdgcn_rcpf(1.0f + __builtin_amdgcn_exp2f(-g)) * up; }
            u32x4 w; w.x = cvt_pk_bf16(h[0], h[1]); w.y = cvt_pk_bf16(h[2], h[3]); w.z = cvt_pk_bf16(h[4], h[5]); w.w = cvt_pk_bf16(h[6], h[7]);
            *(u32x4*)rowp = w; }
    }
};
struct EpiProj {
    static constexpr bool PERM = true, AFTER_DRAIN = false;
    bf16_t* P; int ldc; const float* lb; const float* rs;
    __device__ __forceinline__ void operator()(const f32x4 (&acc)[2][2][4][2], const Unit& u, int wr, int wc, int fr, int fq) const {
        const int sec = u.pn >> 3;
        const int row0 = u.pm * BM + wr * 64 + fr, col0 = u.pn * BM + wc * 32 + 8 * fq;
        const bool isg = (sec == 1 || sec == 2), act = (sec == 0 || sec == 3); const float sc = (sec == 4) ? 0.08838834764831845f : 1.0f;
        const float* lbp = lb + (isg ? (col0 - 2048) : 0);
#pragma unroll
        for (int ai = 0; ai < 2; ++ai)
#pragma unroll
            for (int m = 0; m < 4; ++m) { bf16_t* rowp = P + (size_t)(row0 + ai * HALF + m * 16) * ldc + col0;
                const float r = rs[row0 + ai * HALF + m * 16];
#pragma unroll
                for (int bj = 0; bj < 2; ++bj) { float g[8]; u32x4 w;
                    if (isg) {
                        const f32x4 la = *(const f32x4*)(lbp + bj * HALF), lc = *(const f32x4*)(lbp + bj * HALF + 4);
#pragma unroll
                        for (int e = 0; e < 4; ++e) { const float f0 = la[e] + (1.0f - la[e]) * sigmoidf_fast(acc[ai][bj][m][0][e] * r), f1 = lc[e] + (1.0f - lc[e]) * sigmoidf_fast(acc[ai][bj][m][1][e] * r);
                            g[e] = __builtin_amdgcn_logf(f0); g[4 + e] = __builtin_amdgcn_logf(f1); }
                        w.x = cvt_pk_f16(g[0], g[1]); w.y = cvt_pk_f16(g[2], g[3]); w.z = cvt_pk_f16(g[4], g[5]); w.w = cvt_pk_f16(g[6], g[7]);
                    } else {
#pragma unroll
                        for (int n = 0; n < 2; ++n)
#pragma unroll
                            for (int e = 0; e < 4; ++e) { const float v = acc[ai][bj][m][n][e] * r; g[4 * n + e] = act ? v * sigmoidf_fast(v) : v * sc; }
                        w.x = cvt_pk_bf16(g[0], g[1]); w.y = cvt_pk_bf16(g[2], g[3]); w.z = cvt_pk_bf16(g[4], g[5]); w.w = cvt_pk_bf16(g[6], g[7]);
                    }
                    *(u32x4*)(rowp + bj * HALF) = w; }
                asm volatile("" ::: "memory"); }
    }
};

template <class Epi, class Sched, bool ALIGN_EPI = false, bool SP2 = false, bool B_TILED = false, bool A_TILED = false>
__device__ __forceinline__ void gemm_phase(PG8_LAS unsigned char* lds, const Gemm g, const Sched& S, const Epi& E) {
    static_assert(!B_TILED || Epi::PERM, "the pre-tiled B image carries the PERM row order");
    int tid_ = threadIdx.x; asm volatile("" : "+v"(tid_));
    const int tid = tid_, wid = __builtin_amdgcn_readfirstlane(tid >> 6), lane = tid & 63, wr = wid >> 2, wc = wid & 3, fr = lane & 15, fq = lane >> 4;
    const int K = g.K, nt = K / BK;
    unsigned voffA[2], voffB[2];
#pragma unroll
    for (int i = 0; i < 2; ++i) { int R, C; stage_rc(wid * 2048 + lane * 16 + i * 1024, R, C); const int Rb = Epi::PERM ? ((R & ~31) + perm32(R & 31)) : R;
        voffA[i] = A_TILED ? (unsigned)(wid * 2048 + lane * 16 + i * 1024) : (unsigned)(R * K + C) * 2u; voffB[i] = B_TILED ? (unsigned)(wid * 2048 + lane * 16 + i * 1024) : (unsigned)(Rb * K + C) * 2u; }
    const size_t kstep = A_TILED ? (size_t)HTB : (size_t)(BK * 2), kstepB = B_TILED ? (size_t)HTB : (size_t)(BK * 2);
    const size_t hstep = (size_t)HALF * K * 2;
    const size_t tstep = 2 * hstep;
    const unsigned ldsw = (unsigned)wid * 2048u;
    const int aoff = lds_byte(wr * 64 + fr, fq * 8), boff = lds_byte(wc * 32 + fr, fq * 8);
#define PG8_SA(b, h) (((b) * 2 + (h)) * HTB)
#define PG8_SB(b, h) ((4 + (b) * 2 + (h)) * HTB)
#define PG8_STAGE(bufoff, gbase, voff) do { const char* gb_ = (const char*)(gbase); asm volatile("" : "+s"(gb_)); _Pragma("unroll") for (int _i = 0; _i < 2; ++_i) { asm volatile("" : "+v"((voff)[_i])); \
        __builtin_amdgcn_global_load_lds((const unsigned*)(gb_ + (voff)[_i]), (PG8_LAS unsigned*)(lds + (bufoff) + ldsw + _i * 1024), 16, 0, 0); } } while (0)
#define PG8_LDA(dst, b, h) do { _Pragma("unroll") for (int m = 0; m < 4; ++m) _Pragma("unroll") for (int k = 0; k < 2; ++k) dst[m][k] = *(const PG8_LAS bf16x8*)(lds + PG8_SA(b, h) + aoff + m * 2048 + k * 1024); } while (0)
#define PG8_LDB(dst, b, h) do { _Pragma("unroll") for (int n = 0; n < 2; ++n) _Pragma("unroll") for (int k = 0; k < 2; ++k) dst[n][k] = *(const PG8_LAS bf16x8*)(lds + PG8_SB(b, h) + boff + n * 2048 + k * 1024); } while (0)
#define PG8_PRIO_IN(v) ((void)0)
#define PG8_PRIO_BLK(v) __builtin_amdgcn_s_setprio(v)
#define PG8_MMA(ai, bj, At, Bt) do { PG8_PRIO_IN(1); _Pragma("unroll") for (int k = 0; k < 2; ++k) _Pragma("unroll") for (int m = 0; m < 4; ++m) _Pragma("unroll") for (int nn = 0; nn < 2; ++nn) { const int n = (m & 1) ? 1 - nn : nn; \
        acc[ai][bj][m][n] = __builtin_amdgcn_mfma_f32_16x16x32_bf16(Bt[n][k], At[m][k], acc[ai][bj][m][n], 0, 0, 0); } PG8_PRIO_IN(0); } while (0)
#define PG8_MMA0(ai, bj, At, Bt) do { PG8_PRIO_IN(1); _Pragma("unroll") for (int k = 0; k < 2; ++k) _Pragma("unroll") for (int m = 0; m < 4; ++m) _Pragma("unroll") for (int nn = 0; nn < 2; ++nn) { const int n = (m & 1) ? 1 - nn : nn; \
        acc[ai][bj][m][n] = __builtin_amdgcn_mfma_f32_16x16x32_bf16(Bt[n][k], At[m][k], (k == 0) ? (f32x4){0.f, 0.f, 0.f, 0.f} : acc[ai][bj][m][n], 0, 0, 0); } PG8_PRIO_IN(0); } while (0)
#define PG8_WAIT_V(n) asm volatile("s_waitcnt vmcnt(" #n ")" ::: "memory")
#define PG8_WAIT_L(n) asm volatile("s_waitcnt lgkmcnt(" #n ")" ::: "memory")
#define PG8_BAR __builtin_amdgcn_s_barrier()
#define PG8_SCHED __builtin_amdgcn_sched_barrier(0)
    Unit cur, nxt; int ui = 0;
    if (!S.next(0, cur)) return;
    f32x4 acc[2][2][4][2];
    if constexpr (!SP2) {
#pragma unroll
    for (int a = 0; a < 2; ++a)
#pragma unroll
        for (int b = 0; b < 2; ++b)
#pragma unroll
            for (int m = 0; m < 4; ++m)
#pragma unroll
                for (int n = 0; n < 2; ++n) acc[a][b][m][n] = (f32x4){0.f, 0.f, 0.f, 0.f};
    }
    bf16x8 At[4][2], B0[2][2], B1[2][2];
    const char* cA = (const char*)g.A + (size_t)cur.pm * tstep; const char* cB = (const char*)g.Bt + (size_t)cur.pn * tstep;
    S.a_ready(cur);
    if constexpr (SP2) {
        PG8_STAGE(PG8_SB(0, 0), cB, voffB); PG8_STAGE(PG8_SB(0, 1), cB + hstep, voffB); PG8_STAGE(PG8_SA(0, 0), cA, voffA); PG8_STAGE(PG8_SA(0, 1), cA + hstep, voffA);
        if (wr == 1) PG8_BAR;
        PG8_WAIT_V(2); PG8_BAR;
        PG8_STAGE(PG8_SB(1, 0), cB + kstepB, voffB); PG8_STAGE(PG8_SA(1, 0), cA + kstep, voffA); PG8_STAGE(PG8_SB(1, 1), cB + hstep + kstepB, voffB);
        PG8_WAIT_V(6); PG8_BAR;
    } else {
        PG8_STAGE(PG8_SB(0, 0), cB, voffB); PG8_STAGE(PG8_SA(0, 0), cA, voffA); PG8_STAGE(PG8_SB(0, 1), cB + hstep, voffB); PG8_STAGE(PG8_SA(0, 1), cA + hstep, voffA);
        if (wr == 1) PG8_BAR;
        PG8_WAIT_V(4); PG8_BAR;
        PG8_STAGE(PG8_SB(1, 0), cB + kstepB, voffB); PG8_STAGE(PG8_SA(1, 0), cA + kstep, voffA); PG8_STAGE(PG8_SB(1, 1), cB + hstep + kstepB, voffB);
        PG8_WAIT_V(6); PG8_BAR;
    }
    for (;;) {
        const bool has_next = S.next(ui + 1, nxt);
        const char* nA = has_next ? (const char*)g.A + (size_t)nxt.pm * tstep : cA; const char* nB = has_next ? (const char*)g.Bt + (size_t)nxt.pn * tstep : cB;
#define PG8_PTRS() const bool last = (t == nt - 2); \
            const char* a1 = cA + (size_t)(t + 1) * kstep; \
            const char* a2 = last ? nA : cA + (size_t)(t + 2) * kstep; const char* b2 = last ? nB : cB + (size_t)(t + 2) * kstepB; \
            const char* a3 = a2 + kstep; const char* b3 = b2 + kstepB; \
            if (last && has_next) S.a_ready(nxt)
#define PG8_SP2_PAIR(MF) do { PG8_PTRS(); \
            PG8_LDB(B0, 0, 0); PG8_LDB(B1, 0, 1); PG8_SCHED; PG8_LDA(At, 0, 0); PG8_STAGE(PG8_SA(1, 1), a1 + hstep, voffA); \
            PG8_WAIT_V(8); PG8_WAIT_L(0); PG8_BAR; PG8_PRIO_BLK(1); MF(0, 0, At, B0); MF(0, 1, At, B1); PG8_PRIO_BLK(0); PG8_BAR; PG8_SCHED; \
            PG8_LDA(At, 0, 1); PG8_STAGE(PG8_SB(0, 0), b2, voffB); PG8_STAGE(PG8_SB(0, 1), b2 + hstep, voffB); PG8_STAGE(PG8_SA(0, 0), a2, voffA); \
            PG8_WAIT_V(8); PG8_WAIT_L(0); PG8_BAR; PG8_PRIO_BLK(1); MF(1, 0, At, B0); MF(1, 1, At, B1); PG8_PRIO_BLK(0); PG8_BAR; PG8_SCHED; \
            PG8_LDB(B0, 1, 0); PG8_LDB(B1, 1, 1); PG8_SCHED; PG8_LDA(At, 1, 0); PG8_STAGE(PG8_SA(0, 1), a2 + hstep, voffA); \
            PG8_WAIT_V(8); PG8_WAIT_L(0); PG8_BAR; PG8_PRIO_BLK(1); PG8_MMA(0, 0, At, B0); PG8_MMA(0, 1, At, B1); PG8_PRIO_BLK(0); PG8_BAR; PG8_SCHED; \
            PG8_LDA(At, 1, 1); PG8_STAGE(PG8_SB(1, 0), b3, voffB); PG8_STAGE(PG8_SB(1, 1), b3 + hstep, voffB); PG8_STAGE(PG8_SA(1, 0), a3, voffA); \
            PG8_WAIT_V(8); PG8_WAIT_L(0); PG8_BAR; PG8_PRIO_BLK(1); PG8_MMA(1, 0, At, B0); PG8_MMA(1, 1, At, B1); PG8_PRIO_BLK(0); PG8_BAR; PG8_SCHED; } while (0)
        if constexpr (SP2) {
            { const int t = 0; PG8_SP2_PAIR(PG8_MMA0); }
            for (int t = 2; t < nt; t += 2) PG8_SP2_PAIR(PG8_MMA);
        } else {
        for (int t = 0; t < nt; t += 2) {
            PG8_PTRS();
            {
            PG8_LDB(B0, 0, 0); PG8_SCHED; PG8_LDA(At, 0, 0); PG8_STAGE(PG8_SA(1, 1), a1 + hstep, voffA);
            PG8_WAIT_L(8); PG8_BAR; PG8_WAIT_L(0); PG8_MMA(0, 0, At, B0); PG8_BAR; PG8_SCHED;
            PG8_LDB(B1, 0, 1); PG8_STAGE(PG8_SB(0, 0), b2, voffB);
            PG8_BAR; PG8_WAIT_L(0); PG8_MMA(0, 1, At, B1); PG8_BAR;
            PG8_LDA(At, 0, 1); PG8_STAGE(PG8_SA(0, 0), a2, voffA);
            PG8_BAR; PG8_WAIT_L(0); PG8_MMA(1, 0, At, B0); PG8_BAR; PG8_SCHED;
            PG8_STAGE(PG8_SB(0, 1), b2 + hstep, voffB);
            PG8_WAIT_V(6); PG8_BAR; PG8_MMA(1, 1, At, B1); PG8_BAR;
            PG8_LDB(B0, 1, 0); PG8_SCHED; PG8_LDA(At, 1, 0); PG8_STAGE(PG8_SA(0, 1), a2 + hstep, voffA);
            PG8_WAIT_L(8); PG8_BAR; PG8_WAIT_L(0); PG8_MMA(0, 0, At, B0); PG8_BAR; PG8_SCHED;
            PG8_LDB(B1, 1, 1); PG8_STAGE(PG8_SB(1, 0), b3, voffB);
            PG8_BAR; PG8_WAIT_L(0); PG8_MMA(0, 1, At, B1); PG8_BAR;
            PG8_LDA(At, 1, 1); PG8_STAGE(PG8_SA(1, 0), a3, voffA);
            PG8_BAR; PG8_WAIT_L(0); PG8_MMA(1, 0, At, B0); PG8_BAR; PG8_SCHED;
            PG8_STAGE(PG8_SB(1, 1), b3 + hstep, voffB);
            PG8_WAIT_V(6); PG8_BAR; PG8_MMA(1, 1, At, B1); PG8_BAR;
            }
        }
        }
        if constexpr (ALIGN_EPI) { if (wr == 0) PG8_BAR; }
        if constexpr (!Epi::AFTER_DRAIN) { E(acc, cur, wr, wc, fr, fq); if (EPI_TWICE) { asm volatile("" ::: "memory"); E(acc, cur, wr, wc, fr, fq); } S.done(cur); }
        if (!has_next) break;
        if constexpr (!SP2) {
#pragma unroll
        for (int a = 0; a < 2; ++a)
#pragma unroll
            for (int b = 0; b < 2; ++b)
#pragma unroll
                for (int m = 0; m < 4; ++m)
#pragma unroll
                    for (int n = 0; n < 2; ++n) acc[a][b][m][n] = (f32x4){0.f, 0.f, 0.f, 0.f};
        }
        cur = nxt; cA = nA; cB = nB; ++ui;
        if constexpr (ALIGN_EPI) { if (wr == 1) PG8_BAR; }
    }
    PG8_WAIT_V(0);
    if constexpr (!ALIGN_EPI) { if (wr == 0) PG8_BAR; }
    PG8_BAR;
}

template <class Epi, bool B_TILED = false, bool A_TILED = false>
__device__ __forceinline__ void gemm_half_units(PG8_LAS unsigned char* lds, const Gemm g, int pn0, int npn, const Epi& E, int bx, int nwg) {
    int tid_ = threadIdx.x; asm volatile("" : "+v"(tid_));
    const int tid = tid_, wid = __builtin_amdgcn_readfirstlane(tid >> 6), lane = tid & 63, wr = wid >> 2, wc = wid & 3, fr = lane & 15, fq = lane >> 4;
    const int K = g.K, nt = K / BK;
    unsigned voffA[2], voffB[2];
#pragma unroll
    for (int i = 0; i < 2; ++i) { int R, C; stage_rc(wid * 2048 + lane * 16 + i * 1024, R, C); const int Rb = Epi::PERM ? ((R & ~31) + perm32(R & 31)) : R;
        voffA[i] = A_TILED ? (unsigned)(wid * 2048 + lane * 16 + i * 1024) : (unsigned)(R * K + C) * 2u; voffB[i] = B_TILED ? (unsigned)(wid * 2048 + lane * 16 + i * 1024) : (unsigned)(Rb * K + C) * 2u; }
    const size_t kstep = A_TILED ? (size_t)HTB : (size_t)(BK * 2), kstepB = B_TILED ? (size_t)HTB : (size_t)(BK * 2);
    const size_t hstep = (size_t)HALF * K * 2;
    const size_t tstep = 2 * hstep;
    const unsigned ldsw = (unsigned)wid * 2048u;
    const int aoff = lds_byte(wr * 64 + fr, fq * 8), boff = lds_byte(wc * 32 + fr, fq * 8);
    const int nunits = (g.M / HALF) * npn;
    for (int v = bx; v < nunits; v += nwg) {
        const int xcd = v & 7, j = v >> 3, pn = pn0 + j % npn, pmh = (j / npn) * NXCD + xcd;
        f32x4 acc[2][2][4][2];
#pragma unroll
        for (int b = 0; b < 2; ++b)
#pragma unroll
            for (int m = 0; m < 4; ++m)
#pragma unroll
                for (int n = 0; n < 2; ++n) acc[0][b][m][n] = (f32x4){0.f, 0.f, 0.f, 0.f};
        bf16x8 At[4][2], B0[2][2], B1[2][2];
        const char* cA = (const char*)g.A + (size_t)pmh * hstep; const char* cB = (const char*)g.Bt + (size_t)pn * tstep;
        PG8_STAGE(PG8_SB(0, 0), cB, voffB); PG8_STAGE(PG8_SB(0, 1), cB + hstep, voffB); PG8_STAGE(PG8_SA(0, 0), cA, voffA);
        PG8_STAGE(PG8_SB(1, 0), cB + kstepB, voffB); PG8_STAGE(PG8_SB(1, 1), cB + hstep + kstepB, voffB); PG8_STAGE(PG8_SA(1, 0), cA + kstep, voffA);
        PG8_WAIT_V(6); PG8_BAR;
        for (int t = 0; t < nt; t += 2) {
            const int t2 = (t + 2 < nt) ? t + 2 : t;
            const size_t o2 = (size_t)t2 * kstep, o3 = o2 + kstep, p2 = (size_t)t2 * kstepB, p3 = p2 + kstepB;
            PG8_LDB(B0, 0, 0); PG8_LDB(B1, 0, 1); PG8_LDA(At, 0, 0); PG8_WAIT_L(0); PG8_BAR;
            PG8_STAGE(PG8_SB(0, 0), cB + p2, voffB); PG8_STAGE(PG8_SB(0, 1), cB + hstep + p2, voffB); PG8_STAGE(PG8_SA(0, 0), cA + o2, voffA);
            PG8_PRIO_BLK(1); PG8_MMA(0, 0, At, B0); PG8_MMA(0, 1, At, B1); PG8_PRIO_BLK(0);
            PG8_WAIT_V(6); PG8_BAR; PG8_SCHED;
            PG8_LDB(B0, 1, 0); PG8_LDB(B1, 1, 1); PG8_LDA(At, 1, 0); PG8_WAIT_L(0); PG8_BAR;
            PG8_STAGE(PG8_SB(1, 0), cB + p3, voffB); PG8_STAGE(PG8_SB(1, 1), cB + hstep + p3, voffB); PG8_STAGE(PG8_SA(1, 0), cA + o3, voffA);
            PG8_PRIO_BLK(1); PG8_MMA(0, 0, At, B0); PG8_MMA(0, 1, At, B1); PG8_PRIO_BLK(0);
            PG8_WAIT_V(6); PG8_BAR; PG8_SCHED;
        }
        PG8_WAIT_V(0); PG8_BAR;
        E.half(acc, pmh, pn, wr, wc, fr, fq);
    }
    PG8_WAIT_V(0); PG8_BAR;
#undef PG8_SA
#undef PG8_SB
#undef PG8_STAGE
#undef PG8_LDA
#undef PG8_LDB
#undef PG8_MMA
#undef PG8_PRIO_IN
#undef PG8_PRIO_BLK
#undef PG8_MMA0
#undef PG8_PTRS
#undef PG8_SP2_PAIR
#undef PG8_WAIT_V
#undef PG8_WAIT_L
#undef PG8_BAR
#undef PG8_SCHED
}
}

constexpr int NWAVES = 8;
constexpr int DM = 4096, BATCH = 4, SEQ = 4096, MROWS = BATCH * SEQ;
constexpr int FF = 11008, HGW = 2048, NAW = 2048, HD = 128, NHEAD = 16;
constexpr int PROJ_W = 12288;
constexpr int C_Q = 0, C_GF = 2048, C_GB = 4096, C_GATE = 6144, C_NQ = 8192, C_NK = 10240;
constexpr int GRID_W = 64, NROWS = 64, WIN_R = 8, WIN_C = 16;
constexpr float EPS = 1e-6f;
constexpr int N_PHASES = 12;
constexpr int GU_MAIN_N = 84 * 256;
static_assert(GU_MAIN_N % 256 == 0 && (2 * FF - GU_MAIN_N) % 256 == 0 && GU_MAIN_N <= 2 * FF, "gate/up split");

constexpr size_t MiB = 1u << 20;
constexpr size_t WS_CTL = 0, CTL_ZERO_BYTES = 64 * 1024;
constexpr size_t WS_LB = 1 * MiB;
constexpr size_t WS_WGU1 = 2 * MiB, WS_WD1 = 174 * MiB, WS_WIN = 260 * MiB, WS_WOUT = 388 * MiB, WS_WGU2 = 420 * MiB, WS_WD2 = 592 * MiB;
constexpr size_t WS_R1 = 678 * MiB;
constexpr size_t WS_TT = WS_R1 + 384 * MiB;
constexpr size_t WS_R2 = 1190 * MiB;
constexpr size_t WS_R3 = 1446 * MiB;
constexpr size_t WS_END = 1574 * MiB;
static_assert((size_t)2 * FF * DM * 2 <= 172 * MiB && (size_t)FF * DM * 2 <= 86 * MiB, "weights");
static_assert((size_t)MROWS * PROJ_W * 2 == 384 * MiB && (size_t)MROWS * FF * 2 <= 512 * MiB, "R1");
constexpr int CW_TMO = 0, CW_CODE = 1;
constexpr int CW_BAR = 4096;
constexpr int CW_QUEUE = 8192;

constexpr int RING_OFF = 0, RING_BYTES = 131072;
constexpr int LDSCTL_OFF = RING_BYTES, MISC_OFF = LDSCTL_OFF + 320;
constexpr int LDS_BYTES = 147456;

#define GAS __attribute__((address_space(1)))
#define LAS __attribute__((address_space(3)))
typedef unsigned short bf16;
typedef unsigned v4u __attribute__((ext_vector_type(4)));
typedef unsigned v2u __attribute__((ext_vector_type(2)));
typedef float f32x4 __attribute__((ext_vector_type(4)));
typedef GAS unsigned gu32;
#define RLX_AGENT __ATOMIC_RELAXED, __HIP_MEMORY_SCOPE_AGENT
#define LDS_WAIT() asm volatile("s_waitcnt lgkmcnt(0)" ::: "memory")
#define VM_WAIT() asm volatile("s_waitcnt vmcnt(0)" ::: "memory")
__device__ __forceinline__ unsigned f2bf(float f) { unsigned u = __builtin_bit_cast(unsigned, f); return (u + 0x7fffu + ((u >> 16) & 1u)) >> 16; }
__device__ __forceinline__ unsigned pk2(float lo, float hi) { return f2bf(lo) | (f2bf(hi) << 16); }
__device__ __forceinline__ float bf2f(unsigned short b) { return __builtin_bit_cast(float, (unsigned)b << 16); }
__device__ __forceinline__ float bflo(unsigned w) { return __builtin_bit_cast(float, w << 16); }
__device__ __forceinline__ float bfhi(unsigned w) { return __builtin_bit_cast(float, w & 0xffff0000u); }
__device__ __forceinline__ float h2f(unsigned short b) { return (float)__builtin_bit_cast(_Float16, b); }

#define XB_TMO      128
#define XB_XCNT(j)  (256  + 64 * (j))
#define XB_XSUB(j)  (1280 + 64 * (j))
#define XB_XGEN(j)  (2304 + 64 * (j))
#define XB_TOP      3328
#define XB_TOPGEN   3392
#define XCD_BAR_WORDS 3456
#define XB_SPIN_CAP (1u << 18)
__device__ __forceinline__ unsigned xb_ld(unsigned* p)              { return __hip_atomic_load(p, __ATOMIC_RELAXED, __HIP_MEMORY_SCOPE_AGENT); }
__device__ __forceinline__ unsigned xb_add(unsigned* p, unsigned v) { return __hip_atomic_fetch_add(p, v, __ATOMIC_RELAXED, __HIP_MEMORY_SCOPE_AGENT); }
__device__ __forceinline__ unsigned xb_xcc_id() { return (unsigned)__builtin_amdgcn_s_getreg((3 << 11) | 20) & 0xFu; }
#define XB_SPIN(cond, bar) do { unsigned _sp = 0; while (cond) { __builtin_amdgcn_s_sleep(1); \
    if ((++_sp & 255u) == 0u) { if (xb_ld(&(bar)[XB_TMO])) break; if (_sp > XB_SPIN_CAP) { atomicAdd(&(bar)[XB_TMO], 1u); break; } } } } while (0)
struct XcdBarrier { unsigned* bar; unsigned x; volatile LAS unsigned* st; };
__device__ __forceinline__ XcdBarrier xcd_barrier_post(unsigned* bar, volatile LAS unsigned* st) {
    XcdBarrier b; b.bar = bar; b.x = xb_xcc_id(); b.st = st;
    if (threadIdx.x == 0) (void)xb_add(&bar[XB_XCNT(b.x)], 1u);
    return b;
}
__device__ __forceinline__ void xcd_barrier_complete(unsigned* bar, unsigned x, unsigned& nloc, unsigned& nx) {
    const unsigned G = gridDim.x * gridDim.y * gridDim.z;
    unsigned sum, cnt, mine, sp = 0u;
    for (;;) {
        sum = 0u; cnt = 0u; mine = 0u;
#pragma unroll
        for (unsigned j = 0; j < 16; ++j) { const unsigned c = xb_ld(&bar[XB_XCNT(j)]); sum += c; cnt += (c > 0u) ? 1u : 0u; mine = (j == x) ? c : mine; }
        if (sum == G) break;
        __builtin_amdgcn_s_sleep(1);
        if ((++sp & 255u) == 0u) { if (xb_ld(&bar[XB_TMO])) break; if (sp > XB_SPIN_CAP) { atomicAdd(&bar[XB_TMO], 1u); break; } }
    }
    nloc = mine > 0u ? mine : 1u; nx = cnt > 0u ? cnt : 1u;
}
__device__ __forceinline__ void xcd_barrier(const XcdBarrier& b) {
    asm volatile("s_waitcnt vmcnt(0)" ::: "memory");
    __syncthreads();
    if (threadIdx.x == 0) {
        unsigned* bar = b.bar;
        __builtin_amdgcn_s_waitcnt(0);
        unsigned nloc = b.st[0], nx = b.st[1];
        if (nloc == 0u) { xcd_barrier_complete(bar, b.x, nloc, nx); b.st[0] = nloc; b.st[1] = nx; }
        const unsigned old = xb_add(&bar[XB_XSUB(b.x)], 1u);
        const unsigned gen = old / nloc;
        if (old + 1u == (gen + 1u) * nloc) {
            __builtin_amdgcn_fence(__ATOMIC_RELEASE, "agent");
            asm volatile("s_waitcnt vmcnt(0)" ::: "memory");
            const unsigned og = xb_add(&bar[XB_TOP], 1u);
            const unsigned tg = og / nx;
            if (og + 1u == (tg + 1u) * nx) xb_add(&bar[XB_TOPGEN], 1u);
            else XB_SPIN(xb_ld(&bar[XB_TOPGEN]) == tg, bar);
            __builtin_amdgcn_fence(__ATOMIC_ACQUIRE, "agent");
            xb_add(&bar[XB_XGEN(b.x)], 1u);
            asm volatile("s_waitcnt vmcnt(0)" ::: "memory");
        } else {
            XB_SPIN(xb_ld(&bar[XB_XGEN(b.x)]) == gen, bar);
            __builtin_amdgcn_fence(__ATOMIC_ACQUIRE, "agent");
            asm volatile("s_waitcnt vmcnt(0)" ::: "memory");
        }
    }
    __syncthreads();
}

__device__ __forceinline__ float wave_sum(float v) {
#pragma unroll
    for (int o = 1; o < 64; o <<= 1) v += __shfl_xor(v, o);
    return v;
}
__device__ __forceinline__ float wave_max(float v) {
#pragma unroll
    for (int o = 1; o < 64; o <<= 1) v = fmaxf(v, __shfl_xor(v, o));
    return v;
}
__device__ __forceinline__ void transpose_item(const float* W, int K, int N, bf16* WT, int mode, LAS float* scr, int item, int lane, const float* gain, int tiled_rows, float wscale) {
    const int nblk = N / 32, kb = item / nblk, nb = item % nblk, k0 = 64 * kb, n0 = 32 * nb;
    const int rbase = (mode == 0) ? n0 : (mode == 3) ? (((0x75436210u >> (4 * (n0 >> 11))) & 7u) * 2048 + (n0 & 2047)) : (256 * (n0 >> 7) + (n0 & 127) + (mode == 2 ? 128 : 0));
#pragma unroll 8
    for (int i = 0; i < 32; ++i) { const int kk = 2 * i + (lane >> 5); scr[kk * 33 + (lane & 31)] = W[(size_t)(k0 + kk) * N + n0 + (lane & 31)]; }
    LDS_WAIT(); asm volatile("" ::: "memory");
    const int c = lane & 7;
    f32x4 ga = (f32x4){1.f, 1.f, 1.f, 1.f}, gb = ga;
    if (gain) { ga = *(const GAS f32x4*)(gain + k0 + 8 * c); gb = *(const GAS f32x4*)(gain + k0 + 8 * c + 4); }
    ga = ga * wscale; gb = gb * wscale;
#pragma unroll
    for (int j = 0; j < 4; ++j) { const int n = (lane >> 3) + 8 * j; const LAS float* s = scr + (8 * c) * 33 + n;
        v4u o; o.x = pk2(s[0 * 33] * ga.x, s[1 * 33] * ga.y); o.y = pk2(s[2 * 33] * ga.z, s[3 * 33] * ga.w); o.z = pk2(s[4 * 33] * gb.x, s[5 * 33] * gb.y); o.w = pk2(s[6 * 33] * gb.z, s[7 * 33] * gb.w);
        const int r = rbase + n;
        size_t ob;
        if (r < tiled_rows) { const int rr = r & 127, x = rr & 31, R = (rr & ~31) + 16 * ((x >> 2) & 1) + 4 * (x >> 3) + (x & 3);
            ob = ((size_t)(r >> 7) * (size_t)(K >> 6) + (size_t)(k0 >> 6)) * 16384u + (size_t)pg8::lds_byte(R, 8 * c); }
        else ob = ((size_t)r * K + k0 + 8 * c) * 2;
        *(GAS v4u*)((GAS unsigned char*)WT + ob) = o; }
    LDS_WAIT(); asm volatile("" ::: "memory");
}
__device__ __forceinline__ size_t tiled_off(int m, int k, int ktiles) { return ((size_t)(m >> 7) * (size_t)ktiles + (size_t)(k >> 6)) * 16384u + (size_t)pg8::lds_byte(m & 127, k & 63); }
__device__ __forceinline__ void rms_rowpair_to_bf16_tiled(const float* x, bf16* obase, int m0, int lane) {
    const int li = lane & 31, m = m0 + (lane >> 5);
    const GAS f32x4* xr = (const GAS f32x4*)(x + (size_t)m * DM) + li;
    f32x4 v[32]; float ss = 0.f;
#pragma unroll
    for (int j = 0; j < 32; ++j) v[j] = xr[32 * j];
#pragma unroll
    for (int j = 0; j < 32; ++j) ss += (v[j].x * v[j].x + v[j].y * v[j].y) + (v[j].z * v[j].z + v[j].w * v[j].w);
#pragma unroll
    for (int o = 1; o < 32; o <<= 1) ss += __shfl_xor(ss, o);
    const float rs = 1.0f / sqrtf(ss * (1.0f / DM) + EPS);
    GAS unsigned char* o8 = (GAS unsigned char*)obase + tiled_off(m, 4 * li, DM / 64);
#pragma unroll
    for (int j = 0; j < 32; ++j) { const f32x4 a = v[j]; v2u w; w.x = pk2(a.x * rs, a.y * rs); w.y = pk2(a.z * rs, a.w * rs); *(GAS v2u*)(o8 + (size_t)j * 32768u) = w; }
}
__device__ __forceinline__ void rms_row_to_bf16(const float* xrow, const float* gain, bf16* orow, int lane) {
    const GAS f32x4* xr = (const GAS f32x4*)xrow + lane; const GAS f32x4* gr = (const GAS f32x4*)gain + lane;
    f32x4 v[16], gg[16]; float ss = 0.f;
#pragma unroll
    for (int j = 0; j < 16; ++j) { v[j] = xr[64 * j]; gg[j] = gr[64 * j]; }
#pragma unroll
    for (int j = 0; j < 16; ++j) ss += (v[j].x * v[j].x + v[j].y * v[j].y) + (v[j].z * v[j].z + v[j].w * v[j].w);
    const float rs = 1.0f / sqrtf(wave_sum(ss) * (1.0f / DM) + EPS);
    GAS v2u* o8 = (GAS v2u*)orow + lane;
#pragma unroll
    for (int j = 0; j < 16; ++j) { const f32x4 g = gg[j]; v2u w; w.x = pk2(v[j].x * rs * g.x, v[j].y * rs * g.y); w.y = pk2(v[j].z * rs * g.z, v[j].w * rs * g.w); o8[64 * j] = w; }
}
template <bool BASE_TILED, bool OUT_TILED>
__device__ __forceinline__ void norm_res_rowpair(const bf16* ffbuf, const bf16* basebuf, void* outbuf, float w, const LAS float* gl, float* rsout, const float* bscale, int m0, int lane) {
    const int li = lane & 31, m = m0 + (lane >> 5);
    const unsigned toff = (unsigned)tiled_off(m, 4 * li, DM / 64), roff2 = (unsigned)((size_t)m * DM * 2 + (size_t)li * 8), roff4 = (unsigned)((size_t)m * DM * 4 + (size_t)li * 16);
    v2u f[32], b[32];
    { unsigned o_ = roff2; asm volatile("" : "+v"(o_));
#pragma unroll
      for (int j = 0; j < 32; ++j) f[j] = *(const GAS v2u*)((const GAS unsigned char*)ffbuf + (size_t)j * 256u + o_); }
    { unsigned o_ = BASE_TILED ? toff : roff2; asm volatile("" : "+v"(o_));
#pragma unroll
      for (int j = 0; j < 32; ++j) b[j] = *(const GAS v2u*)((const GAS unsigned char*)basebuf + (size_t)j * (BASE_TILED ? 32768u : 256u) + o_); }
    const float bs = bscale ? 1.0f / bscale[m] : 1.0f;
    float ss = 0.f;
#pragma unroll
    for (int j = 0; j < 32; ++j) { const float a0 = bflo(f[j].x), a1 = bfhi(f[j].x), a2 = bflo(f[j].y), a3 = bfhi(f[j].y); ss += (a0 * a0 + a1 * a1) + (a2 * a2 + a3 * a3); }
#pragma unroll
    for (int o = 1; o < 32; o <<= 1) ss += __shfl_xor(ss, o);
    const float rs = w / sqrtf(ss * (1.0f / DM) + EPS);
    const LAS unsigned char* gl_ = (const LAS unsigned char*)gl + li * 16;
#define NRP_H(j) const f32x4 g = *(const LAS f32x4*)(gl_ + (j) * 512); \
        asm volatile("" : "+v"(f[j].x), "+v"(f[j].y), "+v"(b[j].x), "+v"(b[j].y));       \
        f32x4 h; h.x = bflo(b[j].x) * bs + bflo(f[j].x) * rs * g.x; h.y = bfhi(b[j].x) * bs + bfhi(f[j].x) * rs * g.y; h.z = bflo(b[j].y) * bs + bflo(f[j].y) * rs * g.z; h.w = bfhi(b[j].y) * bs + bfhi(f[j].y) * rs * g.w
    if constexpr (OUT_TILED) {
        float s2 = 0.f;
#pragma unroll
        for (int j = 0; j < 32; ++j) { NRP_H(j); s2 += (h.x * h.x + h.y * h.y) + (h.z * h.z + h.w * h.w); if ((j & 3) == 3) asm volatile("" ::: "memory"); }
#pragma unroll
        for (int o = 1; o < 32; o <<= 1) s2 += __shfl_xor(s2, o);
        const float r2 = 1.0f / sqrtf(s2 * (1.0f / DM) + EPS);
        if (li == 0) rsout[m] = r2;
        unsigned o_ = toff; asm volatile("" : "+v"(o_));
#pragma unroll
        for (int j = 0; j < 32; ++j) { NRP_H(j); v2u o; o.x = pk2(h.x * r2, h.y * r2); o.y = pk2(h.z * r2, h.w * r2); *(GAS v2u*)((GAS unsigned char*)outbuf + (size_t)j * 32768u + o_) = o;
            if ((j & 3) == 3) asm volatile("" ::: "memory"); }
    } else {
        unsigned o_ = roff4; asm volatile("" : "+v"(o_));
#pragma unroll
        for (int j = 0; j < 32; ++j) { NRP_H(j); *(GAS f32x4*)((GAS unsigned char*)outbuf + (size_t)j * 512u + o_) = h; if ((j & 3) == 3) asm volatile("" ::: "memory"); }
    }
#undef NRP_H
}
template <bool BASE_BF16, bool OUT_BF16>
__device__ __forceinline__ void norm_res_row(const bf16* ffrow, const void* baserow, void* hrow, float w, const float* gpost, float* rsrow, int lane) {
    const GAS v2u* fr = (const GAS v2u*)ffrow + lane; const GAS f32x4* gp = (const GAS f32x4*)gpost + lane;
    f32x4 v[16]; float ss = 0.f;
    v2u rb16[16]; f32x4 rb32[BASE_BF16 ? 1 : 16];
#pragma unroll
    for (int j = 0; j < 16; ++j) { if (BASE_BF16) rb16[j] = ((const GAS v2u*)baserow + lane)[64 * j]; else rb32[j] = ((const GAS f32x4*)baserow + lane)[64 * j]; }
#pragma unroll
    for (int j = 0; j < 16; ++j) { const v2u r = fr[64 * j]; v[j] = (f32x4){bflo(r.x), bfhi(r.x), bflo(r.y), bfhi(r.y)}; ss += (v[j].x * v[j].x + v[j].y * v[j].y) + (v[j].z * v[j].z + v[j].w * v[j].w); }
    const float rs = w / sqrtf(wave_sum(ss) * (1.0f / DM) + EPS);
    float s2 = 0.f;
#pragma unroll
    for (int j = 0; j < 16; ++j) { const f32x4 g = gp[64 * j]; f32x4 b;
        if (BASE_BF16) { const v2u r = rb16[j]; b = (f32x4){bflo(r.x), bfhi(r.x), bflo(r.y), bfhi(r.y)}; } else b = rb32[j];
        v[j] = b + v[j] * rs * g;
        if (OUT_BF16) { v2u o; o.x = pk2(v[j].x, v[j].y); o.y = pk2(v[j].z, v[j].w); ((GAS v2u*)hrow + lane)[64 * j] = o; } else ((GAS f32x4*)hrow + lane)[64 * j] = v[j];
        s2 += (v[j].x * v[j].x + v[j].y * v[j].y) + (v[j].z * v[j].z + v[j].w * v[j].w); }
    if (rsrow) {
        const float r2 = 1.0f / sqrtf(wave_sum(s2) * (1.0f / DM) + EPS);
        if (lane == 0) *rsrow = r2;
    }
}

constexpr int HG_QB = 0, HG_KT = 8704, HG_KTT = 17408, HG_SC = 27648, HG_EL = 30208, HG_QT = 30720;
typedef short bf16x8 __attribute__((ext_vector_type(8)));
typedef short bf16x4 __attribute__((ext_vector_type(4)));
__device__ __forceinline__ void hgrn_mfma_unit(LAS unsigned char* lds0, const bf16* proj, const bf16* it, bf16* obuf, int b, int h, int dir, int tid) {
    const int lane = tid & 63, wave = __builtin_amdgcn_readfirstlane(tid >> 6), i16 = lane & 15, g = lane >> 4;
    const int k = 16 * wave + i16, qd = g;
    const size_t rowbase = (size_t)b * SEQ;
    const int gcol = (dir ? C_GB : C_GF) + h * HD + k, qcol = C_Q + h * HD + k;
    f32x4 S[8];
#pragma unroll
    for (int kt = 0; kt < 8; ++kt) S[kt] = (f32x4){0.f, 0.f, 0.f, 0.f};
    const GAS unsigned char* vbase = (const GAS unsigned char*)it + ((size_t)(h * HD + 16 * wave) * MROWS + rowbase) * 2;
    const GAS unsigned char* pbase = (const GAS unsigned char*)proj + rowbase * (size_t)(PROJ_W * 2);
    GAS unsigned char* obase = (GAS unsigned char*)obuf + (rowbase * (size_t)HGW + h * HD + 16 * wave) * 2;
    const unsigned lv = (unsigned)(i16 * MROWS + 8 * g) * 2u, lq = (unsigned)(8 * qd * PROJ_W + qcol) * 2u, lg = (unsigned)(8 * qd * PROJ_W + gcol) * 2u, lo_ = (unsigned)(4 * g * HGW + i16) * 2u;
    unsigned short qn[8], gn[8]; bf16x8 vn; f32x4 op[2]; op[0] = (f32x4){0.f, 0.f, 0.f, 0.f}; op[1] = op[0];
    { const int t0 = dir ? (SEQ - 32) : 0; vn = *(const GAS bf16x8*)(vbase + (size_t)t0 * 2 + lv);
#pragma unroll
      for (int j = 0; j < 8; ++j) { const GAS unsigned char* ub = pbase + (size_t)(t0 + j) * (PROJ_W * 2); qn[j] = *(const GAS unsigned short*)(ub + lq); gn[j] = *(const GAS unsigned short*)(ub + lg); } }
    for (int cc = 0; cc < SEQ / 32; ++cc) {
        LAS unsigned char* lds = lds0 + (cc & 1) * 32768;
        LAS float* EL = (LAS float*)(lds + HG_EL);
        const int t0 = dir ? (SEQ - 32 * (cc + 1)) : 32 * cc;
        const bf16x8 vfrag = vn;
        float qv[8], gv[8];
#pragma unroll
        for (int j = 0; j < 8; ++j) { qv[j] = bf2f(qn[j]); gv[j] = h2f(gn[j]); }
        if (cc > 0) { const int tp = dir ? (SEQ - 32 * cc) : 32 * (cc - 1); unsigned lo2 = lo_; asm volatile("" : "+v"(lo2));
#pragma unroll
            for (int itl = 0; itl < 2; ++itl)
#pragma unroll
                for (int e = 0; e < 4; e += 2) { const unsigned pk = pg8::cvt_pk_bf16(op[itl][e], op[itl][e + 1]); GAS unsigned char* ub = obase + (size_t)(tp + 16 * itl + e) * (HGW * 2); GAS unsigned char* ub2 = ub + HGW * 2; asm volatile("" : "+s"(ub2));
                    *(GAS unsigned short*)(ub + lo2) = (unsigned short)(pk & 0xffffu); *(GAS unsigned short*)(ub2 + lo2) = (unsigned short)(pk >> 16); } }
        asm volatile("" ::: "memory");
        if (cc + 1 < SEQ / 32) {
            unsigned lv_ = lv, lq_ = lq, lg_ = lg; asm volatile("" : "+v"(lv_), "+v"(lq_), "+v"(lg_));
            const int t1 = dir ? (SEQ - 32 * (cc + 2)) : 32 * (cc + 1); vn = *(const GAS bf16x8*)(vbase + (size_t)t1 * 2 + lv_);
#pragma unroll
            for (int j = 0; j < 8; ++j) { const GAS unsigned char* ub = pbase + (size_t)(t1 + j) * (PROJ_W * 2); qn[j] = *(const GAS unsigned short*)(ub + lq_); gn[j] = *(const GAS unsigned short*)(ub + lg_); } }
        float cs[8]; float tot = 0.f;
        if (dir == 0) {
#pragma unroll
            for (int j = 0; j < 8; ++j) { tot += gv[j]; cs[j] = tot; }
        } else {
#pragma unroll
            for (int j = 7; j >= 0; --j) { tot += gv[j]; cs[j] = tot; }
        }
        { const float t0q = __shfl(tot, i16), t1q = __shfl(tot, i16 + 16), t2q = __shfl(tot, i16 + 32), t3q = __shfl(tot, i16 + 48);
          float off;
          if (dir == 0) off = (qd > 0 ? t0q : 0.f) + (qd > 1 ? t1q : 0.f) + (qd > 2 ? t2q : 0.f);
          else          off = (qd < 3 ? t3q : 0.f) + (qd < 2 ? t2q : 0.f) + (qd < 1 ? t1q : 0.f);
          if (qd == 0) EL[k] = __builtin_amdgcn_exp2f((t0q + t1q) + (t2q + t3q));
          unsigned kt8[8];
#pragma unroll
          for (int j = 0; j < 8; ++j) { const float bb = cs[j] + off; const float kk = 1.0f - __builtin_amdgcn_exp2f(gv[j]);
              const float qb = qv[j] * __builtin_amdgcn_exp2f(bb), ktv = kk * __builtin_amdgcn_exp2f(fminf(-bb, 115.f));
              const unsigned pk = pg8::cvt_pk_bf16(qb, ktv);
              *(LAS unsigned short*)(lds + HG_QB + (8 * qd + j) * 272 + 2 * k) = (unsigned short)(pk & 0xffffu);
              *(LAS unsigned short*)(lds + HG_KT + (8 * qd + j) * 272 + 2 * k) = (unsigned short)(pk >> 16);
              kt8[j] = pk >> 16; }
          v4u w; w.x = kt8[0] | (kt8[1] << 16); w.y = kt8[2] | (kt8[3] << 16); w.z = kt8[4] | (kt8[5] << 16); w.w = kt8[6] | (kt8[7] << 16);
          *(LAS v4u*)(lds + HG_KTT + k * 80 + 16 * qd) = w; }
        __syncthreads();
        if (wave < 4) { const int ti = wave >> 1, ts = wave & 1; f32x4 a = (f32x4){0.f, 0.f, 0.f, 0.f};
#pragma unroll
            for (int ks = 0; ks < 4; ++ks) { const bf16x8 af = *(const LAS bf16x8*)(lds + HG_QB + (16 * ti + i16) * 272 + (32 * ks + 8 * g) * 2), bfr = *(const LAS bf16x8*)(lds + HG_KT + (16 * ts + i16) * 272 + (32 * ks + 8 * g) * 2);
                a = __builtin_amdgcn_mfma_f32_16x16x32_bf16(af, bfr, a, 0, 0, 0); }
            const int ss = 16 * ts + i16;
#pragma unroll
            for (int e = 0; e < 4; e += 2) { const int si = 16 * ti + 4 * g + e; const bool k0 = dir ? (ss >= si) : (ss <= si), k1 = dir ? (ss >= si + 1) : (ss <= si + 1);
                const unsigned pk = pg8::cvt_pk_bf16(k0 ? a[e] : 0.f, k1 ? a[e + 1] : 0.f);
                *(LAS unsigned short*)(lds + HG_SC + si * 80 + 2 * ss) = (unsigned short)(pk & 0xffffu); *(LAS unsigned short*)(lds + HG_SC + (si + 1) * 80 + 2 * ss) = (unsigned short)(pk >> 16); } }
        f32x4 o[2]; o[0] = (f32x4){0.f, 0.f, 0.f, 0.f}; o[1] = o[0];
#pragma unroll
        for (int s4 = 0; s4 < 4; ++s4) {
            v4u sw; sw.x = pg8::cvt_pk_bf16(S[2 * s4][0], S[2 * s4][1]); sw.y = pg8::cvt_pk_bf16(S[2 * s4][2], S[2 * s4][3]); sw.z = pg8::cvt_pk_bf16(S[2 * s4 + 1][0], S[2 * s4 + 1][1]); sw.w = pg8::cvt_pk_bf16(S[2 * s4 + 1][2], S[2 * s4 + 1][3]);
            const bf16x8 sb = __builtin_bit_cast(bf16x8, sw);
#pragma unroll
            for (int itl = 0; itl < 2; ++itl) { const LAS unsigned char* qr = lds + HG_QB + (16 * itl + i16) * 272 + (32 * s4 + 4 * g) * 2;
                const v2u lo = *(const LAS v2u*)qr, hi = *(const LAS v2u*)(qr + 32);
                v4u aw; aw.x = lo.x; aw.y = lo.y; aw.z = hi.x; aw.w = hi.y;
                o[itl] = __builtin_amdgcn_mfma_f32_16x16x32_bf16(__builtin_bit_cast(bf16x8, aw), sb, o[itl], 0, 0, 0); }
        }
        __syncthreads();
#pragma unroll
        for (int itl = 0; itl < 2; ++itl) { const bf16x8 af = *(const LAS bf16x8*)(lds + HG_SC + (16 * itl + i16) * 80 + 16 * g);
            o[itl] = __builtin_amdgcn_mfma_f32_16x16x32_bf16(af, vfrag, o[itl], 0, 0, 0); }
        op[0] = o[0]; op[1] = o[1];
#pragma unroll
        for (int kt = 0; kt < 8; ++kt) { const bf16x8 af = *(const LAS bf16x8*)(lds + HG_KTT + (16 * kt + i16) * 80 + 16 * g);
            S[kt] = __builtin_amdgcn_mfma_f32_16x16x32_bf16(af, vfrag, S[kt], 0, 0, 0);
            const f32x4 el = *(const LAS f32x4*)(EL + 16 * kt + 4 * g);
            S[kt] = S[kt] * el; }
    }
    { const int tp = dir ? 0 : (SEQ - 32);
#pragma unroll
      for (int itl = 0; itl < 2; ++itl)
#pragma unroll
          for (int e = 0; e < 4; e += 2) { const unsigned pk = pg8::cvt_pk_bf16(op[itl][e], op[itl][e + 1]); GAS unsigned char* ub = obase + (size_t)(tp + 16 * itl + e) * (HGW * 2);
              *(GAS unsigned short*)(ub + lo_) = (unsigned short)(pk & 0xffffu); *(GAS unsigned short*)(ub + HGW * 2 + lo_) = (unsigned short)(pk >> 16); } }
    __syncthreads();
}

constexpr float NA_THR = 8.0f;
__device__ __forceinline__ void na_pair_mfma(const LAS float* tbl, const bf16* proj, const bf16* vt, bf16* mix, int b, int h, int rp, int cb, int lane) {
    const int r0 = 2 * rp;
    const int cbase = (cb == 0) ? 0 : (cb == 1) ? 8 : (cb == 2) ? 24 : 32;
    const int kb = min(max(r0 - WIN_R / 2, 0), NROWS - WIN_R), rs1 = min(max(r0 + 1 - WIN_R / 2, 0), NROWS - WIN_R);
    const int i = lane & 15, g = lane >> 4;
    const int c = 16 * cb + i, cs = min(max(c - WIN_C / 2, 0), GRID_W - WIN_C);
    const size_t tok0 = (size_t)b * SEQ;
    const bf16* qp = proj + (tok0 + r0 * GRID_W + c) * PROJ_W + C_NQ + h * HD + 8 * g;
    bf16x8 qf[2][4];
#pragma unroll
    for (int q = 0; q < 2; ++q)
#pragma unroll
        for (int ks = 0; ks < 4; ++ks) qf[q][ks] = *(const GAS bf16x8*)(qp + (size_t)q * GRID_W * PROJ_W + 32 * ks);
    const int kco = 8 * (i >> 2) + (i & 3);
    const bf16* kp0 = proj + (tok0 + cbase + kco) * PROJ_W + C_NK + h * HD + 8 * g;
    const bf16* vp0 = vt + (size_t)(h * HD + i) * MROWS + tok0 + cbase + 8 * g;
    const LAS float* tb = tbl + h * (15 * 31);
    int dcol[8]; bool okc[8];
#pragma unroll
    for (int j = 0; j < 8; ++j) { const int kcol = cbase + 8 * g + j; okc[j] = (kcol >= cs) && (kcol < cs + WIN_C); dcol[j] = min(max(kcol - c + WIN_C - 1, 0), 30); }
    f32x4 acc[2][8]; float m[2], l[2];
#pragma unroll
    for (int q = 0; q < 2; ++q) { m[q] = -1.0e30f; l[q] = 0.f;
#pragma unroll
        for (int dt = 0; dt < 8; ++dt) acc[q][dt] = (f32x4){0.f, 0.f, 0.f, 0.f}; }
#pragma unroll 1
    for (int kr = 0; kr < 9; ++kr) {
        const int krow = kb + kr, lrow = min(krow, NROWS - 1);
        const bf16* kp = kp0 + (size_t)(lrow * GRID_W) * PROJ_W;
        bf16x8 kf[2][4];
#pragma unroll
        for (int t = 0; t < 2; ++t)
#pragma unroll
            for (int ks = 0; ks < 4; ++ks) kf[t][ks] = *(const GAS bf16x8*)(kp + (size_t)(4 * t) * PROJ_W + 32 * ks);
        bf16x8 vf[8];
#pragma unroll
        for (int dt = 0; dt < 8; ++dt) vf[dt] = *(const GAS bf16x8*)(vp0 + (size_t)(16 * dt) * MROWS + lrow * GRID_W);
#pragma unroll
        for (int q = 0; q < 2; ++q) {
            const int r = r0 + q, rsq = q ? rs1 : kb;
            const bool rowok = (krow >= rsq) && (krow < rsq + WIN_R);
            const int dr = min(max(krow - r + WIN_R - 1, 0), 14);
            f32x4 s0 = (f32x4){0.f, 0.f, 0.f, 0.f}, s1 = s0;
#pragma unroll
            for (int ks = 0; ks < 4; ++ks) { s0 = __builtin_amdgcn_mfma_f32_16x16x32_bf16(kf[0][ks], qf[q][ks], s0, 0, 0, 0); s1 = __builtin_amdgcn_mfma_f32_16x16x32_bf16(kf[1][ks], qf[q][ks], s1, 0, 0, 0); }
            float v[8]; float cmax = -3.0e38f;
#pragma unroll
            for (int j = 0; j < 8; ++j) { const float sv = (j < 4) ? s0[j & 3] : s1[j & 3]; v[j] = (rowok && okc[j]) ? sv + tb[dr * 31 + dcol[j]] : -3.0e38f; cmax = fmaxf(cmax, v[j]); }
            if (__any(cmax > m[q] + NA_THR)) {
                float mx = fmaxf(cmax, __shfl_xor(cmax, 16)); mx = fmaxf(mx, __shfl_xor(mx, 32));
                const float mn = fmaxf(m[q], mx); const float sc = __builtin_amdgcn_exp2f((m[q] - mn) * 1.4426950408889634f);
                l[q] *= sc;
#pragma unroll
                for (int dt = 0; dt < 8; ++dt) acc[q][dt] = acc[q][dt] * sc;
                m[q] = mn; }
            float p[8];
#pragma unroll
            for (int j = 0; j < 8; ++j) { p[j] = __builtin_amdgcn_exp2f((v[j] - m[q]) * 1.4426950408889634f); l[q] += p[j]; }
            v4u w; w.x = pg8::cvt_pk_bf16(p[0], p[1]); w.y = pg8::cvt_pk_bf16(p[2], p[3]); w.z = pg8::cvt_pk_bf16(p[4], p[5]); w.w = pg8::cvt_pk_bf16(p[6], p[7]);
            const bf16x8 pf = __builtin_bit_cast(bf16x8, w);
#pragma unroll
            for (int dt = 0; dt < 8; ++dt) acc[q][dt] = __builtin_amdgcn_mfma_f32_16x16x32_bf16(vf[dt], pf, acc[q][dt], 0, 0, 0);
        }
    }
#pragma unroll
    for (int q = 0; q < 2; ++q) { float lq = l[q]; lq += __shfl_xor(lq, 16); lq += __shfl_xor(lq, 32);
        const float inv = 1.0f / lq;
        bf16* op = mix + (tok0 + (r0 + q) * GRID_W + c) * DM + HGW + h * HD + 4 * g;
#pragma unroll
        for (int dt = 0; dt < 8; ++dt) { v2u w; w.x = pg8::cvt_pk_bf16(acc[q][dt][0] * inv, acc[q][dt][1] * inv); w.y = pg8::cvt_pk_bf16(acc[q][dt][2] * inv, acc[q][dt][3] * inv); *(GAS v2u*)(op + 16 * dt) = w; } }
}

__device__ __forceinline__ void hgrn_combine_row(const bf16* of, const bf16* ob, const bf16* gaterow, const float* hn, bf16* orow, int lane) {
    const GAS v2u* a = (const GAS v2u*)of + lane; const GAS v2u* bq = (const GAS v2u*)ob + lane; const GAS v2u* gr = (const GAS v2u*)gaterow + lane;
    const f32x4 hg = *((const GAS f32x4*)hn + (lane & 31));
    GAS v2u* o8 = (GAS v2u*)orow + lane;
    v2u ra[8], rb[8], rg[8];
#pragma unroll
    for (int j = 0; j < 8; ++j) { ra[j] = a[64 * j]; rb[j] = bq[64 * j]; rg[j] = gr[64 * j]; }
#pragma unroll
    for (int j = 0; j < 8; ++j) {
        f32x4 v = (f32x4){bflo(ra[j].x) + bflo(rb[j].x), bfhi(ra[j].x) + bfhi(rb[j].x), bflo(ra[j].y) + bflo(rb[j].y), bfhi(ra[j].y) + bfhi(rb[j].y)};
        float ss = (v.x * v.x + v.y * v.y) + (v.z * v.z + v.w * v.w);
#pragma unroll
        for (int o = 1; o < 32; o <<= 1) ss += __shfl_xor(ss, o);
        const float rs = 1.0f / sqrtf(ss * (1.0f / HD) + EPS);
        const v2u g = rg[j];
        v2u w; w.x = pk2(v.x * rs * hg.x * bflo(g.x), v.y * rs * hg.y * bfhi(g.x)); w.y = pk2(v.z * rs * hg.z * bflo(g.y), v.w * rs * hg.w * bfhi(g.y));
        o8[64 * j] = w;
    }
}

struct Args { const float* in[18]; float* out; unsigned char* ws; int ph_lo, ph_hi; };
__global__ void __launch_bounds__(NWAVES * 64, 2) fwd_kernel(Args args) {
    extern __shared__ __attribute__((aligned(16))) unsigned char lds_raw[];
    LAS unsigned char* lds = (LAS unsigned char*)lds_raw;
    volatile LAS unsigned* MISC = (volatile LAS unsigned*)(lds + MISC_OFF);
    const int G = gridDim.x, bx = blockIdx.x;
    const int vcu = (G % 8 == 0) ? (bx % 8) * (G / 8) + bx / 8 : bx;
    gu32* ctl = (gu32*)(args.ws + WS_CTL);
    for (int u = threadIdx.x; u < (LDS_BYTES - LDSCTL_OFF) / 4; u += NWAVES * 64) ((LAS unsigned*)(lds + LDSCTL_OFF))[u] = 0u;
    __syncthreads();
    XcdBarrier bar; bar.bar = (unsigned*)(args.ws + WS_CTL) + CW_BAR; bar.x = 0; bar.st = nullptr;
#if !MK_PER_PHASE
    bar = xcd_barrier_post((unsigned*)(args.ws + WS_CTL) + CW_BAR, MISC + 8);
#endif
    const int lo = args.ph_lo, hi = args.ph_hi;
#if DIAG_BAR
    unsigned diag_wait = 0; int diag_nb = 0;
#endif
#define IN(k) (lo <= (k) && (k) < hi)
#define BOTH(k) (IN(k) && IN((k) + 1))
#if MK_PER_PHASE
#define GRID_BAR() do { if (threadIdx.x == 0) __hip_atomic_store(ctl + CW_TMO, 0xBADBA0u, RLX_AGENT); } while (0)
#else
#if DIAG_BAR
#define GRID_BAR() do { const unsigned long long t_a = __builtin_amdgcn_s_memrealtime(); xcd_barrier(bar); const unsigned long long t_b = __builtin_amdgcn_s_memrealtime(); \
        if (DIAG_BAR < 100 || DIAG_BAR - 100 == diag_nb) diag_wait += (unsigned)(t_b - t_a); ++diag_nb; } while (0)
#else
#define GRID_BAR() xcd_barrier(bar)
#endif
#endif
#define WGU1 ((bf16*)(args.ws + WS_WGU1))
#define WGU2 ((bf16*)(args.ws + WS_WGU2))
#define WD1 ((bf16*)(args.ws + WS_WD1))
#define WD2 ((bf16*)(args.ws + WS_WD2))
#define WIN ((bf16*)(args.ws + WS_WIN))
#define WOUT ((bf16*)(args.ws + WS_WOUT))
#define R1 ((bf16*)(args.ws + WS_R1))
#define IT ((bf16*)(args.ws + WS_TT))
#define VT ((bf16*)(args.ws + WS_TT) + (size_t)HGW * MROWS)
#define R2 ((float*)(args.ws + WS_R2))
#define R3 ((bf16*)(args.ws + WS_R3))
#define LB ((float*)(args.ws + WS_LB))
#define RS ((float*)(args.ws + WS_LB + 64 * 1024))
#define PHASE_IDS() int tid = threadIdx.x; asm volatile("" : "+v"(tid)); const int lane = tid & 63, wave = __builtin_amdgcn_readfirstlane(tid >> 6); \
    const int gw = vcu * NWAVES + wave, NGW = G * NWAVES; (void)lane; (void)gw; (void)NGW
#define PHASE_GATEUP(k, W, AP, RSP, ATILED) if (IN(k)) { _Pragma("unroll") for (int rr_ = 0; rr_ < NREP(k); ++rr_) { \
        pg8::Gemm g{(AP), (W), MROWS, 2 * FF, DM}; pg8::StaticOrder S; S.init(MROWS, GU_MAIN_N, G, bx); S.wgm = WGM_GU; \
        pg8::EpiSwiGLU E{R1, FF, (RSP)}; \
        pg8::gemm_phase<pg8::EpiSwiGLU, pg8::StaticOrder, G_ALIGN, G_SP2, true, ATILED>(lds + RING_OFF, g, S, E); \
        pg8::gemm_half_units<pg8::EpiSwiGLU, true, ATILED>(lds + RING_OFF, g, GU_MAIN_N / 256, (2 * FF - GU_MAIN_N) / 256, E, bx, G); } \
        if (BOTH(k)) GRID_BAR(); }
#define PHASE_DOWN(k, W, RSP) if (IN(k)) { _Pragma("unroll") for (int rr_ = 0; rr_ < NREP(k); ++rr_) { \
        pg8::Gemm g{R1, (W), MROWS, DM, FF}; pg8::StaticOrder S; S.init(MROWS, DM, G, bx); S.wgm = WGM_DOWN; \
        pg8::EpiBf16Plain E{(bf16*)R2, DM, (RSP)}; \
        pg8::gemm_phase<pg8::EpiBf16Plain, pg8::StaticOrder, G_ALIGN, G_SP2, true, true>(lds + RING_OFF, g, S, E); } \
        if (BOTH(k)) GRID_BAR(); }
#define PHASE_NORM(k, BBF, OBF, BASE, HOUT, WGT, GPOST, HASU) if (IN(k)) { PHASE_IDS(); \
        _Pragma("unroll") for (int rr_ = 0; rr_ < NREP(k); ++rr_) for (int m = gw; m < MROWS; m += NGW) \
            norm_res_row<BBF, OBF>((const bf16*)R2 + (size_t)m * DM, (const void*)(BASE), (void*)(HOUT), (WGT), (GPOST), (HASU) ? RS + m : (float*)nullptr, lane); \
        if (BOTH(k)) GRID_BAR(); }
#define HB ((bf16*)(args.ws + WS_R2 + 128 * MiB))

    if (IN(0)) { PHASE_IDS();
        LAS float* scr = (LAS float*)(lds + RING_OFF + wave * 16384);
        constexpr int I_GU = (DM / 64) * (FF / 32), I_D = (FF / 64) * (DM / 32), I_IN = (DM / 64) * (16384 / 32), I_OUT = (DM / 64) * (DM / 32);
        constexpr int NITEMS = 6 * I_GU + I_IN + I_OUT;
        static_assert(I_GU == I_D, "items");
        for (int rr_ = 0; rr_ < NREP(0); ++rr_)
        for (int it = gw; it < NITEMS; it += NGW) {
            int r = it; const float* W; bf16* WT; int K = DM, N = FF, mode = 0; const float* gain = nullptr;
            if (r < I_GU) { W = args.in[2]; WT = WGU1; mode = 1; gain = args.in[1]; }
            else if ((r -= I_GU) < I_GU) { W = args.in[3]; WT = WGU1; mode = 2; gain = args.in[1]; }
            else if ((r -= I_GU) < I_D) { W = args.in[4]; WT = WD1; K = FF; N = DM; }
            else if ((r -= I_D) < I_IN) { W = args.in[7]; WT = WIN; N = 16384; mode = 3; gain = args.in[6]; }
            else if ((r -= I_IN) < I_OUT) { W = args.in[11]; WT = WOUT; N = DM; }
            else if ((r -= I_OUT) < I_GU) { W = args.in[14]; WT = WGU2; mode = 1; gain = args.in[13]; }
            else if ((r -= I_GU) < I_GU) { W = args.in[15]; WT = WGU2; mode = 2; gain = args.in[13]; }
            else { r -= I_GU; W = args.in[16]; WT = WD2; K = FF; N = DM; }
            transpose_item(W, K, N, WT, mode, scr, r, lane, gain, (mode == 3) ? PROJ_W : (1 << 30), mode == 1 ? 1.4426950408889634f : mode == 2 ? 0.6931471805599453f : 1.0f);
        }
        for (int mp = gw; mp < MROWS / 2; mp += NGW) rms_rowpair_to_bf16_tiled(args.in[0], R3, 2 * mp, lane);
        for (int i = bx * 512 + tid; i < 2 * HGW; i += G * 512) { const float l0 = args.in[8][i], l1 = args.in[8][2 * HGW + i]; LB[i] = 1.0f / (1.0f + expf(l1 - l0)); }
        if (BOTH(0)) GRID_BAR();
    }
    PHASE_GATEUP(1, WGU1, R3, (const float*)nullptr, true)
    PHASE_DOWN(2, WD1, (const float*)nullptr)
    PHASE_NORM(3, false, true, args.in[0] + (size_t)m * DM, HB + (size_t)m * DM, 0.5f, args.in[5], true)
    if (IN(3) && IN(4)) { for (int eb = 0; eb < EXTRA_BARS; ++eb) GRID_BAR(); }
    if (IN(4)) {
#pragma unroll
        for (int rr_ = 0; rr_ < NREP(4); ++rr_) {
        { pg8::Gemm g{HB, WIN, MROWS, PROJ_W, DM}; pg8::StaticOrder S; S.init(MROWS, PROJ_W, G, bx); S.wgm = WGM_IN;
          pg8::EpiProj E{R1, PROJ_W, LB, RS};
          pg8::gemm_phase<pg8::EpiProj, pg8::StaticOrder, G_ALIGN, G_SP2, true>(lds + RING_OFF, g, S, E); }
        { pg8::Gemm g{WIN + (size_t)PROJ_W * DM, HB, HGW + NAW, MROWS, DM}; pg8::StaticOrder S; S.init(HGW + NAW, MROWS, G, bx); S.wgm = WGM_TT;
          pg8::EpiBf16ColScale E{IT, MROWS, RS};
          pg8::gemm_phase<pg8::EpiBf16ColScale, pg8::StaticOrder, G_ALIGN, G_SP2>(lds + RING_OFF, g, S, E); }
        }
        if (BOTH(4)) GRID_BAR();
    }
    if (IN(5)) { PHASE_IDS();
        for (int rr_ = 0; rr_ < NREP(5); ++rr_)
        if (bx < 2 * BATCH * NHEAD) { const int dir = bx & 1, h = (bx >> 1) & 15, b = bx >> 5;
            hgrn_mfma_unit(lds + RING_OFF, R1, IT, (bf16*)R2 + (size_t)dir * MROWS * HGW, b, h, dir, tid); }
        { LAS float* tbl = (LAS float*)(lds + RING_OFF);
          for (int q = tid; q < NHEAD * 15 * 31; q += 512) tbl[q] = args.in[10][q];
          __syncthreads();
          const int xq = (int)(xb_xcc_id() & 7u);
          for (int rr_ = 0; rr_ < NREP(12); ++rr_)
          for (int qq = 0; qq < 8; ++qq) { const int q = (xq + qq) & 7;
            for (;;) {
              if (tid == 0) MISC[16] = __hip_atomic_fetch_add(ctl + CW_QUEUE + 64 * (8 * rr_ + q), 1u, RLX_AGENT);
              __syncthreads();
              const int li = (int)MISC[16];
              __syncthreads();
              if (li >= 128) break;
              const int rq = li & 15, bh = q * 8 + (li >> 4), h = bh & 15, b = bh >> 4;
              na_pair_mfma(tbl, R1, VT, R3, b, h, 2 * rq + (wave >> 2), wave & 3, lane);
            } }
        }
        if (BOTH(5)) GRID_BAR();
    }
    if (IN(6)) { PHASE_IDS();
        for (int rr_ = 0; rr_ < NREP(6); ++rr_)
        for (int m = gw; m < MROWS; m += NGW)
            hgrn_combine_row((const bf16*)R2 + (size_t)m * HGW, (const bf16*)R2 + (size_t)MROWS * HGW + (size_t)m * HGW, R1 + (size_t)m * PROJ_W + C_GATE, args.in[9], R3 + (size_t)m * DM, lane);
        if (BOTH(6)) GRID_BAR();
    }
    if (IN(7)) {
#pragma unroll
        for (int rr_ = 0; rr_ < NREP(7); ++rr_) {
        pg8::Gemm g{R3, WOUT, MROWS, DM, DM}; pg8::StaticOrder S; S.init(MROWS, DM, G, bx); S.nrep = P7_INNER_REP; S.wgm = WGM_OUT;
        pg8::EpiBf16Plain E{(bf16*)R2, DM, (const float*)nullptr};
        pg8::gemm_phase<pg8::EpiBf16Plain, pg8::StaticOrder, G_ALIGN, G_SP2, true>(lds + RING_OFF, g, S, E); }
        if (BOTH(7)) GRID_BAR();
    }
    if (IN(8)) { PHASE_IDS();
        LAS float* gl = (LAS float*)(lds + RING_OFF);
        for (int i = tid; i < DM / 4; i += 512) ((LAS f32x4*)gl)[i] = ((const GAS f32x4*)args.in[12])[i];
        __syncthreads();
        _Pragma("unroll") for (int rr_ = 0; rr_ < NREP(8); ++rr_) for (int mp = gw; mp < MROWS / 2; mp += NGW)
            norm_res_rowpair<false, true>((const bf16*)R2, HB, (void*)R3, 1.0f, gl, RS, (const float*)nullptr, 2 * mp, lane);
        if (BOTH(8)) GRID_BAR(); }
    PHASE_GATEUP(9, WGU2, R3, (const float*)nullptr, true)
    PHASE_DOWN(10, WD2, (const float*)nullptr)
    if (IN(11)) { PHASE_IDS();
        LAS float* gl = (LAS float*)(lds + RING_OFF);
        for (int i = tid; i < DM / 4; i += 512) ((LAS f32x4*)gl)[i] = ((const GAS f32x4*)args.in[17])[i];
        __syncthreads();
        for (int mp = gw; mp < MROWS / 2; mp += NGW)
            norm_res_rowpair<true, false>((const bf16*)R2, R3, (void*)args.out, 0.5f, gl, (float*)nullptr, RS, 2 * mp, lane); }
#if DIAG_BAR
    if (threadIdx.x == 0) { gu32* dw = ctl + 12288;
        __hip_atomic_fetch_add(dw, diag_wait, RLX_AGENT); __hip_atomic_fetch_max(dw + 64, diag_wait, RLX_AGENT);
        __threadfence();
        const unsigned prev = __hip_atomic_fetch_add(dw + 128, 1u, RLX_AGENT);
        if (prev == (unsigned)G - 1u) { __threadfence(); const unsigned sum = __hip_atomic_load(dw, RLX_AGENT), mx = __hip_atomic_load(dw + 64, RLX_AGENT);
            const float val = (DIAG_BAR == 2) ? (float)mx * 0.01f : (float)sum * 0.01f / (float)G;
            args.out[0] = 1000.0f + floorf(val * (1.0f / 40.0f)) * 40.0f; } }
#endif
#if !MK_PER_PHASE
    if (IN(11)) { if (xb_ld((unsigned*)(args.ws + WS_CTL) + CW_BAR + XB_TMO) != 0u) { const float q = __builtin_nanf(""); for (int m = bx; m < MROWS; m += G) for (int c = threadIdx.x; c < DM; c += 512) args.out[(size_t)m * DM + c] = q; } }
#endif
#undef IN
#undef BOTH
}

extern "C" void kernel_launch(void* const* d_in, const int* in_sizes, int n_in, void* d_out, int out_size, void* d_ws, size_t ws_size, hipStream_t stream) {
    static int grid = 0;
    if (grid == 0) {
        if (n_in != 18 || in_sizes[0] != MROWS * DM || out_size != MROWS * DM || ws_size < WS_END) {
            fprintf(stderr, "kernel_launch: unexpected shapes (n_in %d, in0 %d, out %d, ws %zu need %zu); nothing launched\n", n_in, n_in > 0 ? in_sizes[0] : -1, out_size, ws_size, (size_t)WS_END); grid = -1; return; }
        int dev = 0, cus = 0;
        if (hipGetDevice(&dev) != hipSuccess || hipDeviceGetAttribute(&cus, hipDeviceAttributeMultiprocessorCount, dev) != hipSuccess) { grid = -1; return; }
        if (hipFuncSetAttribute((const void*)fwd_kernel, hipFuncAttributeMaxDynamicSharedMemorySize, LDS_BYTES) != hipSuccess) { fprintf(stderr, "kernel_launch: hipFuncSetAttribute failed\n"); grid = -1; return; }
        int per_cu = 0;
        if (hipOccupancyMaxActiveBlocksPerMultiprocessor(&per_cu, (const void*)fwd_kernel, NWAVES * 64, LDS_BYTES) != hipSuccess || per_cu < 1)
            fprintf(stderr, "kernel_launch: note: occupancy query reports %d workgroups per CU\n", per_cu);
        (void)hipGetLastError();
        grid = cus;
    }
    if (grid < 0) return;
    if (hipMemsetAsync((char*)d_ws + WS_CTL, 0, CTL_ZERO_BYTES, stream) != hipSuccess) { fprintf(stderr, "kernel_launch: memset failed\n"); return; }
    Args a{};
    for (int i = 0; i < 18; ++i) a.in[i] = (const float*)d_in[i];
    a.out = (float*)d_out; a.ws = (unsigned char*)d_ws;
#if MK_PER_PHASE
    for (int p = 0; p < N_PHASES; ++p) { a.ph_lo = p; a.ph_hi = p + 1; hipLaunchKernelGGL(fwd_kernel, dim3(grid), dim3(NWAVES * 64), LDS_BYTES, stream, a); }
#else
    a.ph_lo = 0; a.ph_hi = N_PHASES;
    hipLaunchKernelGGL(fwd_kernel, dim3(grid), dim3(NWAVES * 64), LDS_BYTES, stream, a);
#endif
    const hipError_t le = hipPeekAtLastError();
    if (le != hipSuccess) fprintf(stderr, "kernel_launch: launch failed: %s\n", hipGetErrorName(le));
}
```

```cpp
#include <hip/hip_runtime.h>
#include <cstdio>
#include <cstdint>

#ifndef REPEAT_MASK
#define REPEAT_MASK 0
#endif
#define NREP(k) (1 + ((REPEAT_MASK >> (k)) & 1))
#ifndef G_SP2
#define G_SP2 true
#endif
#ifndef G_ALIGN
#define G_ALIGN true
#endif
#ifndef EPI_TWICE
#define EPI_TWICE 0
#endif
#ifndef DIAG_BAR
#define DIAG_BAR 0
#endif
#ifndef P7_INNER_REP
#define P7_INNER_REP 1
#endif
#ifndef WGM_GU
#define WGM_GU 8
#endif
#ifndef WGM_IN
#define WGM_IN 8
#endif
#ifndef WGM_OUT
#define WGM_OUT 4
#endif
#ifndef WGM_TT
#define WGM_TT 4
#endif
#ifndef WGM_DOWN
#define WGM_DOWN 4
#endif
#ifndef EXTRA_BARS
#define EXTRA_BARS 0
#endif
#ifndef MK_PER_PHASE
#define MK_PER_PHASE 0
#endif

namespace pg8 {
#define PG8_LAS __attribute__((address_space(3)))
typedef unsigned short bf16_t;
typedef short bf16x8 __attribute__((ext_vector_type(8)));
typedef float f32x4 __attribute__((ext_vector_type(4)));
typedef unsigned u32x4 __attribute__((ext_vector_type(4)));
constexpr int BM = 256, BK = 64, HALF = 128, HTB = HALF * BK * 2  , STAGE_BYTES = 8 * HTB, NXCD = 8, WGM = 8;

__host__ __device__ __forceinline__ int lds_byte(int r, int c) { const int st = (r >> 4) * 2 + (c >> 5), rr = r & 15, cc = c & 31, ob = rr * 64 + cc * 2; return st * 1024 + (ob ^ (((ob >> 9) & 1) << 5)); }
__host__ __device__ __forceinline__ void stage_rc(int b, int& R, int& C) { const int st = b / 1024, sb = b % 1024, swz = sb ^ (((sb >> 9) & 1) << 5); R = (st >> 1) * 16 + swz / 64; C = (st & 1) * 32 + (swz % 64) / 2; }
__host__ __device__ __forceinline__ int perm32(int rho) { const int n = rho >> 4, i = rho & 15; return 8 * (i >> 2) + 4 * n + (i & 3); }

struct Unit { int pm, pn; };
struct Gemm { const bf16_t* A; const bf16_t* Bt; int M, N, K; };

struct StaticOrder {
    int nM, nN, nwg, G, c, nrep = 1, wgm = WGM;
    __host__ __device__ void init(int M, int N, int G_, int c_) { nM = M / BM; nN = N / BM; nwg = nM * nN; G = G_; c = c_; }
    __host__ __device__ bool next(int i, Unit& u) const {
        long L = (long)i * G + c; if (L >= (long)nwg * nrep) return false; L %= nwg;
        int wgid = (int)L; { const int q = nwg / NXCD, r = nwg % NXCD, xcd = wgid % NXCD, off = wgid / NXCD; wgid = (xcd < r ? xcd * (q + 1) : r * (q + 1) + (xcd - r) * q) + off; }
        const int nig = wgm * nN, gid = wgid / nig, fm = gid * wgm, gsz = (nM - fm) < wgm ? (nM - fm) : wgm;
        u.pm = fm + ((wgid % nig) % gsz); u.pn = (wgid % nig) / gsz; return true;
    }
    __device__ __forceinline__ void a_ready(const Unit&) const {}
    __device__ __forceinline__ void done(const Unit&) const {}
};

typedef float f32x2_t __attribute__((ext_vector_type(2)));
typedef __bf16 bf16x2_t __attribute__((ext_vector_type(2)));
__device__ __forceinline__ unsigned cvt_pk_bf16(float lo, float hi) { const f32x2_t v = {lo, hi}; const bf16x2_t b = __builtin_convertvector(v, bf16x2_t); return __builtin_bit_cast(unsigned, b); }
__device__ __forceinline__ unsigned cvt_pk_f16(float lo, float hi) { typedef _Float16 h2 __attribute__((ext_vector_type(2))); h2 v; v.x = (_Float16)lo; v.y = (_Float16)hi; return __builtin_bit_cast(unsigned, v); }
__device__ __forceinline__ float sigmoidf_fast(float v) { return __builtin_amdgcn_rcpf(1.0f + __builtin_amdgcn_exp2f(-1.4426950408889634f * v)); }

struct EpiF32 {
    static constexpr bool PERM = false, AFTER_DRAIN = false;
    float* C; int ldc;
    __device__ __forceinline__ void operator()(const f32x4 (&acc)[2][2][4][2], const Unit& u, int wr, int wc, int fr, int fq) const {
        const int row0 = u.pm * BM + wr * 64 + fr, col0 = u.pn * BM + wc * 32 + 4 * fq;
#pragma unroll
        for (int ai = 0; ai < 2; ++ai)
#pragma unroll
            for (int m = 0; m < 4; ++m) { float* rowp = C + (size_t)(row0 + ai * HALF + m * 16) * ldc + col0;
#pragma unroll
                for (int bj = 0; bj < 2; ++bj)
#pragma unroll
                    for (int n = 0; n < 2; ++n) *(f32x4*)(rowp + bj * HALF + n * 16) = acc[ai][bj][m][n]; }
    }
};
struct EpiBf16Plain {
    static constexpr bool PERM = true, AFTER_DRAIN = false;
    bf16_t* O; int ldc; const float* rs;
    __device__ __forceinline__ void operator()(const f32x4 (&acc)[2][2][4][2], const Unit& u, int wr, int wc, int fr, int fq) const {
        const int row0 = u.pm * BM + wr * 64 + fr, col0 = u.pn * BM + wc * 32 + 8 * fq;
#pragma unroll
        for (int ai = 0; ai < 2; ++ai)
#pragma unroll
            for (int m = 0; m < 4; ++m) { bf16_t* rowp = O + (size_t)(row0 + ai * HALF + m * 16) * ldc + col0;
                const float r = rs ? rs[row0 + ai * HALF + m * 16] : 1.0f;
#pragma unroll
                for (int bj = 0; bj < 2; ++bj) { const f32x4 v0 = acc[ai][bj][m][0] * r, v1 = acc[ai][bj][m][1] * r;
                    u32x4 w; w.x = cvt_pk_bf16(v0[0], v0[1]); w.y = cvt_pk_bf16(v0[2], v0[3]); w.z = cvt_pk_bf16(v1[0], v1[1]); w.w = cvt_pk_bf16(v1[2], v1[3]);
                    *(u32x4*)(rowp + bj * HALF) = w; } }
    }
};
struct EpiBf16ColScale {
    static constexpr bool PERM = true, AFTER_DRAIN = false;
    bf16_t* O; int ldc; const float* cs;
    __device__ __forceinline__ void operator()(const f32x4 (&acc)[2][2][4][2], const Unit& u, int wr, int wc, int fr, int fq) const {
        const int row0 = u.pm * BM + wr * 64 + fr, col0 = u.pn * BM + wc * 32 + 8 * fq;
        f32x4 c0[2], c1[2];
#pragma unroll
        for (int bj = 0; bj < 2; ++bj) { c0[bj] = *(const f32x4*)(cs + col0 + bj * HALF); c1[bj] = *(const f32x4*)(cs + col0 + bj * HALF + 4); }
#pragma unroll
        for (int ai = 0; ai < 2; ++ai)
#pragma unroll
            for (int m = 0; m < 4; ++m) { bf16_t* rowp = O + (size_t)(row0 + ai * HALF + m * 16) * ldc + col0;
#pragma unroll
                for (int bj = 0; bj < 2; ++bj) { const f32x4 v0 = acc[ai][bj][m][0] * c0[bj], v1 = acc[ai][bj][m][1] * c1[bj];
                    u32x4 w; w.x = cvt_pk_bf16(v0[0], v0[1]); w.y = cvt_pk_bf16(v0[2], v0[3]); w.z = cvt_pk_bf16(v1[0], v1[1]); w.w = cvt_pk_bf16(v1[2], v1[3]);
                    *(u32x4*)(rowp + bj * HALF) = w; } }
    }
};
struct EpiSwiGLU {
    static constexpr bool PERM = true, AFTER_DRAIN = false;
    bf16_t* H; int ldc; const float* rs;
    __device__ __forceinline__ size_t tiled(int hp, int pn, int wr, int wc, int fr, int fq) const {
        return ((size_t)hp * (size_t)(ldc >> 6) + (size_t)(pn * 2 + (wc >> 1))) * 16384u + (size_t)lds_byte(wr * 64 + fr, (wc & 1) * 32 + 8 * fq); }
    __device__ __forceinline__ void operator()(const f32x4 (&acc)[2][2][4][2], const Unit& u, int wr, int wc, int fr, int fq) const {
        const int row0 = u.pm * BM + wr * 64 + fr;
#pragma unroll
        for (int ai = 0; ai < 2; ++ai)
#pragma unroll
            for (int m = 0; m < 4; ++m) { bf16_t* rowp = (bf16_t*)((unsigned char*)H + tiled(u.pm * 2 + ai, u.pn, wr, wc, fr, fq) + m * 2048);
                const float r = rs ? rs[row0 + ai * HALF + m * 16] : 1.0f;
                float h[8], gg[8], tt[8];
#pragma unroll
                for (int n = 0; n < 2; ++n)
#pragma unroll
                    for (int e = 0; e < 4; ++e) gg[4 * n + e] = acc[ai][0][m][n][e] * r;
#pragma unroll
                for (int q = 0; q < 8; ++q) tt[q] = __builtin_amdgcn_exp2f(-gg[q]);
#pragma unroll
                for (int n = 0; n < 2; ++n)
#pragma unroll
                    for (int e = 0; e < 4; ++e) h[4 * n + e] = gg[4 * n + e] * acc[ai][1][m][n][e];
#pragma unroll
                for (int q = 0; q < 8; ++q) tt[q] = 1.0f + tt[q];
#pragma unroll
                for (int q = 0; q < 8; ++q) tt[q] = __builtin_amdgcn_rcpf(tt[q]);
#pragma unroll
                for (int q = 0; q < 8; ++q) h[q] = h[q] * tt[q];
                u32x4 w; w.x = cvt_pk_bf16(h[0], h[1]); w.y = cvt_pk_bf16(h[2], h[3]); w.z = cvt_pk_bf16(h[4], h[5]); w.w = cvt_pk_bf16(h[6], h[7]);
                *(u32x4*)rowp = w; }
    }
    __device__ __forceinline__ void half(const f32x4 (&acc)[2][2][4][2], int pmh, int pn, int wr, int wc, int fr, int fq) const {
        const int row0 = pmh * HALF + wr * 64 + fr;
#pragma unroll
        for (int m = 0; m < 4; ++m) { bf16_t* rowp = (bf16_t*)((unsigned char*)H + tiled(pmh, pn, wr, wc, fr, fq) + m * 2048);
            const float r = rs ? rs[row0 + m * 16] : 1.0f;
            float h[8];
#pragma unroll
            for (int n = 0; n < 2; ++n)
#pragma unroll
                for (int e = 0; e < 4; ++e) { const float g = acc[0][0][m][n][e] * r, up = acc[0][1][m][n][e]; h[4 * n + e] = g * __builtin_amdgcn_rcpf(1.0f + __builtin_amdgcn_exp2f(-g)) * up; }
            u32x4 w; w.x = cvt_pk_bf16(h[0], h[1]); w.y = cvt_pk_bf16(h[2], h[3]); w.z = cvt_pk_bf16(h[4], h[5]); w.w = cvt_pk_bf16(h[6], h[7]);
            *(u32x4*)rowp = w; }
    }
};
struct EpiProj {
    static constexpr bool PERM = true, AFTER_DRAIN = false;
    bf16_t* P; int ldc; const float* lb; const float* rs;
    __device__ __forceinline__ void operator()(const f32x4 (&acc)[2][2][4][2], const Unit& u, int wr, int wc, int fr, int fq) const {
        const int sec = u.pn >> 3;
        const int row0 = u.pm * BM + wr * 64 + fr, col0 = u.pn * BM + wc * 32 + 8 * fq;
        const bool isg = (sec == 1 || sec == 2), act = (sec == 0 || sec == 3); const float sc = (sec == 4) ? 0.08838834764831845f : 1.0f;
        const float* lbp = lb + (isg ? (col0 - 2048) : 0);
#pragma unroll
        for (int ai = 0; ai < 2; ++ai)
#pragma unroll
            for (int m = 0; m < 4; ++m) { bf16_t* rowp = P + (size_t)(row0 + ai * HALF + m * 16) * ldc + col0;
                const float r = rs ? rs[row0 + ai * HALF + m * 16] : 1.0f;
#pragma unroll
                for (int bj = 0; bj < 2; ++bj) { float g[8]; u32x4 w;
                    if (isg) {
                        const f32x4 la = *(const f32x4*)(lbp + bj * HALF), lc = *(const f32x4*)(lbp + bj * HALF + 4);
#pragma unroll
                        for (int e = 0; e < 4; ++e) { const float f0 = la[e] + (1.0f - la[e]) * sigmoidf_fast(acc[ai][bj][m][0][e] * r), f1 = lc[e] + (1.0f - lc[e]) * sigmoidf_fast(acc[ai][bj][m][1][e] * r);
                            g[e] = __builtin_amdgcn_logf(f0); g[4 + e] = __builtin_amdgcn_logf(f1); }
                        w.x = cvt_pk_f16(g[0], g[1]); w.y = cvt_pk_f16(g[2], g[3]); w.z = cvt_pk_f16(g[4], g[5]); w.w = cvt_pk_f16(g[6], g[7]);
                    } else {
#pragma unroll
                        for (int n = 0; n < 2; ++n)
#pragma unroll
                            for (int e = 0; e < 4; ++e) { const float v = acc[ai][bj][m][n][e] * r; g[4 * n + e] = act ? v * sigmoidf_fast(v) : v * sc; }
                        w.x = cvt_pk_bf16(g[0], g[1]); w.y = cvt_pk_bf16(g[2], g[3]); w.z = cvt_pk_bf16(g[4], g[5]); w.w = cvt_pk_bf16(g[6], g[7]);
                    }
                    *(u32x4*)(rowp + bj * HALF) = w; }
                asm volatile("" ::: "memory"); }
    }
};

template <class Epi, class Sched, bool ALIGN_EPI = false, bool SP2 = false, bool B_TILED = false, bool A_TILED = false>
__device__ __forceinline__ void gemm_phase(PG8_LAS unsigned char* lds, const Gemm g, const Sched& S, const Epi& E) {
    static_assert(!B_TILED || Epi::PERM, "the pre-tiled B image carries the PERM row order");
    int tid_ = threadIdx.x; asm volatile("" : "+v"(tid_));
    const int tid = tid_, wid = __builtin_amdgcn_readfirstlane(tid >> 6), lane = tid & 63, wr = wid >> 2, wc = wid & 3, fr = lane & 15, fq = lane >> 4;
    const int K = g.K, nt = K / BK;
    unsigned voffA[2], voffB[2];
#pragma unroll
    for (int i = 0; i < 2; ++i) { int R, C; stage_rc(wid * 2048 + lane * 16 + i * 1024, R, C); const int Rb = Epi::PERM ? ((R & ~31) + perm32(R & 31)) : R;
        voffA[i] = A_TILED ? (unsigned)(wid * 2048 + lane * 16 + i * 1024) : (unsigned)(R * K + C) * 2u; voffB[i] = B_TILED ? (unsigned)(wid * 2048 + lane * 16 + i * 1024) : (unsigned)(Rb * K + C) * 2u; }
    const size_t kstep = A_TILED ? (size_t)HTB : (size_t)(BK * 2), kstepB = B_TILED ? (size_t)HTB : (size_t)(BK * 2);
    const size_t hstep = (size_t)HALF * K * 2;
    const size_t tstep = 2 * hstep;
    const unsigned ldsw = (unsigned)wid * 2048u;
    const int aoff = lds_byte(wr * 64 + fr, fq * 8), boff = lds_byte(wc * 32 + fr, fq * 8);
#define PG8_SA(b, h) (((b) * 2 + (h)) * HTB)
#define PG8_SB(b, h) ((4 + (b) * 2 + (h)) * HTB)
#define PG8_STAGE(bufoff, gbase, voff) do { const char* gb_ = (const char*)(gbase); asm volatile("" : "+s"(gb_)); _Pragma("unroll") for (int _i = 0; _i < 2; ++_i) { asm volatile("" : "+v"((voff)[_i])); \
        __builtin_amdgcn_global_load_lds((const unsigned*)(gb_ + (voff)[_i]), (PG8_LAS unsigned*)(lds + (bufoff) + ldsw + _i * 1024), 16, 0, 0); } } while (0)
#define PG8_LDA(dst, b, h) do { _Pragma("unroll") for (int m = 0; m < 4; ++m) _Pragma("unroll") for (int k = 0; k < 2; ++k) dst[m][k] = *(const PG8_LAS bf16x8*)(lds + PG8_SA(b, h) + aoff + m * 2048 + k * 1024); } while (0)
#define PG8_LDB(dst, b, h) do { _Pragma("unroll") for (int n = 0; n < 2; ++n) _Pragma("unroll") for (int k = 0; k < 2; ++k) dst[n][k] = *(const PG8_LAS bf16x8*)(lds + PG8_SB(b, h) + boff + n * 2048 + k * 1024); } while (0)
#define PG8_PRIO_IN(v) ((void)0)
#define PG8_PRIO_BLK(v) __builtin_amdgcn_s_setprio(v)
#define PG8_MMA(ai, bj, At, Bt) do { PG8_PRIO_IN(1); _Pragma("unroll") for (int k = 0; k < 2; ++k) _Pragma("unroll") for (int m = 0; m < 4; ++m) _Pragma("unroll") for (int nn = 0; nn < 2; ++nn) { const int n = (m & 1) ? 1 - nn : nn; \
        acc[ai][bj][m][n] = __builtin_amdgcn_mfma_f32_16x16x32_bf16(Bt[n][k], At[m][k], acc[ai][bj][m][n], 0, 0, 0); } PG8_PRIO_IN(0); } while (0)
#define PG8_MMA0(ai, bj, At, Bt) do { PG8_PRIO_IN(1); _Pragma("unroll") for (int k = 0; k < 2; ++k) _Pragma("unroll") for (int m = 0; m < 4; ++m) _Pragma("unroll") for (int nn = 0; nn < 2; ++nn) { const int n = (m & 1) ? 1 - nn : nn; \
        acc[ai][bj][m][n] = __builtin_amdgcn_mfma_f32_16x16x32_bf16(Bt[n][k], At[m][k], (k == 0) ? (f32x4){0.f, 0.f, 0.f, 0.f} : acc[ai][bj][m][n], 0, 0, 0); } PG8_PRIO_IN(0); } while (0)
#define PG8_WAIT_V(n) asm volatile("s_waitcnt vmcnt(" #n ")" ::: "memory")
#define PG8_WAIT_L(n) asm volatile("s_waitcnt lgkmcnt(" #n ")" ::: "memory")
#define PG8_BAR __builtin_amdgcn_s_barrier()
#define PG8_SCHED __builtin_amdgcn_sched_barrier(0)
    Unit cur, nxt; int ui = 0;
    if (!S.next(0, cur)) return;
    f32x4 acc[2][2][4][2];
    if constexpr (!SP2) {
#pragma unroll
    for (int a = 0; a < 2; ++a)
#pragma unroll
        for (int b = 0; b < 2; ++b)
#pragma unroll
            for (int m = 0; m < 4; ++m)
#pragma unroll
                for (int n = 0; n < 2; ++n) acc[a][b][m][n] = (f32x4){0.f, 0.f, 0.f, 0.f};
    }
    bf16x8 At[4][2], B0[2][2], B1[2][2];
    const char* cA = (const char*)g.A + (size_t)cur.pm * tstep; const char* cB = (const char*)g.Bt + (size_t)cur.pn * tstep;
    S.a_ready(cur);
    if constexpr (SP2) {
        PG8_STAGE(PG8_SB(0, 0), cB, voffB); PG8_STAGE(PG8_SB(0, 1), cB + hstep, voffB); PG8_STAGE(PG8_SA(0, 0), cA, voffA); PG8_STAGE(PG8_SA(0, 1), cA + hstep, voffA);
        if (wr == 1) PG8_BAR;
        PG8_WAIT_V(2); PG8_BAR;
        PG8_STAGE(PG8_SB(1, 0), cB + kstepB, voffB); PG8_STAGE(PG8_SA(1, 0), cA + kstep, voffA); PG8_STAGE(PG8_SB(1, 1), cB + hstep + kstepB, voffB);
        PG8_WAIT_V(6); PG8_BAR;
    } else {
        PG8_STAGE(PG8_SB(0, 0), cB, voffB); PG8_STAGE(PG8_SA(0, 0), cA, voffA); PG8_STAGE(PG8_SB(0, 1), cB + hstep, voffB); PG8_STAGE(PG8_SA(0, 1), cA + hstep, voffA);
        if (wr == 1) PG8_BAR;
        PG8_WAIT_V(4); PG8_BAR;
        PG8_STAGE(PG8_SB(1, 0), cB + kstepB, voffB); PG8_STAGE(PG8_SA(1, 0), cA + kstep, voffA); PG8_STAGE(PG8_SB(1, 1), cB + hstep + kstepB, voffB);
        PG8_WAIT_V(6); PG8_BAR;
    }
    for (;;) {
        const bool has_next = S.next(ui + 1, nxt);
        const char* nA = has_next ? (const char*)g.A + (size_t)nxt.pm * tstep : cA; const char* nB = has_next ? (const char*)g.Bt + (size_t)nxt.pn * tstep : cB;
#define PG8_PTRS() const bool last = (t == nt - 2); \
            const char* a1 = cA + (size_t)(t + 1) * kstep; \
            const char* a2 = last ? nA : cA + (size_t)(t + 2) * kstep; const char* b2 = last ? nB : cB + (size_t)(t + 2) * kstepB; \
            const char* a3 = a2 + kstep; const char* b3 = b2 + kstepB; \
            if (last && has_next) S.a_ready(nxt)
#define PG8_SP2_PAIR(MF) do { PG8_PTRS(); \
            PG8_LDB(B0, 0, 0); PG8_LDB(B1, 0, 1); PG8_SCHED; PG8_LDA(At, 0, 0); PG8_STAGE(PG8_SA(1, 1), a1 + hstep, voffA); \
            PG8_WAIT_V(8); PG8_WAIT_L(0); PG8_BAR; PG8_PRIO_BLK(1); MF(0, 0, At, B0); MF(0, 1, At, B1); PG8_PRIO_BLK(0); PG8_BAR; PG8_SCHED; \
            PG8_LDA(At, 0, 1); PG8_STAGE(PG8_SB(0, 0), b2, voffB); PG8_STAGE(PG8_SB(0, 1), b2 + hstep, voffB); PG8_STAGE(PG8_SA(0, 0), a2, voffA); \
            PG8_WAIT_V(8); PG8_WAIT_L(0); PG8_BAR; PG8_PRIO_BLK(1); MF(1, 0, At, B0); MF(1, 1, At, B1); PG8_PRIO_BLK(0); PG8_BAR; PG8_SCHED; \
            PG8_LDB(B0, 1, 0); PG8_LDB(B1, 1, 1); PG8_SCHED; PG8_LDA(At, 1, 0); PG8_STAGE(PG8_SA(0, 1), a2 + hstep, voffA); \
            PG8_WAIT_V(8); PG8_WAIT_L(0); PG8_BAR; PG8_PRIO_BLK(1); PG8_MMA(0, 0, At, B0); PG8_MMA(0, 1, At, B1); PG8_PRIO_BLK(0); PG8_BAR; PG8_SCHED; \
            PG8_LDA(At, 1, 1); PG8_STAGE(PG8_SB(1, 0), b3, voffB); PG8_STAGE(PG8_SB(1, 1), b3 + hstep, voffB); PG8_STAGE(PG8_SA(1, 0), a3, voffA); \
            PG8_WAIT_V(8); PG8_WAIT_L(0); PG8_BAR; PG8_PRIO_BLK(1); PG8_MMA(1, 0, At, B0); PG8_MMA(1, 1, At, B1); PG8_PRIO_BLK(0); PG8_BAR; PG8_SCHED; } while (0)
        if constexpr (SP2) {
            { const int t = 0; PG8_SP2_PAIR(PG8_MMA0); }
            for (int t = 2; t < nt; t += 2) PG8_SP2_PAIR(PG8_MMA);
        } else {
        for (int t = 0; t < nt; t += 2) {
            PG8_PTRS();
            {
            PG8_LDB(B0, 0, 0); PG8_SCHED; PG8_LDA(At, 0, 0); PG8_STAGE(PG8_SA(1, 1), a1 + hstep, voffA);
            PG8_WAIT_L(8); PG8_BAR; PG8_WAIT_L(0); PG8_MMA(0, 0, At, B0); PG8_BAR; PG8_SCHED;
            PG8_LDB(B1, 0, 1); PG8_STAGE(PG8_SB(0, 0), b2, voffB);
            PG8_BAR; PG8_WAIT_L(0); PG8_MMA(0, 1, At, B1); PG8_BAR;
            PG8_LDA(At, 0, 1); PG8_STAGE(PG8_SA(0, 0), a2, voffA);
            PG8_BAR; PG8_WAIT_L(0); PG8_MMA(1, 0, At, B0); PG8_BAR; PG8_SCHED;
            PG8_STAGE(PG8_SB(0, 1), b2 + hstep, voffB);
            PG8_WAIT_V(6); PG8_BAR; PG8_MMA(1, 1, At, B1); PG8_BAR;
            PG8_LDB(B0, 1, 0); PG8_SCHED; PG8_LDA(At, 1, 0); PG8_STAGE(PG8_SA(0, 1), a2 + hstep, voffA);
            PG8_WAIT_L(8); PG8_BAR; PG8_WAIT_L(0); PG8_MMA(0, 0, At, B0); PG8_BAR; PG8_SCHED;
            PG8_LDB(B1, 1, 1); PG8_STAGE(PG8_SB(1, 0), b3, voffB);
            PG8_BAR; PG8_WAIT_L(0); PG8_MMA(0, 1, At, B1); PG8_BAR;
            PG8_LDA(At, 1, 1); PG8_STAGE(PG8_SA(1, 0), a3, voffA);
            PG8_BAR; PG8_WAIT_L(0); PG8_MMA(1, 0, At, B0); PG8_BAR; PG8_SCHED;
            PG8_STAGE(PG8_SB(1, 1), b3 + hstep, voffB);
            PG8_WAIT_V(6); PG8_BAR; PG8_MMA(1, 1, At, B1); PG8_BAR;
            }
        }
        }
        if constexpr (ALIGN_EPI) { if (wr == 0) PG8_BAR; }
        if constexpr (!Epi::AFTER_DRAIN) { E(acc, cur, wr, wc, fr, fq); if (EPI_TWICE) { asm volatile("" ::: "memory"); E(acc, cur, wr, wc, fr, fq); } S.done(cur); }
        if (!has_next) break;
        if constexpr (!SP2) {
#pragma unroll
        for (int a = 0; a < 2; ++a)
#pragma unroll
            for (int b = 0; b < 2; ++b)
#pragma unroll
                for (int m = 0; m < 4; ++m)
#pragma unroll
                    for (int n = 0; n < 2; ++n) acc[a][b][m][n] = (f32x4){0.f, 0.f, 0.f, 0.f};
        }
        cur = nxt; cA = nA; cB = nB; ++ui;
        if constexpr (ALIGN_EPI) { if (wr == 1) PG8_BAR; }
    }
    PG8_WAIT_V(0);
    if constexpr (!ALIGN_EPI) { if (wr == 0) PG8_BAR; }
    PG8_BAR;
}

template <class Epi, bool B_TILED = false, bool A_TILED = false>
__device__ __forceinline__ void gemm_half_units(PG8_LAS unsigned char* lds, const Gemm g, int pn0, int npn, const Epi& E, int bx, int nwg) {
    int tid_ = threadIdx.x; asm volatile("" : "+v"(tid_));
    const int tid = tid_, wid = __builtin_amdgcn_readfirstlane(tid >> 6), lane = tid & 63, wr = wid >> 2, wc = wid & 3, fr = lane & 15, fq = lane >> 4;
    const int K = g.K, nt = K / BK;
    unsigned voffA[2], voffB[2];
#pragma unroll
    for (int i = 0; i < 2; ++i) { int R, C; stage_rc(wid * 2048 + lane * 16 + i * 1024, R, C); const int Rb = Epi::PERM ? ((R & ~31) + perm32(R & 31)) : R;
        voffA[i] = A_TILED ? (unsigned)(wid * 2048 + lane * 16 + i * 1024) : (unsigned)(R * K + C) * 2u; voffB[i] = B_TILED ? (unsigned)(wid * 2048 + lane * 16 + i * 1024) : (unsigned)(Rb * K + C) * 2u; }
    const size_t kstep = A_TILED ? (size_t)HTB : (size_t)(BK * 2), kstepB = B_TILED ? (size_t)HTB : (size_t)(BK * 2);
    const size_t hstep = (size_t)HALF * K * 2;
    const size_t tstep = 2 * hstep;
    const unsigned ldsw = (unsigned)wid * 2048u;
    const int aoff = lds_byte(wr * 64 + fr, fq * 8), boff = lds_byte(wc * 32 + fr, fq * 8);
    const int nunits = (g.M / HALF) * npn;
    for (int v = bx; v < nunits; v += nwg) {
        const int xcd = v & 7, j = v >> 3, pn = pn0 + j % npn, pmh = (j / npn) * NXCD + xcd;
        f32x4 acc[2][2][4][2];
#pragma unroll
        for (int b = 0; b < 2; ++b)
#pragma unroll
            for (int m = 0; m < 4; ++m)
#pragma unroll
                for (int n = 0; n < 2; ++n) acc[0][b][m][n] = (f32x4){0.f, 0.f, 0.f, 0.f};
        bf16x8 At[4][2], B0[2][2], B1[2][2];
        const char* cA = (const char*)g.A + (size_t)pmh * hstep; const char* cB = (const char*)g.Bt + (size_t)pn * tstep;
        PG8_STAGE(PG8_SB(0, 0), cB, voffB); PG8_STAGE(PG8_SB(0, 1), cB + hstep, voffB); PG8_STAGE(PG8_SA(0, 0), cA, voffA);
        PG8_STAGE(PG8_SB(1, 0), cB + kstepB, voffB); PG8_STAGE(PG8_SB(1, 1), cB + hstep + kstepB, voffB); PG8_STAGE(PG8_SA(1, 0), cA + kstep, voffA);
        PG8_WAIT_V(6); PG8_BAR;
        for (int t = 0; t < nt; t += 2) {
            const int t2 = (t + 2 < nt) ? t + 2 : t;
            const size_t o2 = (size_t)t2 * kstep, o3 = o2 + kstep, p2 = (size_t)t2 * kstepB, p3 = p2 + kstepB;
            PG8_LDB(B0, 0, 0); PG8_LDB(B1, 0, 1); PG8_LDA(At, 0, 0); PG8_WAIT_L(0); PG8_BAR;
            PG8_STAGE(PG8_SB(0, 0), cB + p2, voffB); PG8_STAGE(PG8_SB(0, 1), cB + hstep + p2, voffB); PG8_STAGE(PG8_SA(0, 0), cA + o2, voffA);
            PG8_PRIO_BLK(1); PG8_MMA(0, 0, At, B0); PG8_MMA(0, 1, At, B1); PG8_PRIO_BLK(0);
            PG8_WAIT_V(6); PG8_BAR; PG8_SCHED;
            PG8_LDB(B0, 1, 0); PG8_LDB(B1, 1, 1); PG8_LDA(At, 1, 0); PG8_WAIT_L(0); PG8_BAR;
            PG8_STAGE(PG8_SB(1, 0), cB + p3, voffB); PG8_STAGE(PG8_SB(1, 1), cB + hstep + p3, voffB); PG8_STAGE(PG8_SA(1, 0), cA + o3, voffA);
            PG8_PRIO_BLK(1); PG8_MMA(0, 0, At, B0); PG8_MMA(0, 1, At, B1); PG8_PRIO_BLK(0);
            PG8_WAIT_V(6); PG8_BAR; PG8_SCHED;
        }
        PG8_WAIT_V(0); PG8_BAR;
        E.half(acc, pmh, pn, wr, wc, fr, fq);
    }
    PG8_WAIT_V(0); PG8_BAR;
#undef PG8_SA
#undef PG8_SB
#undef PG8_STAGE
#undef PG8_LDA
#undef PG8_LDB
#undef PG8_MMA
#undef PG8_PRIO_IN
#undef PG8_PRIO_BLK
#undef PG8_MMA0
#undef PG8_PTRS
#undef PG8_SP2_PAIR
#undef PG8_WAIT_V
#undef PG8_WAIT_L
#undef PG8_BAR
#undef PG8_SCHED
}
}

constexpr int NWAVES = 8;
constexpr int DM = 4096, BATCH = 4, SEQ = 4096, MROWS = BATCH * SEQ;
constexpr int FF = 11008, HGW = 2048, NAW = 2048, HD = 128, NHEAD = 16;
constexpr int PROJ_W = 12288;
constexpr int C_Q = 0, C_GF = 2048, C_GB = 4096, C_GATE = 6144, C_NQ = 8192, C_NK = 10240;
constexpr int GRID_W = 64, NROWS = 64, WIN_R = 8, WIN_C = 16;
constexpr float EPS = 1e-6f;
constexpr int N_PHASES = 12;
constexpr int GU_MAIN_N = 84 * 256;
static_assert(GU_MAIN_N % 256 == 0 && (2 * FF - GU_MAIN_N) % 256 == 0 && GU_MAIN_N <= 2 * FF, "gate/up split");

constexpr size_t MiB = 1u << 20;
constexpr size_t WS_CTL = 0, CTL_ZERO_BYTES = 64 * 1024;
constexpr size_t WS_LB = 1 * MiB;
constexpr size_t WS_WGU1 = 2 * MiB, WS_WD1 = 174 * MiB, WS_WIN = 260 * MiB, WS_WOUT = 388 * MiB, WS_WGU2 = 420 * MiB, WS_WD2 = 592 * MiB;
constexpr size_t WS_R1 = 678 * MiB;
constexpr size_t WS_TT = WS_R1 + 384 * MiB;
constexpr size_t WS_R2 = 1190 * MiB;
constexpr size_t WS_R3 = 1446 * MiB;
constexpr size_t WS_END = 1574 * MiB;
static_assert((size_t)2 * FF * DM * 2 <= 172 * MiB && (size_t)FF * DM * 2 <= 86 * MiB, "weights");
static_assert((size_t)MROWS * PROJ_W * 2 == 384 * MiB && (size_t)MROWS * FF * 2 <= 512 * MiB, "R1");
constexpr int CW_TMO = 0, CW_CODE = 1;
constexpr int CW_BAR = 4096;
constexpr int CW_QUEUE = 8192;

constexpr int RING_OFF = 0, RING_BYTES = 131072;
constexpr int LDSCTL_OFF = RING_BYTES, MISC_OFF = LDSCTL_OFF + 320;
constexpr int LDS_BYTES = 147456;

#define GAS __attribute__((address_space(1)))
#define LAS __attribute__((address_space(3)))
typedef unsigned short bf16;
typedef unsigned v4u __attribute__((ext_vector_type(4)));
typedef unsigned v2u __attribute__((ext_vector_type(2)));
typedef float f32x4 __attribute__((ext_vector_type(4)));
typedef GAS unsigned gu32;
#define RLX_AGENT __ATOMIC_RELAXED, __HIP_MEMORY_SCOPE_AGENT
#define LDS_WAIT() asm volatile("s_waitcnt lgkmcnt(0)" ::: "memory")
#define VM_WAIT() asm volatile("s_waitcnt vmcnt(0)" ::: "memory")
__device__ __forceinline__ unsigned f2bf(float f) { unsigned u = __builtin_bit_cast(unsigned, f); return (u + 0x7fffu + ((u >> 16) & 1u)) >> 16; }
__device__ __forceinline__ unsigned pk2(float lo, float hi) { return f2bf(lo) | (f2bf(hi) << 16); }
__device__ __forceinline__ float bf2f(unsigned short b) { return __builtin_bit_cast(float, (unsigned)b << 16); }
__device__ __forceinline__ float bflo(unsigned w) { return __builtin_bit_cast(float, w << 16); }
__device__ __forceinline__ float bfhi(unsigned w) { return __builtin_bit_cast(float, w & 0xffff0000u); }
__device__ __forceinline__ float h2f(unsigned short b) { return (float)__builtin_bit_cast(_Float16, b); }

#define XB_TMO      128
#define XB_XCNT(j)  (256  + 64 * (j))
#define XB_XSUB(j)  (1280 + 64 * (j))
#define XB_XGEN(j)  (2304 + 64 * (j))
#define XB_TOP      3328
#define XB_TOPGEN   3392
#define XCD_BAR_WORDS 3456
#define XB_SPIN_CAP (1u << 18)
__device__ __forceinline__ unsigned xb_ld(unsigned* p)              { return __hip_atomic_load(p, __ATOMIC_RELAXED, __HIP_MEMORY_SCOPE_AGENT); }
__device__ __forceinline__ unsigned xb_add(unsigned* p, unsigned v) { return __hip_atomic_fetch_add(p, v, __ATOMIC_RELAXED, __HIP_MEMORY_SCOPE_AGENT); }
__device__ __forceinline__ unsigned xb_xcc_id() { return (unsigned)__builtin_amdgcn_s_getreg((3 << 11) | 20) & 0xFu; }
#define XB_SPIN(cond, bar) do { unsigned _sp = 0; while (cond) { __builtin_amdgcn_s_sleep(1); \
    if ((++_sp & 255u) == 0u) { if (xb_ld(&(bar)[XB_TMO])) break; if (_sp > XB_SPIN_CAP) { atomicAdd(&(bar)[XB_TMO], 1u); break; } } } } while (0)
struct XcdBarrier { unsigned* bar; unsigned x; volatile LAS unsigned* st; };
__device__ __forceinline__ XcdBarrier xcd_barrier_post(unsigned* bar, volatile LAS unsigned* st) {
    XcdBarrier b; b.bar = bar; b.x = xb_xcc_id(); b.st = st;
    if (threadIdx.x == 0) (void)xb_add(&bar[XB_XCNT(b.x)], 1u);
    return b;
}
__device__ __forceinline__ void xcd_barrier_complete(unsigned* bar, unsigned x, unsigned& nloc, unsigned& nx) {
    const unsigned G = gridDim.x * gridDim.y * gridDim.z;
    unsigned sum, cnt, mine, sp = 0u;
    for (;;) {
        sum = 0u; cnt = 0u; mine = 0u;
#pragma unroll
        for (unsigned j = 0; j < 16; ++j) { const unsigned c = xb_ld(&bar[XB_XCNT(j)]); sum += c; cnt += (c > 0u) ? 1u : 0u; mine = (j == x) ? c : mine; }
        if (sum == G) break;
        __builtin_amdgcn_s_sleep(1);
        if ((++sp & 255u) == 0u) { if (xb_ld(&bar[XB_TMO])) break; if (sp > XB_SPIN_CAP) { atomicAdd(&bar[XB_TMO], 1u); break; } }
    }
    nloc = mine > 0u ? mine : 1u; nx = cnt > 0u ? cnt : 1u;
}
__device__ __forceinline__ void xcd_barrier(const XcdBarrier& b) {
    asm volatile("s_waitcnt vmcnt(0)" ::: "memory");
    __syncthreads();
    if (threadIdx.x == 0) {
        unsigned* bar = b.bar;
        __builtin_amdgcn_s_waitcnt(0);
        unsigned nloc = b.st[0], nx = b.st[1];
        if (nloc == 0u) { xcd_barrier_complete(bar, b.x, nloc, nx); b.st[0] = nloc; b.st[1] = nx; }
        const unsigned old = xb_add(&bar[XB_XSUB(b.x)], 1u);
        const unsigned gen = old / nloc;
        if (old + 1u == (gen + 1u) * nloc) {
            __builtin_amdgcn_fence(__ATOMIC_RELEASE, "agent");
            asm volatile("s_waitcnt vmcnt(0)" ::: "memory");
            const unsigned og = xb_add(&bar[XB_TOP], 1u);
            const unsigned tg = og / nx;
            if (og + 1u == (tg + 1u) * nx) xb_add(&bar[XB_TOPGEN], 1u);
            else XB_SPIN(xb_ld(&bar[XB_TOPGEN]) == tg, bar);
            __builtin_amdgcn_fence(__ATOMIC_ACQUIRE, "agent");
            xb_add(&bar[XB_XGEN(b.x)], 1u);
            asm volatile("s_waitcnt vmcnt(0)" ::: "memory");
        } else {
            XB_SPIN(xb_ld(&bar[XB_XGEN(b.x)]) == gen, bar);
            __builtin_amdgcn_fence(__ATOMIC_ACQUIRE, "agent");
            asm volatile("s_waitcnt vmcnt(0)" ::: "memory");
        }
    }
    __syncthreads();
}

__device__ __forceinline__ float wave_sum(float v) {
#pragma unroll
    for (int o = 1; o < 64; o <<= 1) v += __shfl_xor(v, o);
    return v;
}
__device__ __forceinline__ float wave_max(float v) {
#pragma unroll
    for (int o = 1; o < 64; o <<= 1) v = fmaxf(v, __shfl_xor(v, o));
    return v;
}
__device__ __forceinline__ void transpose_item(const float* W, int K, int N, bf16* WT, int mode, LAS float* scr, int item, int lane, const float* gain, int tiled_rows, float wscale) {
    const int nblk = N / 32, kb = item / nblk, nb = item % nblk, k0 = 64 * kb, n0 = 32 * nb;
    const int rbase = (mode == 0) ? n0 : (mode == 3) ? (((0x75436210u >> (4 * (n0 >> 11))) & 7u) * 2048 + (n0 & 2047)) : (256 * (n0 >> 7) + (n0 & 127) + (mode == 2 ? 128 : 0));
#pragma unroll 8
    for (int i = 0; i < 32; ++i) { const int kk = 2 * i + (lane >> 5); scr[kk * 33 + (lane & 31)] = W[(size_t)(k0 + kk) * N + n0 + (lane & 31)]; }
    LDS_WAIT(); asm volatile("" ::: "memory");
    const int c = lane & 7;
    f32x4 ga = (f32x4){1.f, 1.f, 1.f, 1.f}, gb = ga;
    if (gain) { ga = *(const GAS f32x4*)(gain + k0 + 8 * c); gb = *(const GAS f32x4*)(gain + k0 + 8 * c + 4); }
    ga = ga * wscale; gb = gb * wscale;
#pragma unroll
    for (int j = 0; j < 4; ++j) { const int n = (lane >> 3) + 8 * j; const LAS float* s = scr + (8 * c) * 33 + n;
        v4u o; o.x = pk2(s[0 * 33] * ga.x, s[1 * 33] * ga.y); o.y = pk2(s[2 * 33] * ga.z, s[3 * 33] * ga.w); o.z = pk2(s[4 * 33] * gb.x, s[5 * 33] * gb.y); o.w = pk2(s[6 * 33] * gb.z, s[7 * 33] * gb.w);
        const int r = rbase + n;
        size_t ob;
        if (r < tiled_rows) { const int rr = r & 127, x = rr & 31, R = (rr & ~31) + 16 * ((x >> 2) & 1) + 4 * (x >> 3) + (x & 3);
            ob = ((size_t)(r >> 7) * (size_t)(K >> 6) + (size_t)(k0 >> 6)) * 16384u + (size_t)pg8::lds_byte(R, 8 * c); }
        else ob = ((size_t)r * K + k0 + 8 * c) * 2;
        *(GAS v4u*)((GAS unsigned char*)WT + ob) = o; }
    LDS_WAIT(); asm volatile("" ::: "memory");
}
__device__ __forceinline__ size_t tiled_off(int m, int k, int ktiles) { return ((size_t)(m >> 7) * (size_t)ktiles + (size_t)(k >> 6)) * 16384u + (size_t)pg8::lds_byte(m & 127, k & 63); }
__device__ __forceinline__ void rms_rowpair_to_bf16_tiled(const float* x, bf16* obase, int m0, int lane) {
    const int li = lane & 31, m = m0 + (lane >> 5);
    const GAS f32x4* xr = (const GAS f32x4*)(x + (size_t)m * DM) + li;
    f32x4 v[32]; float ss = 0.f;
#pragma unroll
    for (int j = 0; j < 32; ++j) v[j] = xr[32 * j];
#pragma unroll
    for (int j = 0; j < 32; ++j) ss += (v[j].x * v[j].x + v[j].y * v[j].y) + (v[j].z * v[j].z + v[j].w * v[j].w);
#pragma unroll
    for (int o = 1; o < 32; o <<= 1) ss += __shfl_xor(ss, o);
    const float rs = 1.0f / sqrtf(ss * (1.0f / DM) + EPS);
    GAS unsigned char* o8 = (GAS unsigned char*)obase + tiled_off(m, 4 * li, DM / 64);
#pragma unroll
    for (int j = 0; j < 32; ++j) { const f32x4 a = v[j]; v2u w; w.x = pk2(a.x * rs, a.y * rs); w.y = pk2(a.z * rs, a.w * rs); *(GAS v2u*)(o8 + (size_t)j * 32768u) = w; }
}
__device__ __forceinline__ void rms_row_to_bf16(const float* xrow, const float* gain, bf16* orow, int lane) {
    const GAS f32x4* xr = (const GAS f32x4*)xrow + lane; const GAS f32x4* gr = (const GAS f32x4*)gain + lane;
    f32x4 v[16], gg[16]; float ss = 0.f;
#pragma unroll
    for (int j = 0; j < 16; ++j) { v[j] = xr[64 * j]; gg[j] = gr[64 * j]; }
#pragma unroll
    for (int j = 0; j < 16; ++j) ss += (v[j].x * v[j].x + v[j].y * v[j].y) + (v[j].z * v[j].z + v[j].w * v[j].w);
    const float rs = 1.0f / sqrtf(wave_sum(ss) * (1.0f / DM) + EPS);
    GAS v2u* o8 = (GAS v2u*)orow + lane;
#pragma unroll
    for (int j = 0; j < 16; ++j) { const f32x4 g = gg[j]; v2u w; w.x = pk2(v[j].x * rs * g.x, v[j].y * rs * g.y); w.y = pk2(v[j].z * rs * g.z, v[j].w * rs * g.w); o8[64 * j] = w; }
}
template <bool BASE_TILED, bool OUT_TILED>
__device__ __forceinline__ void norm_res_rowpair(const bf16* ffbuf, const bf16* basebuf, void* outbuf, float w, const LAS float* gl, float* rsout, const float* bscale, int m0, int lane) {
    const int li = lane & 31, m = m0 + (lane >> 5);
    const unsigned toff = (unsigned)tiled_off(m, 4 * li, DM / 64), roff2 = (unsigned)((size_t)m * DM * 2 + (size_t)li * 8), roff4 = (unsigned)((size_t)m * DM * 4 + (size_t)li * 16);
    v2u f[32], b[32];
    { unsigned o_ = roff2; asm volatile("" : "+v"(o_));
#pragma unroll
      for (int j = 0; j < 32; ++j) f[j] = *(const GAS v2u*)((const GAS unsigned char*)ffbuf + (size_t)j * 256u + o_); }
    { unsigned o_ = BASE_TILED ? toff : roff2; asm volatile("" : "+v"(o_));
#pragma unroll
      for (int j = 0; j < 32; ++j) b[j] = *(const GAS v2u*)((const GAS unsigned char*)basebuf + (size_t)j * (BASE_TILED ? 32768u : 256u) + o_); }
    const float bs = bscale ? 1.0f / bscale[m] : 1.0f;
    float ss = 0.f;
#pragma unroll
    for (int j = 0; j < 32; ++j) { const float a0 = bflo(f[j].x), a1 = bfhi(f[j].x), a2 = bflo(f[j].y), a3 = bfhi(f[j].y); ss += (a0 * a0 + a1 * a1) + (a2 * a2 + a3 * a3); }
#pragma unroll
    for (int o = 1; o < 32; o <<= 1) ss += __shfl_xor(ss, o);
    const float rs = w / sqrtf(ss * (1.0f / DM) + EPS);
    const LAS unsigned char* gl_ = (const LAS unsigned char*)gl + li * 16;
#define NRP_H(j) const f32x4 g = *(const LAS f32x4*)(gl_ + (j) * 512); \
        asm volatile("" : "+v"(f[j].x), "+v"(f[j].y), "+v"(b[j].x), "+v"(b[j].y));       \
        f32x4 h; h.x = bflo(b[j].x) * bs + bflo(f[j].x) * rs * g.x; h.y = bfhi(b[j].x) * bs + bfhi(f[j].x) * rs * g.y; h.z = bflo(b[j].y) * bs + bflo(f[j].y) * rs * g.z; h.w = bfhi(b[j].y) * bs + bfhi(f[j].y) * rs * g.w
    if constexpr (OUT_TILED) {
        float s2 = 0.f;
#pragma unroll
        for (int j = 0; j < 32; ++j) { NRP_H(j); s2 += (h.x * h.x + h.y * h.y) + (h.z * h.z + h.w * h.w); if ((j & 3) == 3) asm volatile("" ::: "memory"); }
#pragma unroll
        for (int o = 1; o < 32; o <<= 1) s2 += __shfl_xor(s2, o);
        const float r2 = 1.0f / sqrtf(s2 * (1.0f / DM) + EPS);
        if (li == 0) rsout[m] = r2;
        unsigned o_ = toff; asm volatile("" : "+v"(o_));
#pragma unroll
        for (int j = 0; j < 32; ++j) { NRP_H(j); v2u o; o.x = pk2(h.x * r2, h.y * r2); o.y = pk2(h.z * r2, h.w * r2); *(GAS v2u*)((GAS unsigned char*)outbuf + (size_t)j * 32768u + o_) = o;
            if ((j & 3) == 3) asm volatile("" ::: "memory"); }
    } else {
        unsigned o_ = roff4; asm volatile("" : "+v"(o_));
#pragma unroll
        for (int j = 0; j < 32; ++j) { NRP_H(j); *(GAS f32x4*)((GAS unsigned char*)outbuf + (size_t)j * 512u + o_) = h; if ((j & 3) == 3) asm volatile("" ::: "memory"); }
    }
#undef NRP_H
}
template <bool BASE_BF16, bool OUT_BF16>
__device__ __forceinline__ void norm_res_row(const bf16* ffrow, const void* baserow, void* hrow, float w, const float* gpost, float* rsrow, int lane) {
    const GAS v2u* fr = (const GAS v2u*)ffrow + lane; const GAS f32x4* gp = (const GAS f32x4*)gpost + lane;
    f32x4 v[16]; float ss = 0.f;
    v2u rb16[16]; f32x4 rb32[BASE_BF16 ? 1 : 16];
#pragma unroll
    for (int j = 0; j < 16; ++j) { if (BASE_BF16) rb16[j] = ((const GAS v2u*)baserow + lane)[64 * j]; else rb32[j] = ((const GAS f32x4*)baserow + lane)[64 * j]; }
#pragma unroll
    for (int j = 0; j < 16; ++j) { const v2u r = fr[64 * j]; v[j] = (f32x4){bflo(r.x), bfhi(r.x), bflo(r.y), bfhi(r.y)}; ss += (v[j].x * v[j].x + v[j].y * v[j].y) + (v[j].z * v[j].z + v[j].w * v[j].w); }
    const float rs = w / sqrtf(wave_sum(ss) * (1.0f / DM) + EPS);
    float s2 = 0.f;
#pragma unroll
    for (int j = 0; j < 16; ++j) { const f32x4 g = gp[64 * j]; f32x4 b;
        if (BASE_BF16) { const v2u r = rb16[j]; b = (f32x4){bflo(r.x), bfhi(r.x), bflo(r.y), bfhi(r.y)}; } else b = rb32[j];
        v[j] = b + v[j] * rs * g;
        if (OUT_BF16 && !rsrow) { v2u o; o.x = pk2(v[j].x, v[j].y); o.y = pk2(v[j].z, v[j].w); ((GAS v2u*)hrow + lane)[64 * j] = o; } else if (!OUT_BF16) ((GAS f32x4*)hrow + lane)[64 * j] = v[j];
        s2 += (v[j].x * v[j].x + v[j].y * v[j].y) + (v[j].z * v[j].z + v[j].w * v[j].w); }
    if (rsrow) {
        const float r2 = 1.0f / sqrtf(wave_sum(s2) * (1.0f / DM) + EPS);
        if (lane == 0) *rsrow = r2;
        if (OUT_BF16) {
#pragma unroll
            for (int j = 0; j < 16; ++j) { v2u o; o.x = pk2(v[j].x * r2, v[j].y * r2); o.y = pk2(v[j].z * r2, v[j].w * r2); ((GAS v2u*)hrow + lane)[64 * j] = o; } }
    }
}

constexpr int HG_QB = 0, HG_KT = 8704, HG_KTT = 17408, HG_SC = 27648, HG_EL = 30208, HG_QT = 30720;
typedef short bf16x8 __attribute__((ext_vector_type(8)));
typedef short bf16x4 __attribute__((ext_vector_type(4)));
__device__ __forceinline__ void hgrn_mfma_unit(LAS unsigned char* lds0, const bf16* proj, const bf16* it, bf16* obuf, int b, int h, int dir, int tid) {
    const int lane = tid & 63, wave = __builtin_amdgcn_readfirstlane(tid >> 6), i16 = lane & 15, g = lane >> 4;
    const int k = 16 * wave + i16, qd = g;
    const size_t rowbase = (size_t)b * SEQ;
    const int gcol = (dir ? C_GB : C_GF) + h * HD + k, qcol = C_Q + h * HD + k;
    f32x4 S[8];
#pragma unroll
    for (int kt = 0; kt < 8; ++kt) S[kt] = (f32x4){0.f, 0.f, 0.f, 0.f};
    const GAS unsigned char* vbase = (const GAS unsigned char*)it + ((size_t)(h * HD + 16 * wave) * MROWS + rowbase) * 2;
    const GAS unsigned char* pbase = (const GAS unsigned char*)proj + rowbase * (size_t)(PROJ_W * 2);
    GAS unsigned char* obase = (GAS unsigned char*)obuf + (rowbase * (size_t)HGW + h * HD + 16 * wave) * 2;
    const unsigned lv = (unsigned)(i16 * MROWS + 8 * g) * 2u, lq = (unsigned)(8 * qd * PROJ_W + qcol) * 2u, lg = (unsigned)(8 * qd * PROJ_W + gcol) * 2u, lo_ = (unsigned)(4 * g * HGW + i16) * 2u;
    unsigned short qn[8], gn[8]; bf16x8 vn; f32x4 op[2]; op[0] = (f32x4){0.f, 0.f, 0.f, 0.f}; op[1] = op[0];
    { const int t0 = dir ? (SEQ - 32) : 0; vn = *(const GAS bf16x8*)(vbase + (size_t)t0 * 2 + lv);
#pragma unroll
      for (int j = 0; j < 8; ++j) { const GAS unsigned char* ub = pbase + (size_t)(t0 + j) * (PROJ_W * 2); qn[j] = *(const GAS unsigned short*)(ub + lq); gn[j] = *(const GAS unsigned short*)(ub + lg); } }
    for (int cc = 0; cc < SEQ / 32; ++cc) {
        LAS unsigned char* lds = lds0 + (cc & 1) * 32768;
        LAS float* EL = (LAS float*)(lds + HG_EL);
        const int t0 = dir ? (SEQ - 32 * (cc + 1)) : 32 * cc;
        const bf16x8 vfrag = vn;
        float qv[8], gv[8];
#pragma unroll
        for (int j = 0; j < 8; ++j) { qv[j] = bf2f(qn[j]); gv[j] = h2f(gn[j]); }
        if (cc > 0) { const int tp = dir ? (SEQ - 32 * cc) : 32 * (cc - 1); unsigned lo2 = lo_; asm volatile("" : "+v"(lo2));
#pragma unroll
            for (int itl = 0; itl < 2; ++itl)
#pragma unroll
                for (int e = 0; e < 4; e += 2) { const unsigned pk = pg8::cvt_pk_bf16(op[itl][e], op[itl][e + 1]); GAS unsigned char* ub = obase + (size_t)(tp + 16 * itl + e) * (HGW * 2); GAS unsigned char* ub2 = ub + HGW * 2; asm volatile("" : "+s"(ub2));
                    *(GAS unsigned short*)(ub + lo2) = (unsigned short)(pk & 0xffffu); *(GAS unsigned short*)(ub2 + lo2) = (unsigned short)(pk >> 16); } }
        asm volatile("" ::: "memory");
        if (cc + 1 < SEQ / 32) {
            unsigned lv_ = lv, lq_ = lq, lg_ = lg; asm volatile("" : "+v"(lv_), "+v"(lq_), "+v"(lg_));
            const int t1 = dir ? (SEQ - 32 * (cc + 2)) : 32 * (cc + 1); vn = *(const GAS bf16x8*)(vbase + (size_t)t1 * 2 + lv_);
#pragma unroll
            for (int j = 0; j < 8; ++j) { const GAS unsigned char* ub = pbase + (size_t)(t1 + j) * (PROJ_W * 2); qn[j] = *(const GAS unsigned short*)(ub + lq_); gn[j] = *(const GAS unsigned short*)(ub + lg_); } }
        float cs[8]; float tot = 0.f;
        if (dir == 0) {
#pragma unroll
            for (int j = 0; j < 8; ++j) { tot += gv[j]; cs[j] = tot; }
        } else {
#pragma unroll
            for (int j = 7; j >= 0; --j) { tot += gv[j]; cs[j] = tot; }
        }
        { const float t0q = __shfl(tot, i16), t1q = __shfl(tot, i16 + 16), t2q = __shfl(tot, i16 + 32), t3q = __shfl(tot, i16 + 48);
          float off;
          if (dir == 0) off = (qd > 0 ? t0q : 0.f) + (qd > 1 ? t1q : 0.f) + (qd > 2 ? t2q : 0.f);
          else          off = (qd < 3 ? t3q : 0.f) + (qd < 2 ? t2q : 0.f) + (qd < 1 ? t1q : 0.f);
          if (qd == 0) EL[k] = __builtin_amdgcn_exp2f((t0q + t1q) + (t2q + t3q));
          unsigned kt8[8];
#pragma unroll
          for (int j = 0; j < 8; ++j) { const float bb = cs[j] + off; const float kk = 1.0f - __builtin_amdgcn_exp2f(gv[j]);
              const float qb = qv[j] * __builtin_amdgcn_exp2f(bb), ktv = kk * __builtin_amdgcn_exp2f(fminf(-bb, 115.f));
              const unsigned pk = pg8::cvt_pk_bf16(qb, ktv);
              *(LAS unsigned short*)(lds + HG_QB + (8 * qd + j) * 272 + 2 * k) = (unsigned short)(pk & 0xffffu);
              *(LAS unsigned short*)(lds + HG_KT + (8 * qd + j) * 272 + 2 * k) = (unsigned short)(pk >> 16);
              kt8[j] = pk >> 16; }
          v4u w; w.x = kt8[0] | (kt8[1] << 16); w.y = kt8[2] | (kt8[3] << 16); w.z = kt8[4] | (kt8[5] << 16); w.w = kt8[6] | (kt8[7] << 16);
          *(LAS v4u*)(lds + HG_KTT + k * 80 + 16 * qd) = w; }
        __syncthreads();
        if (wave < 4) { const int ti = wave >> 1, ts = wave & 1; f32x4 a = (f32x4){0.f, 0.f, 0.f, 0.f};
#pragma unroll
            for (int ks = 0; ks < 4; ++ks) { const bf16x8 af = *(const LAS bf16x8*)(lds + HG_QB + (16 * ti + i16) * 272 + (32 * ks + 8 * g) * 2), bfr = *(const LAS bf16x8*)(lds + HG_KT + (16 * ts + i16) * 272 + (32 * ks + 8 * g) * 2);
                a = __builtin_amdgcn_mfma_f32_16x16x32_bf16(af, bfr, a, 0, 0, 0); }
            const int ss = 16 * ts + i16;
#pragma unroll
            for (int e = 0; e < 4; e += 2) { const int si = 16 * ti + 4 * g + e; const bool k0 = dir ? (ss >= si) : (ss <= si), k1 = dir ? (ss >= si + 1) : (ss <= si + 1);
                const unsigned pk = pg8::cvt_pk_bf16(k0 ? a[e] : 0.f, k1 ? a[e + 1] : 0.f);
                *(LAS unsigned short*)(lds + HG_SC + si * 80 + 2 * ss) = (unsigned short)(pk & 0xffffu); *(LAS unsigned short*)(lds + HG_SC + (si + 1) * 80 + 2 * ss) = (unsigned short)(pk >> 16); } }
        f32x4 o[2]; o[0] = (f32x4){0.f, 0.f, 0.f, 0.f}; o[1] = o[0];
#pragma unroll
        for (int s4 = 0; s4 < 4; ++s4) {
            v4u sw; sw.x = pg8::cvt_pk_bf16(S[2 * s4][0], S[2 * s4][1]); sw.y = pg8::cvt_pk_bf16(S[2 * s4][2], S[2 * s4][3]); sw.z = pg8::cvt_pk_bf16(S[2 * s4 + 1][0], S[2 * s4 + 1][1]); sw.w = pg8::cvt_pk_bf16(S[2 * s4 + 1][2], S[2 * s4 + 1][3]);
            const bf16x8 sb = __builtin_bit_cast(bf16x8, sw);
#pragma unroll
            for (int itl = 0; itl < 2; ++itl) { const LAS unsigned char* qr = lds + HG_QB + (16 * itl + i16) * 272 + (32 * s4 + 4 * g) * 2;
                const v2u lo = *(const LAS v2u*)qr, hi = *(const LAS v2u*)(qr + 32);
                v4u aw; aw.x = lo.x; aw.y = lo.y; aw.z = hi.x; aw.w = hi.y;
                o[itl] = __builtin_amdgcn_mfma_f32_16x16x32_bf16(__builtin_bit_cast(bf16x8, aw), sb, o[itl], 0, 0, 0); }
        }
        __syncthreads();
#pragma unroll
        for (int itl = 0; itl < 2; ++itl) { const bf16x8 af = *(const LAS bf16x8*)(lds + HG_SC + (16 * itl + i16) * 80 + 16 * g);
            o[itl] = __builtin_amdgcn_mfma_f32_16x16x32_bf16(af, vfrag, o[itl], 0, 0, 0); }
        op[0] = o[0]; op[1] = o[1];
#pragma unroll
        for (int kt = 0; kt < 8; ++kt) { const bf16x8 af = *(const LAS bf16x8*)(lds + HG_KTT + (16 * kt + i16) * 80 + 16 * g);
            S[kt] = __builtin_amdgcn_mfma_f32_16x16x32_bf16(af, vfrag, S[kt], 0, 0, 0);
            const f32x4 el = *(const LAS f32x4*)(EL + 16 * kt + 4 * g);
            S[kt] = S[kt] * el; }
    }
    { const int tp = dir ? 0 : (SEQ - 32);
#pragma unroll
      for (int itl = 0; itl < 2; ++itl)
#pragma unroll
          for (int e = 0; e < 4; e += 2) { const unsigned pk = pg8::cvt_pk_bf16(op[itl][e], op[itl][e + 1]); GAS unsigned char* ub = obase + (size_t)(tp + 16 * itl + e) * (HGW * 2);
              *(GAS unsigned short*)(ub + lo_) = (unsigned short)(pk & 0xffffu); *(GAS unsigned short*)(ub + HGW * 2 + lo_) = (unsigned short)(pk >> 16); } }
    __syncthreads();
}

constexpr float NA_THR = 8.0f;
__device__ __forceinline__ void na_pair_mfma(const LAS float* tbl, const bf16* proj, const bf16* vt, bf16* mix, int b, int h, int rp, int cb, int lane) {
    const int r0 = 2 * rp;
    const int cbase = (cb == 0) ? 0 : (cb == 1) ? 8 : (cb == 2) ? 24 : 32;
    const int kb = min(max(r0 - WIN_R / 2, 0), NROWS - WIN_R), rs1 = min(max(r0 + 1 - WIN_R / 2, 0), NROWS - WIN_R);
    const int i = lane & 15, g = lane >> 4;
    const int c = 16 * cb + i, cs = min(max(c - WIN_C / 2, 0), GRID_W - WIN_C);
    const size_t tok0 = (size_t)b * SEQ;
    const bf16* qp = proj + (tok0 + r0 * GRID_W + c) * PROJ_W + C_NQ + h * HD + 8 * g;
    bf16x8 qf[2][4];
#pragma unroll
    for (int q = 0; q < 2; ++q)
#pragma unroll
        for (int ks = 0; ks < 4; ++ks) qf[q][ks] = *(const GAS bf16x8*)(qp + (size_t)q * GRID_W * PROJ_W + 32 * ks);
    const int kco = 8 * (i >> 2) + (i & 3);
    const bf16* kp0 = proj + (tok0 + cbase + kco) * PROJ_W + C_NK + h * HD + 8 * g;
    const bf16* vp0 = vt + (size_t)(h * HD + i) * MROWS + tok0 + cbase + 8 * g;
    const LAS float* tb = tbl + h * (15 * 31);
    int dcol[8]; bool okc[8];
#pragma unroll
    for (int j = 0; j < 8; ++j) { const int kcol = cbase + 8 * g + j; okc[j] = (kcol >= cs) && (kcol < cs + WIN_C); dcol[j] = min(max(kcol - c + WIN_C - 1, 0), 30); }
    f32x4 acc[2][8]; float m[2], l[2];
#pragma unroll
    for (int q = 0; q < 2; ++q) { m[q] = -1.0e30f; l[q] = 0.f;
#pragma unroll
        for (int dt = 0; dt < 8; ++dt) acc[q][dt] = (f32x4){0.f, 0.f, 0.f, 0.f}; }
#pragma unroll 1
    for (int kr = 0; kr < 9; ++kr) {
        const int krow = kb + kr, lrow = min(krow, NROWS - 1);
        const bf16* kp = kp0 + (size_t)(lrow * GRID_W) * PROJ_W;
        bf16x8 kf[2][4];
#pragma unroll
        for (int t = 0; t < 2; ++t)
#pragma unroll
            for (int ks = 0; ks < 4; ++ks) kf[t][ks] = *(const GAS bf16x8*)(kp + (size_t)(4 * t) * PROJ_W + 32 * ks);
        bf16x8 vf[8];
#pragma unroll
        for (int dt = 0; dt < 8; ++dt) vf[dt] = *(const GAS bf16x8*)(vp0 + (size_t)(16 * dt) * MROWS + lrow * GRID_W);
#pragma unroll
        for (int q = 0; q < 2; ++q) {
            const int r = r0 + q, rsq = q ? rs1 : kb;
            const bool rowok = (krow >= rsq) && (krow < rsq + WIN_R);
            const int dr = min(max(krow - r + WIN_R - 1, 0), 14);
            f32x4 s0 = (f32x4){0.f, 0.f, 0.f, 0.f}, s1 = s0;
#pragma unroll
            for (int ks = 0; ks < 4; ++ks) { s0 = __builtin_amdgcn_mfma_f32_16x16x32_bf16(kf[0][ks], qf[q][ks], s0, 0, 0, 0); s1 = __builtin_amdgcn_mfma_f32_16x16x32_bf16(kf[1][ks], qf[q][ks], s1, 0, 0, 0); }
            float v[8]; float cmax = -3.0e38f;
#pragma unroll
            for (int j = 0; j < 8; ++j) { const float sv = (j < 4) ? s0[j & 3] : s1[j & 3]; v[j] = (rowok && okc[j]) ? sv + tb[dr * 31 + dcol[j]] : -3.0e38f; cmax = fmaxf(cmax, v[j]); }
            if (__any(cmax > m[q] + NA_THR)) {
                float mx = fmaxf(cmax, __shfl_xor(cmax, 16)); mx = fmaxf(mx, __shfl_xor(mx, 32));
                const float mn = fmaxf(m[q], mx); const float sc = __builtin_amdgcn_exp2f((m[q] - mn) * 1.4426950408889634f);
                l[q] *= sc;
#pragma unroll
                for (int dt = 0; dt < 8; ++dt) acc[q][dt] = acc[q][dt] * sc;
                m[q] = mn; }
            float p[8];
#pragma unroll
            for (int j = 0; j < 8; ++j) { p[j] = __builtin_amdgcn_exp2f((v[j] - m[q]) * 1.4426950408889634f); l[q] += p[j]; }
            v4u w; w.x = pg8::cvt_pk_bf16(p[0], p[1]); w.y = pg8::cvt_pk_bf16(p[2], p[3]); w.z = pg8::cvt_pk_bf16(p[4], p[5]); w.w = pg8::cvt_pk_bf16(p[6], p[7]);
            const bf16x8 pf = __builtin_bit_cast(bf16x8, w);
#pragma unroll
            for (int dt = 0; dt < 8; ++dt) acc[q][dt] = __builtin_amdgcn_mfma_f32_16x16x32_bf16(vf[dt], pf, acc[q][dt], 0, 0, 0);
        }
    }
#pragma unroll
    for (int q = 0; q < 2; ++q) { float lq = l[q]; lq += __shfl_xor(lq, 16); lq += __shfl_xor(lq, 32);
        const float inv = 1.0f / lq;
        bf16* op = mix + (tok0 + (r0 + q) * GRID_W + c) * DM + HGW + h * HD + 4 * g;
#pragma unroll
        for (int dt = 0; dt < 8; ++dt) { v2u w; w.x = pg8::cvt_pk_bf16(acc[q][dt][0] * inv, acc[q][dt][1] * inv); w.y = pg8::cvt_pk_bf16(acc[q][dt][2] * inv, acc[q][dt][3] * inv); *(GAS v2u*)(op + 16 * dt) = w; } }
}

__device__ __forceinline__ void hgrn_combine_row(const bf16* of, const bf16* ob, const bf16* gaterow, const float* hn, bf16* orow, int lane) {
    const GAS v2u* a = (const GAS v2u*)of + lane; const GAS v2u* bq = (const GAS v2u*)ob + lane; const GAS v2u* gr = (const GAS v2u*)gaterow + lane;
    const f32x4 hg = *((const GAS f32x4*)hn + (lane & 31));
    GAS v2u* o8 = (GAS v2u*)orow + lane;
    v2u ra[8], rb[8], rg[8];
#pragma unroll
    for (int j = 0; j < 8; ++j) { ra[j] = a[64 * j]; rb[j] = bq[64 * j]; rg[j] = gr[64 * j]; }
#pragma unroll
    for (int j = 0; j < 8; ++j) {
        f32x4 v = (f32x4){bflo(ra[j].x) + bflo(rb[j].x), bfhi(ra[j].x) + bfhi(rb[j].x), bflo(ra[j].y) + bflo(rb[j].y), bfhi(ra[j].y) + bfhi(rb[j].y)};
        float ss = (v.x * v.x + v.y * v.y) + (v.z * v.z + v.w * v.w);
#pragma unroll
        for (int o = 1; o < 32; o <<= 1) ss += __shfl_xor(ss, o);
        const float rs = 1.0f / sqrtf(ss * (1.0f / HD) + EPS);
        const v2u g = rg[j];
        v2u w; w.x = pk2(v.x * rs * hg.x * bflo(g.x), v.y * rs * hg.y * bfhi(g.x)); w.y = pk2(v.z * rs * hg.z * bflo(g.y), v.w * rs * hg.w * bfhi(g.y));
        o8[64 * j] = w;
    }
}

struct Args { const float* in[18]; float* out; unsigned char* ws; int ph_lo, ph_hi; };
__global__ void __launch_bounds__(NWAVES * 64, 2) fwd_kernel(Args args) {
    extern __shared__ __attribute__((aligned(16))) unsigned char lds_raw[];
    LAS unsigned char* lds = (LAS unsigned char*)lds_raw;
    volatile LAS unsigned* MISC = (volatile LAS unsigned*)(lds + MISC_OFF);
    const int G = gridDim.x, bx = blockIdx.x;
    const int vcu = (G % 8 == 0) ? (bx % 8) * (G / 8) + bx / 8 : bx;
    gu32* ctl = (gu32*)(args.ws + WS_CTL);
    for (int u = threadIdx.x; u < (LDS_BYTES - LDSCTL_OFF) / 4; u += NWAVES * 64) ((LAS unsigned*)(lds + LDSCTL_OFF))[u] = 0u;
    __syncthreads();
    XcdBarrier bar; bar.bar = (unsigned*)(args.ws + WS_CTL) + CW_BAR; bar.x = 0; bar.st = nullptr;
#if !MK_PER_PHASE
    bar = xcd_barrier_post((unsigned*)(args.ws + WS_CTL) + CW_BAR, MISC + 8);
#endif
    const int lo = args.ph_lo, hi = args.ph_hi;
#if DIAG_BAR
    unsigned diag_wait = 0; int diag_nb = 0;
#endif
#define IN(k) (lo <= (k) && (k) < hi)
#define BOTH(k) (IN(k) && IN((k) + 1))
#if MK_PER_PHASE
#define GRID_BAR() do { if (threadIdx.x == 0) __hip_atomic_store(ctl + CW_TMO, 0xBADBA0u, RLX_AGENT); } while (0)
#else
#if DIAG_BAR
#define GRID_BAR() do { const unsigned long long t_a = __builtin_amdgcn_s_memrealtime(); xcd_barrier(bar); const unsigned long long t_b = __builtin_amdgcn_s_memrealtime(); \
        if (DIAG_BAR < 100 || DIAG_BAR - 100 == diag_nb) diag_wait += (unsigned)(t_b - t_a); ++diag_nb; } while (0)
#else
#define GRID_BAR() xcd_barrier(bar)
#endif
#endif
#define WGU1 ((bf16*)(args.ws + WS_WGU1))
#define WGU2 ((bf16*)(args.ws + WS_WGU2))
#define WD1 ((bf16*)(args.ws + WS_WD1))
#define WD2 ((bf16*)(args.ws + WS_WD2))
#define WIN ((bf16*)(args.ws + WS_WIN))
#define WOUT ((bf16*)(args.ws + WS_WOUT))
#define R1 ((bf16*)(args.ws + WS_R1))
#define IT ((bf16*)(args.ws + WS_TT))
#define VT ((bf16*)(args.ws + WS_TT) + (size_t)HGW * MROWS)
#define R2 ((float*)(args.ws + WS_R2))
#define R3 ((bf16*)(args.ws + WS_R3))
#define LB ((float*)(args.ws + WS_LB))
#define RS ((float*)(args.ws + WS_LB + 64 * 1024))
#define PHASE_IDS() int tid = threadIdx.x; asm volatile("" : "+v"(tid)); const int lane = tid & 63, wave = __builtin_amdgcn_readfirstlane(tid >> 6); \
    const int gw = vcu * NWAVES + wave, NGW = G * NWAVES; (void)lane; (void)gw; (void)NGW
#define PHASE_GATEUP(k, W, AP, RSP, ATILED) if (IN(k)) { _Pragma("unroll") for (int rr_ = 0; rr_ < NREP(k); ++rr_) { \
        pg8::Gemm g{(AP), (W), MROWS, 2 * FF, DM}; pg8::StaticOrder S; S.init(MROWS, GU_MAIN_N, G, bx); S.wgm = WGM_GU; \
        pg8::EpiSwiGLU E{R1, FF, (RSP)}; \
        pg8::gemm_phase<pg8::EpiSwiGLU, pg8::StaticOrder, G_ALIGN, G_SP2, true, ATILED>(lds + RING_OFF, g, S, E); \
        pg8::gemm_half_units<pg8::EpiSwiGLU, true, ATILED>(lds + RING_OFF, g, GU_MAIN_N / 256, (2 * FF - GU_MAIN_N) / 256, E, bx, G); } \
        if (BOTH(k)) GRID_BAR(); }
#define PHASE_DOWN(k, W, RSP) if (IN(k)) { _Pragma("unroll") for (int rr_ = 0; rr_ < NREP(k); ++rr_) { \
        pg8::Gemm g{R1, (W), MROWS, DM, FF}; pg8::StaticOrder S; S.init(MROWS, DM, G, bx); S.wgm = WGM_DOWN; \
        pg8::EpiBf16Plain E{(bf16*)R2, DM, (RSP)}; \
        pg8::gemm_phase<pg8::EpiBf16Plain, pg8::StaticOrder, G_ALIGN, G_SP2, true, true>(lds + RING_OFF, g, S, E); } \
        if (BOTH(k)) GRID_BAR(); }
#define PHASE_NORM(k, BBF, OBF, BASE, HOUT, WGT, GPOST, HASU) if (IN(k)) { PHASE_IDS(); \
        _Pragma("unroll") for (int rr_ = 0; rr_ < NREP(k); ++rr_) for (int m = gw; m < MROWS; m += NGW) \
            norm_res_row<BBF, OBF>((const bf16*)R2 + (size_t)m * DM, (const void*)(BASE), (void*)(HOUT), (WGT), (GPOST), (HASU) ? RS + m : (float*)nullptr, lane); \
        if (BOTH(k)) GRID_BAR(); }
#define HB ((bf16*)(args.ws + WS_R2 + 128 * MiB))

    if (IN(0)) { PHASE_IDS();
        LAS float* scr = (LAS float*)(lds + RING_OFF + wave * 16384);
        constexpr int I_GU = (DM / 64) * (FF / 32), I_D = (FF / 64) * (DM / 32), I_IN = (DM / 64) * (16384 / 32), I_OUT = (DM / 64) * (DM / 32);
        constexpr int NITEMS = 6 * I_GU + I_IN + I_OUT;
        static_assert(I_GU == I_D, "items");
        for (int rr_ = 0; rr_ < NREP(0); ++rr_)
        for (int it = gw; it < NITEMS; it += NGW) {
            int r = it; const float* W; bf16* WT; int K = DM, N = FF, mode = 0; const float* gain = nullptr;
            if (r < I_GU) { W = args.in[2]; WT = WGU1; mode = 1; gain = args.in[1]; }
            else if ((r -= I_GU) < I_GU) { W = args.in[3]; WT = WGU1; mode = 2; gain = args.in[1]; }
            else if ((r -= I_GU) < I_D) { W = args.in[4]; WT = WD1; K = FF; N = DM; }
            else if ((r -= I_D) < I_IN) { W = args.in[7]; WT = WIN; N = 16384; mode = 3; gain = args.in[6]; }
            else if ((r -= I_IN) < I_OUT) { W = args.in[11]; WT = WOUT; N = DM; }
            else if ((r -= I_OUT) < I_GU) { W = args.in[14]; WT = WGU2; mode = 1; gain = args.in[13]; }
            else if ((r -= I_GU) < I_GU) { W = args.in[15]; WT = WGU2; mode = 2; gain = args.in[13]; }
            else { r -= I_GU; W = args.in[16]; WT = WD2; K = FF; N = DM; }
            transpose_item(W, K, N, WT, mode, scr, r, lane, gain, (mode == 3) ? PROJ_W : (1 << 30), mode == 1 ? 1.4426950408889634f : mode == 2 ? 0.6931471805599453f : 1.0f);
        }
        for (int mp = gw; mp < MROWS / 2; mp += NGW) rms_rowpair_to_bf16_tiled(args.in[0], R3, 2 * mp, lane);
        for (int i = bx * 512 + tid; i < 2 * HGW; i += G * 512) { const float l0 = args.in[8][i], l1 = args.in[8][2 * HGW + i]; LB[i] = 1.0f / (1.0f + expf(l1 - l0)); }
        if (BOTH(0)) GRID_BAR();
    }
    PHASE_GATEUP(1, WGU1, R3, (const float*)nullptr, true)
    PHASE_DOWN(2, WD1, (const float*)nullptr)
    PHASE_NORM(3, false, true, args.in[0] + (size_t)m * DM, HB + (size_t)m * DM, 0.5f, args.in[5], true)
    if (IN(3) && IN(4)) { for (int eb = 0; eb < EXTRA_BARS; ++eb) GRID_BAR(); }
    if (IN(4)) {
#pragma unroll
        for (int rr_ = 0; rr_ < NREP(4); ++rr_) {
        { pg8::Gemm g{HB, WIN, MROWS, PROJ_W, DM}; pg8::StaticOrder S; S.init(MROWS, PROJ_W, G, bx); S.wgm = WGM_IN;
          pg8::EpiProj E{R1, PROJ_W, LB, (const float*)nullptr};
          pg8::gemm_phase<pg8::EpiProj, pg8::StaticOrder, G_ALIGN, G_SP2, true>(lds + RING_OFF, g, S, E); }
        { pg8::Gemm g{WIN + (size_t)PROJ_W * DM, HB, HGW + NAW, MROWS, DM}; pg8::StaticOrder S; S.init(HGW + NAW, MROWS, G, bx); S.wgm = WGM_TT;
          pg8::EpiBf16Plain E{IT, MROWS, (const float*)nullptr};
          pg8::gemm_phase<pg8::EpiBf16Plain, pg8::StaticOrder, G_ALIGN, G_SP2>(lds + RING_OFF, g, S, E); }
        }
        if (BOTH(4)) GRID_BAR();
    }
    if (IN(5)) { PHASE_IDS();
        for (int rr_ = 0; rr_ < NREP(5); ++rr_)
        if (bx < 2 * BATCH * NHEAD) { const int dir = bx & 1, h = (bx >> 1) & 15, b = bx >> 5;
            hgrn_mfma_unit(lds + RING_OFF, R1, IT, (bf16*)R2 + (size_t)dir * MROWS * HGW, b, h, dir, tid); }
        { LAS float* tbl = (LAS float*)(lds + RING_OFF);
          for (int q = tid; q < NHEAD * 15 * 31; q += 512) tbl[q] = args.in[10][q];
          __syncthreads();
          const int xq = (int)(xb_xcc_id() & 7u);
          for (int rr_ = 0; rr_ < NREP(12); ++rr_)
          for (int qq = 0; qq < 8; ++qq) { const int q = (xq + qq) & 7;
            for (;;) {
              if (tid == 0) MISC[16] = __hip_atomic_fetch_add(ctl + CW_QUEUE + 64 * (8 * rr_ + q), 1u, RLX_AGENT);
              __syncthreads();
              const int li = (int)MISC[16];
              __syncthreads();
              if (li >= 128) break;
              const int rq = li & 15, bh = q * 8 + (li >> 4), h = bh & 15, b = bh >> 4;
              na_pair_mfma(tbl, R1, VT, R3, b, h, 2 * rq + (wave >> 2), wave & 3, lane);
            } }
        }
        if (BOTH(5)) GRID_BAR();
    }
    if (IN(6)) { PHASE_IDS();
        for (int rr_ = 0; rr_ < NREP(6); ++rr_)
        for (int m = gw; m < MROWS; m += NGW)
            hgrn_combine_row((const bf16*)R2 + (size_t)m * HGW, (const bf16*)R2 + (size_t)MROWS * HGW + (size_t)m * HGW, R1 + (size_t)m * PROJ_W + C_GATE, args.in[9], R3 + (size_t)m * DM, lane);
        if (BOTH(6)) GRID_BAR();
    }
    if (IN(7)) {
#pragma unroll
        for (int rr_ = 0; rr_ < NREP(7); ++rr_) {
        pg8::Gemm g{R3, WOUT, MROWS, DM, DM}; pg8::StaticOrder S; S.init(MROWS, DM, G, bx); S.nrep = P7_INNER_REP; S.wgm = WGM_OUT;
        pg8::EpiBf16Plain E{(bf16*)R2, DM, (const float*)nullptr};
        pg8::gemm_phase<pg8::EpiBf16Plain, pg8::StaticOrder, G_ALIGN, G_SP2, true>(lds + RING_OFF, g, S, E); }
        if (BOTH(7)) GRID_BAR();
    }
    if (IN(8)) { PHASE_IDS();
        LAS float* gl = (LAS float*)(lds + RING_OFF);
        for (int i = tid; i < DM / 4; i += 512) ((LAS f32x4*)gl)[i] = ((const GAS f32x4*)args.in[12])[i];
        __syncthreads();
        _Pragma("unroll") for (int rr_ = 0; rr_ < NREP(8); ++rr_) for (int mp = gw; mp < MROWS / 2; mp += NGW)
            norm_res_rowpair<false, true>((const bf16*)R2, HB, (void*)R3, 1.0f, gl, RS, RS, 2 * mp, lane);
        if (BOTH(8)) GRID_BAR(); }
    PHASE_GATEUP(9, WGU2, R3, (const float*)nullptr, true)
    PHASE_DOWN(10, WD2, (const float*)nullptr)
    if (IN(11)) { PHASE_IDS();
        LAS float* gl = (LAS float*)(lds + RING_OFF);
        for (int i = tid; i < DM / 4; i += 512) ((LAS f32x4*)gl)[i] = ((const GAS f32x4*)args.in[17])[i];
        __syncthreads();
        for (int mp = gw; mp < MROWS / 2; mp += NGW)
            norm_res_rowpair<true, false>((const bf16*)R2, R3, (void*)args.out, 0.5f, gl, (float*)nullptr, RS, 2 * mp, lane); }
#if DIAG_BAR
    if (threadIdx.x == 0) { gu32* dw = ctl + 12288;
        __hip_atomic_fetch_add(dw, diag_wait, RLX_AGENT); __hip_atomic_fetch_max(dw + 64, diag_wait, RLX_AGENT);
        __threadfence();
        const unsigned prev = __hip_atomic_fetch_add(dw + 128, 1u, RLX_AGENT);
        if (prev == (unsigned)G - 1u) { __threadfence(); const unsigned sum = __hip_atomic_load(dw, RLX_AGENT), mx = __hip_atomic_load(dw + 64, RLX_AGENT);
            const float val = (DIAG_BAR == 2) ? (float)mx * 0.01f : (float)sum * 0.01f / (float)G;
            args.out[0] = 1000.0f + floorf(val * (1.0f / 40.0f)) * 40.0f; } }
#endif
#if !MK_PER_PHASE
    if (IN(11)) { if (xb_ld((unsigned*)(args.ws + WS_CTL) + CW_BAR + XB_TMO) != 0u) { const float q = __builtin_nanf(""); for (int m = bx; m < MROWS; m += G) for (int c = threadIdx.x; c < DM; c += 512) args.out[(size_t)m * DM + c] = q; } }
#endif
#undef IN
#undef BOTH
}

extern "C" void kernel_launch(void* const* d_in, const int* in_sizes, int n_in, void* d_out, int out_size, void* d_ws, size_t ws_size, hipStream_t stream) {
    static int grid = 0;
    if (grid == 0) {
        if (n_in != 18 || in_sizes[0] != MROWS * DM || out_size != MROWS * DM || ws_size < WS_END) {
            fprintf(stderr, "kernel_launch: unexpected shapes (n_in %d, in0 %d, out %d, ws %zu need %zu); nothing launched\n", n_in, n_in > 0 ? in_sizes[0] : -1, out_size, ws_size, (size_t)WS_END); grid = -1; return; }
        int dev = 0, cus = 0;
        if (hipGetDevice(&dev) != hipSuccess || hipDeviceGetAttribute(&cus, hipDeviceAttributeMultiprocessorCount, dev) != hipSuccess) { grid = -1; return; }
        if (hipFuncSetAttribute((const void*)fwd_kernel, hipFuncAttributeMaxDynamicSharedMemorySize, LDS_BYTES) != hipSuccess) { fprintf(stderr, "kernel_launch: hipFuncSetAttribute failed\n"); grid = -1; return; }
        int per_cu = 0;
        if (hipOccupancyMaxActiveBlocksPerMultiprocessor(&per_cu, (const void*)fwd_kernel, NWAVES * 64, LDS_BYTES) != hipSuccess || per_cu < 1)
            fprintf(stderr, "kernel_launch: note: occupancy query reports %d workgroups per CU\n", per_cu);
        (void)hipGetLastError();
        grid = cus;
    }
    if (grid < 0) return;
    if (hipMemsetAsync((char*)d_ws + WS_CTL, 0, CTL_ZERO_BYTES, stream) != hipSuccess) { fprintf(stderr, "kernel_launch: memset failed\n"); return; }
    Args a{};
    for (int i = 0; i < 18; ++i) a.in[i] = (const float*)d_in[i];
    a.out = (float*)d_out; a.ws = (unsigned char*)d_ws;
#if MK_PER_PHASE
    for (int p = 0; p < N_PHASES; ++p) { a.ph_lo = p; a.ph_hi = p + 1; hipLaunchKernelGGL(fwd_kernel, dim3(grid), dim3(NWAVES * 64), LDS_BYTES, stream, a); }
#else
    a.ph_lo = 0; a.ph_hi = N_PHASES;
    hipLaunchKernelGGL(fwd_kernel, dim3(grid), dim3(NWAVES * 64), LDS_BYTES, stream, a);
#endif
    const hipError_t le = hipPeekAtLastError();
    if (le != hipSuccess) fprintf(stderr, "kernel_launch: launch failed: %s\n", hipGetErrorName(le));
}
```

```cpp
#include <hip/hip_runtime.h>
#include <cstdio>
#include <cstdint>

#ifndef REPEAT_MASK
#define REPEAT_MASK 0
#endif
#define NREP(k) (1 + ((REPEAT_MASK >> (k)) & 1))
#ifndef G_SP2
#define G_SP2 true
#endif
#ifndef G_ALIGN
#define G_ALIGN true
#endif
#ifndef EPI_TWICE
#define EPI_TWICE 0
#endif
#ifndef DIAG_BAR
#define DIAG_BAR 0
#endif
#ifndef P7_INNER_REP
#define P7_INNER_REP 1
#endif
#ifndef WGM_GU
#define WGM_GU 8
#endif
#ifndef WGM_IN
#define WGM_IN 8
#endif
#ifndef WGM_OUT
#define WGM_OUT 4
#endif
#ifndef WGM_TT
#define WGM_TT 4
#endif
#ifndef WGM_DOWN
#define WGM_DOWN 4
#endif
#ifndef EXTRA_BARS
#define EXTRA_BARS 0
#endif
#ifndef MK_PER_PHASE
#define MK_PER_PHASE 0
#endif

namespace pg8 {
#define PG8_LAS __attribute__((address_space(3)))
typedef unsigned short bf16_t;
typedef short bf16x8 __attribute__((ext_vector_type(8)));
typedef float f32x4 __attribute__((ext_vector_type(4)));
typedef unsigned u32x4 __attribute__((ext_vector_type(4)));
constexpr int BM = 256, BK = 64, HALF = 128, HTB = HALF * BK * 2  , STAGE_BYTES = 8 * HTB, NXCD = 8, WGM = 8;

__host__ __device__ __forceinline__ int lds_byte(int r, int c) { const int st = (r >> 4) * 2 + (c >> 5), rr = r & 15, cc = c & 31, ob = rr * 64 + cc * 2; return st * 1024 + (ob ^ (((ob >> 9) & 1) << 5)); }
__host__ __device__ __forceinline__ void stage_rc(int b, int& R, int& C) { const int st = b / 1024, sb = b % 1024, swz = sb ^ (((sb >> 9) & 1) << 5); R = (st >> 1) * 16 + swz / 64; C = (st & 1) * 32 + (swz % 64) / 2; }
__host__ __device__ __forceinline__ int perm32(int rho) { const int n = rho >> 4, i = rho & 15; return 8 * (i >> 2) + 4 * n + (i & 3); }

struct Unit { int pm, pn; };
struct Gemm { const bf16_t* A; const bf16_t* Bt; int M, N, K; };

struct StaticOrder {
    int nM, nN, nwg, G, c, nrep = 1, wgm = WGM;
    __host__ __device__ void init(int M, int N, int G_, int c_) { nM = M / BM; nN = N / BM; nwg = nM * nN; G = G_; c = c_; }
    __host__ __device__ bool next(int i, Unit& u) const {
        long L = (long)i * G + c; if (L >= (long)nwg * nrep) return false; L %= nwg;
        int wgid = (int)L; { const int q = nwg / NXCD, r = nwg % NXCD, xcd = wgid % NXCD, off = wgid / NXCD; wgid = (xcd < r ? xcd * (q + 1) : r * (q + 1) + (xcd - r) * q) + off; }
        const int nig = wgm * nN, gid = wgid / nig, fm = gid * wgm, gsz = (nM - fm) < wgm ? (nM - fm) : wgm;
        u.pm = fm + ((wgid % nig) % gsz); u.pn = (wgid % nig) / gsz; return true;
    }
    __device__ __forceinline__ void a_ready(const Unit&) const {}
    __device__ __forceinline__ void done(const Unit&) const {}
};

typedef float f32x2_t __attribute__((ext_vector_type(2)));
typedef __bf16 bf16x2_t __attribute__((ext_vector_type(2)));
__device__ __forceinline__ unsigned cvt_pk_bf16(float lo, float hi) { const f32x2_t v = {lo, hi}; const bf16x2_t b = __builtin_convertvector(v, bf16x2_t); return __builtin_bit_cast(unsigned, b); }
__device__ __forceinline__ unsigned cvt_pk_f16(float lo, float hi) { typedef _Float16 h2 __attribute__((ext_vector_type(2))); h2 v; v.x = (_Float16)lo; v.y = (_Float16)hi; return __builtin_bit_cast(unsigned, v); }
__device__ __forceinline__ float sigmoidf_fast(float v) { return __builtin_amdgcn_rcpf(1.0f + __builtin_amdgcn_exp2f(-1.4426950408889634f * v)); }

struct EpiF32 {
    static constexpr bool PERM = false, AFTER_DRAIN = false;
    float* C; int ldc;
    __device__ __forceinline__ void operator()(const f32x4 (&acc)[2][2][4][2], const Unit& u, int wr, int wc, int fr, int fq) const {
        const int row0 = u.pm * BM + wr * 64 + fr, col0 = u.pn * BM + wc * 32 + 4 * fq;
#pragma unroll
        for (int ai = 0; ai < 2; ++ai)
#pragma unroll
            for (int m = 0; m < 4; ++m) { float* rowp = C + (size_t)(row0 + ai * HALF + m * 16) * ldc + col0;
#pragma unroll
                for (int bj = 0; bj < 2; ++bj)
#pragma unroll
                    for (int n = 0; n < 2; ++n) *(f32x4*)(rowp + bj * HALF + n * 16) = acc[ai][bj][m][n]; }
    }
};
struct EpiBf16Plain {
    static constexpr bool PERM = true, AFTER_DRAIN = false;
    bf16_t* O; int ldc; const float* rs;
    __device__ __forceinline__ void operator()(const f32x4 (&acc)[2][2][4][2], const Unit& u, int wr, int wc, int fr, int fq) const {
        const int row0 = u.pm * BM + wr * 64 + fr, col0 = u.pn * BM + wc * 32 + 8 * fq;
#pragma unroll
        for (int ai = 0; ai < 2; ++ai)
#pragma unroll
            for (int m = 0; m < 4; ++m) { bf16_t* rowp = O + (size_t)(row0 + ai * HALF + m * 16) * ldc + col0;
                const float r = rs ? rs[row0 + ai * HALF + m * 16] : 1.0f;
#pragma unroll
                for (int bj = 0; bj < 2; ++bj) { const f32x4 v0 = acc[ai][bj][m][0] * r, v1 = acc[ai][bj][m][1] * r;
                    u32x4 w; w.x = cvt_pk_bf16(v0[0], v0[1]); w.y = cvt_pk_bf16(v0[2], v0[3]); w.z = cvt_pk_bf16(v1[0], v1[1]); w.w = cvt_pk_bf16(v1[2], v1[3]);
                    *(u32x4*)(rowp + bj * HALF) = w; } }
    }
};
struct EpiBf16ColScale {
    static constexpr bool PERM = true, AFTER_DRAIN = false;
    bf16_t* O; int ldc; const float* cs;
    __device__ __forceinline__ void operator()(const f32x4 (&acc)[2][2][4][2], const Unit& u, int wr, int wc, int fr, int fq) const {
        const int row0 = u.pm * BM + wr * 64 + fr, col0 = u.pn * BM + wc * 32 + 8 * fq;
        f32x4 c0[2], c1[2];
#pragma unroll
        for (int bj = 0; bj < 2; ++bj) { c0[bj] = *(const f32x4*)(cs + col0 + bj * HALF); c1[bj] = *(const f32x4*)(cs + col0 + bj * HALF + 4); }
#pragma unroll
        for (int ai = 0; ai < 2; ++ai)
#pragma unroll
            for (int m = 0; m < 4; ++m) { bf16_t* rowp = O + (size_t)(row0 + ai * HALF + m * 16) * ldc + col0;
#pragma unroll
                for (int bj = 0; bj < 2; ++bj) { const f32x4 v0 = acc[ai][bj][m][0] * c0[bj], v1 = acc[ai][bj][m][1] * c1[bj];
                    u32x4 w; w.x = cvt_pk_bf16(v0[0], v0[1]); w.y = cvt_pk_bf16(v0[2], v0[3]); w.z = cvt_pk_bf16(v1[0], v1[1]); w.w = cvt_pk_bf16(v1[2], v1[3]);
                    *(u32x4*)(rowp + bj * HALF) = w; } }
    }
};
struct EpiSwiGLU {
    static constexpr bool PERM = true, AFTER_DRAIN = false;
    bf16_t* H; int ldc; const float* rs;
    __device__ __forceinline__ size_t tiled(int hp, int pn, int wr, int wc, int fr, int fq) const {
        return ((size_t)hp * (size_t)(ldc >> 6) + (size_t)(pn * 2 + (wc >> 1))) * 16384u + (size_t)lds_byte(wr * 64 + fr, (wc & 1) * 32 + 8 * fq); }
    __device__ __forceinline__ void operator()(const f32x4 (&acc)[2][2][4][2], const Unit& u, int wr, int wc, int fr, int fq) const {
        const int row0 = u.pm * BM + wr * 64 + fr;
#pragma unroll
        for (int ai = 0; ai < 2; ++ai)
#pragma unroll
            for (int m = 0; m < 4; ++m) { bf16_t* rowp = (bf16_t*)((unsigned char*)H + tiled(u.pm * 2 + ai, u.pn, wr, wc, fr, fq) + m * 2048);
                const float r = rs ? rs[row0 + ai * HALF + m * 16] : 1.0f;
                float h[8], gg[8], tt[8];
#pragma unroll
                for (int n = 0; n < 2; ++n)
#pragma unroll
                    for (int e = 0; e < 4; ++e) gg[4 * n + e] = acc[ai][0][m][n][e] * r;
#pragma unroll
                for (int q = 0; q < 8; ++q) tt[q] = __builtin_amdgcn_exp2f(-gg[q]);
#pragma unroll
                for (int n = 0; n < 2; ++n)
#pragma unroll
                    for (int e = 0; e < 4; ++e) h[4 * n + e] = gg[4 * n + e] * acc[ai][1][m][n][e];
#pragma unroll
                for (int q = 0; q < 8; ++q) tt[q] = 1.0f + tt[q];
#pragma unroll
                for (int q = 0; q < 8; ++q) tt[q] = __builtin_amdgcn_rcpf(tt[q]);
#pragma unroll
                for (int q = 0; q < 8; ++q) h[q] = h[q] * tt[q];
                u32x4 w; w.x = cvt_pk_bf16(h[0], h[1]); w.y = cvt_pk_bf16(h[2], h[3]); w.z = cvt_pk_bf16(h[4], h[5]); w.w = cvt_pk_bf16(h[6], h[7]);
                *(u32x4*)rowp = w; }
    }
    __device__ __forceinline__ void half(const f32x4 (&acc)[2][2][4][2], int pmh, int pn, int wr, int wc, int fr, int fq) const {
        const int row0 = pmh * HALF + wr * 64 + fr;
#pragma unroll
        for (int m = 0; m < 4; ++m) { bf16_t* rowp = (bf16_t*)((unsigned char*)H + tiled(pmh, pn, wr, wc, fr, fq) + m * 2048);
            const float r = rs ? rs[row0 + m * 16] : 1.0f;
            float h[8];
#pragma unroll
            for (int n = 0; n < 2; ++n)
#pragma unroll
                for (int e = 0; e < 4; ++e) { const float g = acc[0][0][m][n][e] * r, up = acc[0][1][m][n][e]; h[4 * n + e] = g * __builtin_amdgcn_rcpf(1.0f + __builtin_amdgcn_exp2f(-g)) * up; }
            u32x4 w; w.x = cvt_pk_bf16(h[0], h[1]); w.y = cvt_pk_bf16(h[2], h[3]); w.z = cvt_pk_bf16(h[4], h[5]); w.w = cvt_pk_bf16(h[6], h[7]);
            *(u32x4*)rowp = w; }
    }
};
struct EpiProj {
    static constexpr bool PERM = true, AFTER_DRAIN = false;
    bf16_t* P; int ldc; const float* lb; const float* rs;
    __device__ __forceinline__ void operator()(const f32x4 (&acc)[2][2][4][2], const Unit& u, int wr, int wc, int fr, int fq) const {
        const int sec = u.pn >> 3;
        const int row0 = u.pm * BM + wr * 64 + fr, col0 = u.pn * BM + wc * 32 + 8 * fq;
        const bool isg = (sec == 1 || sec == 2), act = (sec == 0 || sec == 3); const float sc = (sec == 4) ? 0.08838834764831845f : 1.0f;
        const float* lbp = lb + (isg ? (col0 - 2048) : 0);
#pragma unroll
        for (int ai = 0; ai < 2; ++ai)
#pragma unroll
            for (int m = 0; m < 4; ++m) { bf16_t* rowp = P + (size_t)(row0 + ai * HALF + m * 16) * ldc + col0;
                const float r = rs ? rs[row0 + ai * HALF + m * 16] : 1.0f;
#pragma unroll
                for (int bj = 0; bj < 2; ++bj) { float g[8]; u32x4 w;
                    if (isg) {
                        const f32x4 la = *(const f32x4*)(lbp + bj * HALF), lc = *(const f32x4*)(lbp + bj * HALF + 4);
#pragma unroll
                        for (int e = 0; e < 4; ++e) { const float f0 = la[e] + (1.0f - la[e]) * sigmoidf_fast(acc[ai][bj][m][0][e] * r), f1 = lc[e] + (1.0f - lc[e]) * sigmoidf_fast(acc[ai][bj][m][1][e] * r);
                            g[e] = __builtin_amdgcn_logf(f0); g[4 + e] = __builtin_amdgcn_logf(f1); }
                        w.x = cvt_pk_f16(g[0], g[1]); w.y = cvt_pk_f16(g[2], g[3]); w.z = cvt_pk_f16(g[4], g[5]); w.w = cvt_pk_f16(g[6], g[7]);
                    } else {
#pragma unroll
                        for (int n = 0; n < 2; ++n)
#pragma unroll
                            for (int e = 0; e < 4; ++e) { const float v = acc[ai][bj][m][n][e] * r; g[4 * n + e] = act ? v * sigmoidf_fast(v) : v * sc; }
                        w.x = cvt_pk_bf16(g[0], g[1]); w.y = cvt_pk_bf16(g[2], g[3]); w.z = cvt_pk_bf16(g[4], g[5]); w.w = cvt_pk_bf16(g[6], g[7]);
                    }
                    *(u32x4*)(rowp + bj * HALF) = w; }
                asm volatile("" ::: "memory"); }
    }
};

template <class Epi, class Sched, bool ALIGN_EPI = false, bool SP2 = false, bool B_TILED = false, bool A_TILED = false>
__device__ __forceinline__ void gemm_phase(PG8_LAS unsigned char* lds, const Gemm g, const Sched& S, const Epi& E) {
    static_assert(!B_TILED || Epi::PERM, "the pre-tiled B image carries the PERM row order");
    int tid_ = threadIdx.x; asm volatile("" : "+v"(tid_));
    const int tid = tid_, wid = __builtin_amdgcn_readfirstlane(tid >> 6), lane = tid & 63, wr = wid >> 2, wc = wid & 3, fr = lane & 15, fq = lane >> 4;
    const int K = g.K, nt = K / BK;
    unsigned voffA[2], voffB[2];
#pragma unroll
    for (int i = 0; i < 2; ++i) { int R, C; stage_rc(wid * 2048 + lane * 16 + i * 1024, R, C); const int Rb = Epi::PERM ? ((R & ~31) + perm32(R & 31)) : R;
        voffA[i] = A_TILED ? (unsigned)(wid * 2048 + lane * 16 + i * 1024) : (unsigned)(R * K + C) * 2u; voffB[i] = B_TILED ? (unsigned)(wid * 2048 + lane * 16 + i * 1024) : (unsigned)(Rb * K + C) * 2u; }
    const size_t kstep = A_TILED ? (size_t)HTB : (size_t)(BK * 2), kstepB = B_TILED ? (size_t)HTB : (size_t)(BK * 2);
    const size_t hstep = (size_t)HALF * K * 2;
    const size_t tstep = 2 * hstep;
    const unsigned ldsw = (unsigned)wid * 2048u;
    const int aoff = lds_byte(wr * 64 + fr, fq * 8), boff = lds_byte(wc * 32 + fr, fq * 8);
#define PG8_SA(b, h) (((b) * 2 + (h)) * HTB)
#define PG8_SB(b, h) ((4 + (b) * 2 + (h)) * HTB)
#define PG8_STAGE(bufoff, gbase, voff) do { const char* gb_ = (const char*)(gbase); asm volatile("" : "+s"(gb_)); _Pragma("unroll") for (int _i = 0; _i < 2; ++_i) { asm volatile("" : "+v"((voff)[_i])); \
        __builtin_amdgcn_global_load_lds((const unsigned*)(gb_ + (voff)[_i]), (PG8_LAS unsigned*)(lds + (bufoff) + ldsw + _i * 1024), 16, 0, 0); } } while (0)
#define PG8_LDA(dst, b, h) do { _Pragma("unroll") for (int m = 0; m < 4; ++m) _Pragma("unroll") for (int k = 0; k < 2; ++k) dst[m][k] = *(const PG8_LAS bf16x8*)(lds + PG8_SA(b, h) + aoff + m * 2048 + k * 1024); } while (0)
#define PG8_LDB(dst, b, h) do { _Pragma("unroll") for (int n = 0; n < 2; ++n) _Pragma("unroll") for (int k = 0; k < 2; ++k) dst[n][k] = *(const PG8_LAS bf16x8*)(lds + PG8_SB(b, h) + boff + n * 2048 + k * 1024); } while (0)
#define PG8_PRIO_IN(v) ((void)0)
#define PG8_PRIO_BLK(v) __builtin_amdgcn_s_setprio(v)
#define PG8_MMA(ai, bj, At, Bt) do { PG8_PRIO_IN(1); _Pragma("unroll") for (int k = 0; k < 2; ++k) _Pragma("unroll") for (int m = 0; m < 4; ++m) _Pragma("unroll") for (int nn = 0; nn < 2; ++nn) { const int n = (m & 1) ? 1 - nn : nn; \
        acc[ai][bj][m][n] = __builtin_amdgcn_mfma_f32_16x16x32_bf16(Bt[n][k], At[m][k], acc[ai][bj][m][n], 0, 0, 0); } PG8_PRIO_IN(0); } while (0)
#define PG8_MMA0(ai, bj, At, Bt) do { PG8_PRIO_IN(1); _Pragma("unroll") for (int k = 0; k < 2; ++k) _Pragma("unroll") for (int m = 0; m < 4; ++m) _Pragma("unroll") for (int nn = 0; nn < 2; ++nn) { const int n = (m & 1) ? 1 - nn : nn; \
        acc[ai][bj][m][n] = __builtin_amdgcn_mfma_f32_16x16x32_bf16(Bt[n][k], At[m][k], (k == 0) ? (f32x4){0.f, 0.f, 0.f, 0.f} : acc[ai][bj][m][n], 0, 0, 0); } PG8_PRIO_IN(0); } while (0)
#define PG8_WAIT_V(n) asm volatile("s_waitcnt vmcnt(" #n ")" ::: "memory")
#define PG8_WAIT_L(n) asm volatile("s_waitcnt lgkmcnt(" #n ")" ::: "memory")
#define PG8_BAR __builtin_amdgcn_s_barrier()
#define PG8_SCHED __builtin_amdgcn_sched_barrier(0)
    Unit cur, nxt; int ui = 0;
    if (!S.next(0, cur)) return;
    f32x4 acc[2][2][4][2];
    if constexpr (!SP2) {
#pragma unroll
    for (int a = 0; a < 2; ++a)
#pragma unroll
        for (int b = 0; b < 2; ++b)
#pragma unroll
            for (int m = 0; m < 4; ++m)
#pragma unroll
                for (int n = 0; n < 2; ++n) acc[a][b][m][n] = (f32x4){0.f, 0.f, 0.f, 0.f};
    }
    bf16x8 At[4][2], B0[2][2], B1[2][2];
    const char* cA = (const char*)g.A + (size_t)cur.pm * tstep; const char* cB = (const char*)g.Bt + (size_t)cur.pn * tstep;
    S.a_ready(cur);
    if constexpr (SP2) {
        PG8_STAGE(PG8_SB(0, 0), cB, voffB); PG8_STAGE(PG8_SB(0, 1), cB + hstep, voffB); PG8_STAGE(PG8_SA(0, 0), cA, voffA); PG8_STAGE(PG8_SA(0, 1), cA + hstep, voffA);
        if (wr == 1) PG8_BAR;
        PG8_WAIT_V(2); PG8_BAR;
        PG8_STAGE(PG8_SB(1, 0), cB + kstepB, voffB); PG8_STAGE(PG8_SA(1, 0), cA + kstep, voffA); PG8_STAGE(PG8_SB(1, 1), cB + hstep + kstepB, voffB);
        PG8_WAIT_V(6); PG8_BAR;
    } else {
        PG8_STAGE(PG8_SB(0, 0), cB, voffB); PG8_STAGE(PG8_SA(0, 0), cA, voffA); PG8_STAGE(PG8_SB(0, 1), cB + hstep, voffB); PG8_STAGE(PG8_SA(0, 1), cA + hstep, voffA);
        if (wr == 1) PG8_BAR;
        PG8_WAIT_V(4); PG8_BAR;
        PG8_STAGE(PG8_SB(1, 0), cB + kstepB, voffB); PG8_STAGE(PG8_SA(1, 0), cA + kstep, voffA); PG8_STAGE(PG8_SB(1, 1), cB + hstep + kstepB, voffB);
        PG8_WAIT_V(6); PG8_BAR;
    }
    for (;;) {
        const bool has_next = S.next(ui + 1, nxt);
        const char* nA = has_next ? (const char*)g.A + (size_t)nxt.pm * tstep : cA; const char* nB = has_next ? (const char*)g.Bt + (size_t)nxt.pn * tstep : cB;
#define PG8_PTRS() const bool last = (t == nt - 2); \
            const char* a1 = cA + (size_t)(t + 1) * kstep; \
            const char* a2 = last ? nA : cA + (size_t)(t + 2) * kstep; const char* b2 = last ? nB : cB + (size_t)(t + 2) * kstepB; \
            const char* a3 = a2 + kstep; const char* b3 = b2 + kstepB; \
            if (last && has_next) S.a_ready(nxt)
#define PG8_SP2_PAIR(MF) do { PG8_PTRS(); \
            PG8_LDB(B0, 0, 0); PG8_LDB(B1, 0, 1); PG8_SCHED; PG8_LDA(At, 0, 0); PG8_STAGE(PG8_SA(1, 1), a1 + hstep, voffA); \
            PG8_WAIT_V(8); PG8_WAIT_L(0); PG8_BAR; PG8_PRIO_BLK(1); MF(0, 0, At, B0); MF(0, 1, At, B1); PG8_PRIO_BLK(0); PG8_BAR; PG8_SCHED; \
            PG8_LDA(At, 0, 1); PG8_STAGE(PG8_SB(0, 0), b2, voffB); PG8_STAGE(PG8_SB(0, 1), b2 + hstep, voffB); PG8_STAGE(PG8_SA(0, 0), a2, voffA); \
            PG8_WAIT_V(8); PG8_WAIT_L(0); PG8_BAR; PG8_PRIO_BLK(1); MF(1, 0, At, B0); MF(1, 1, At, B1); PG8_PRIO_BLK(0); PG8_BAR; PG8_SCHED; \
            PG8_LDB(B0, 1, 0); PG8_LDB(B1, 1, 1); PG8_SCHED; PG8_LDA(At, 1, 0); PG8_STAGE(PG8_SA(0, 1), a2 + hstep, voffA); \
            PG8_WAIT_V(8); PG8_WAIT_L(0); PG8_BAR; PG8_PRIO_BLK(1); PG8_MMA(0, 0, At, B0); PG8_MMA(0, 1, At, B1); PG8_PRIO_BLK(0); PG8_BAR; PG8_SCHED; \
            PG8_LDA(At, 1, 1); PG8_STAGE(PG8_SB(1, 0), b3, voffB); PG8_STAGE(PG8_SB(1, 1), b3 + hstep, voffB); PG8_STAGE(PG8_SA(1, 0), a3, voffA); \
            PG8_WAIT_V(8); PG8_WAIT_L(0); PG8_BAR; PG8_PRIO_BLK(1); PG8_MMA(1, 0, At, B0); PG8_MMA(1, 1, At, B1); PG8_PRIO_BLK(0); PG8_BAR; PG8_SCHED; } while (0)
        if constexpr (SP2) {
            { const int t = 0; PG8_SP2_PAIR(PG8_MMA0); }
            for (int t = 2; t < nt; t += 2) PG8_SP2_PAIR(PG8_MMA);
        } else {
        for (int t = 0; t < nt; t += 2) {
            PG8_PTRS();
            {
            PG8_LDB(B0, 0, 0); PG8_SCHED; PG8_LDA(At, 0, 0); PG8_STAGE(PG8_SA(1, 1), a1 + hstep, voffA);
            PG8_WAIT_L(8); PG8_BAR; PG8_WAIT_L(0); PG8_MMA(0, 0, At, B0); PG8_BAR; PG8_SCHED;
            PG8_LDB(B1, 0, 1); PG8_STAGE(PG8_SB(0, 0), b2, voffB);
            PG8_BAR; PG8_WAIT_L(0); PG8_MMA(0, 1, At, B1); PG8_BAR;
            PG8_LDA(At, 0, 1); PG8_STAGE(PG8_SA(0, 0), a2, voffA);
            PG8_BAR; PG8_WAIT_L(0); PG8_MMA(1, 0, At, B0); PG8_BAR; PG8_SCHED;
            PG8_STAGE(PG8_SB(0, 1), b2 + hstep, voffB);
            PG8_WAIT_V(6); PG8_BAR; PG8_MMA(1, 1, At, B1); PG8_BAR;
            PG8_LDB(B0, 1, 0); PG8_SCHED; PG8_LDA(At, 1, 0); PG8_STAGE(PG8_SA(0, 1), a2 + hstep, voffA);
            PG8_WAIT_L(8); PG8_BAR; PG8_WAIT_L(0); PG8_MMA(0, 0, At, B0); PG8_BAR; PG8_SCHED;
            PG8_LDB(B1, 1, 1); PG8_STAGE(PG8_SB(1, 0), b3, voffB);
            PG8_BAR; PG8_WAIT_L(0); PG8_MMA(0, 1, At, B1); PG8_BAR;
            PG8_LDA(At, 1, 1); PG8_STAGE(PG8_SA(1, 0), a3, voffA);
            PG8_BAR; PG8_WAIT_L(0); PG8_MMA(1, 0, At, B0); PG8_BAR; PG8_SCHED;
            PG8_STAGE(PG8_SB(1, 1), b3 + hstep, voffB);
            PG8_WAIT_V(6); PG8_BAR; PG8_MMA(1, 1, At, B1); PG8_BAR;
            }
        }
        }
        if constexpr (ALIGN_EPI) { if (wr == 0) PG8_BAR; }
        if constexpr (!Epi::AFTER_DRAIN) { E(acc, cur, wr, wc, fr, fq); if (EPI_TWICE) { asm volatile("" ::: "memory"); E(acc, cur, wr, wc, fr, fq); } S.done(cur); }
        if (!has_next) break;
        if constexpr (!SP2) {
#pragma unroll
        for (int a = 0; a < 2; ++a)
#pragma unroll
            for (int b = 0; b < 2; ++b)
#pragma unroll
                for (int m = 0; m < 4; ++m)
#pragma unroll
                    for (int n = 0; n < 2; ++n) acc[a][b][m][n] = (f32x4){0.f, 0.f, 0.f, 0.f};
        }
        cur = nxt; cA = nA; cB = nB; ++ui;
        if constexpr (ALIGN_EPI) { if (wr == 1) PG8_BAR; }
    }
    PG8_WAIT_V(0);
    if constexpr (!ALIGN_EPI) { if (wr == 0) PG8_BAR; }
    PG8_BAR;
}

template <class Epi, bool B_TILED = false, bool A_TILED = false>
__device__ __forceinline__ void gemm_half_units(PG8_LAS unsigned char* lds, const Gemm g, int pn0, int npn, const Epi& E, int bx, int nwg) {
    int tid_ = threadIdx.x; asm volatile("" : "+v"(tid_));
    const int tid = tid_, wid = __builtin_amdgcn_readfirstlane(tid >> 6), lane = tid & 63, wr = wid >> 2, wc = wid & 3, fr = lane & 15, fq = lane >> 4;
    const int K = g.K, nt = K / BK;
    unsigned voffA[2], voffB[2];
#pragma unroll
    for (int i = 0; i < 2; ++i) { int R, C; stage_rc(wid * 2048 + lane * 16 + i * 1024, R, C); const int Rb = Epi::PERM ? ((R & ~31) + perm32(R & 31)) : R;
        voffA[i] = A_TILED ? (unsigned)(wid * 2048 + lane * 16 + i * 1024) : (unsigned)(R * K + C) * 2u; voffB[i] = B_TILED ? (unsigned)(wid * 2048 + lane * 16 + i * 1024) : (unsigned)(Rb * K + C) * 2u; }
    const size_t kstep = A_TILED ? (size_t)HTB : (size_t)(BK * 2), kstepB = B_TILED ? (size_t)HTB : (size_t)(BK * 2);
    const size_t hstep = (size_t)HALF * K * 2;
    const size_t tstep = 2 * hstep;
    const unsigned ldsw = (unsigned)wid * 2048u;
    const int aoff = lds_byte(wr * 64 + fr, fq * 8), boff = lds_byte(wc * 32 + fr, fq * 8);
    const int nunits = (g.M / HALF) * npn;
    for (int v = bx; v < nunits; v += nwg) {
        const int xcd = v & 7, j = v >> 3, pn = pn0 + j % npn, pmh = (j / npn) * NXCD + xcd;
        f32x4 acc[2][2][4][2];
#pragma unroll
        for (int b = 0; b < 2; ++b)
#pragma unroll
            for (int m = 0; m < 4; ++m)
#pragma unroll
                for (int n = 0; n < 2; ++n) acc[0][b][m][n] = (f32x4){0.f, 0.f, 0.f, 0.f};
        bf16x8 At[4][2], B0[2][2], B1[2][2];
        const char* cA = (const char*)g.A + (size_t)pmh * hstep; const char* cB = (const char*)g.Bt + (size_t)pn * tstep;
        PG8_STAGE(PG8_SB(0, 0), cB, voffB); PG8_STAGE(PG8_SB(0, 1), cB + hstep, voffB); PG8_STAGE(PG8_SA(0, 0), cA, voffA);
        PG8_STAGE(PG8_SB(1, 0), cB + kstepB, voffB); PG8_STAGE(PG8_SB(1, 1), cB + hstep + kstepB, voffB); PG8_STAGE(PG8_SA(1, 0), cA + kstep, voffA);
        PG8_WAIT_V(6); PG8_BAR;
        for (int t = 0; t < nt; t += 2) {
            const int t2 = (t + 2 < nt) ? t + 2 : t;
            const size_t o2 = (size_t)t2 * kstep, o3 = o2 + kstep, p2 = (size_t)t2 * kstepB, p3 = p2 + kstepB;
            PG8_LDB(B0, 0, 0); PG8_LDB(B1, 0, 1); PG8_LDA(At, 0, 0); PG8_WAIT_L(0); PG8_BAR;
            PG8_STAGE(PG8_SB(0, 0), cB + p2, voffB); PG8_STAGE(PG8_SB(0, 1), cB + hstep + p2, voffB); PG8_STAGE(PG8_SA(0, 0), cA + o2, voffA);
            PG8_PRIO_BLK(1); PG8_MMA(0, 0, At, B0); PG8_MMA(0, 1, At, B1); PG8_PRIO_BLK(0);
            PG8_WAIT_V(6); PG8_BAR; PG8_SCHED;
            PG8_LDB(B0, 1, 0); PG8_LDB(B1, 1, 1); PG8_LDA(At, 1, 0); PG8_WAIT_L(0); PG8_BAR;
            PG8_STAGE(PG8_SB(1, 0), cB + p3, voffB); PG8_STAGE(PG8_SB(1, 1), cB + hstep + p3, voffB); PG8_STAGE(PG8_SA(1, 0), cA + o3, voffA);
            PG8_PRIO_BLK(1); PG8_MMA(0, 0, At, B0); PG8_MMA(0, 1, At, B1); PG8_PRIO_BLK(0);
            PG8_WAIT_V(6); PG8_BAR; PG8_SCHED;
        }
        PG8_WAIT_V(0); PG8_BAR;
        E.half(acc, pmh, pn, wr, wc, fr, fq);
    }
    PG8_WAIT_V(0); PG8_BAR;
#undef PG8_SA
#undef PG8_SB
#undef PG8_STAGE
#undef PG8_LDA
#undef PG8_LDB
#undef PG8_MMA
#undef PG8_PRIO_IN
#undef PG8_PRIO_BLK
#undef PG8_MMA0
#undef PG8_PTRS
#undef PG8_SP2_PAIR
#undef PG8_WAIT_V
#undef PG8_WAIT_L
#undef PG8_BAR
#undef PG8_SCHED
}
}

constexpr int NWAVES = 8;
constexpr int DM = 4096, BATCH = 4, SEQ = 4096, MROWS = BATCH * SEQ;
constexpr int FF = 11008, HGW = 2048, NAW = 2048, HD = 128, NHEAD = 16;
constexpr int PROJ_W = 12288;
constexpr int C_Q = 0, C_GF = 2048, C_GB = 4096, C_GATE = 6144, C_NQ = 8192, C_NK = 10240;
constexpr int GRID_W = 64, NROWS = 64, WIN_R = 8, WIN_C = 16;
constexpr float EPS = 1e-6f;
constexpr int N_PHASES = 12;
constexpr int GU_MAIN_N = 84 * 256;
static_assert(GU_MAIN_N % 256 == 0 && (2 * FF - GU_MAIN_N) % 256 == 0 && GU_MAIN_N <= 2 * FF, "gate/up split");

constexpr size_t MiB = 1u << 20;
constexpr size_t WS_CTL = 0, CTL_ZERO_BYTES = 64 * 1024;
constexpr size_t WS_LB = 1 * MiB;
constexpr size_t WS_WGU1 = 2 * MiB, WS_WD1 = 174 * MiB, WS_WIN = 260 * MiB, WS_WOUT = 388 * MiB, WS_WGU2 = 420 * MiB, WS_WD2 = 592 * MiB;
constexpr size_t WS_R1 = 678 * MiB;
constexpr size_t WS_TT = WS_R1 + 384 * MiB;
constexpr size_t WS_R2 = 1190 * MiB;
constexpr size_t WS_R3 = 1446 * MiB;
constexpr size_t WS_END = 1574 * MiB;
static_assert((size_t)2 * FF * DM * 2 <= 172 * MiB && (size_t)FF * DM * 2 <= 86 * MiB, "weights");
static_assert((size_t)MROWS * PROJ_W * 2 == 384 * MiB && (size_t)MROWS * FF * 2 <= 512 * MiB, "R1");
constexpr int CW_TMO = 0, CW_CODE = 1;
constexpr int CW_BAR = 4096;
constexpr int CW_QUEUE = 8192;

constexpr int RING_OFF = 0, RING_BYTES = 131072;
constexpr int LDSCTL_OFF = RING_BYTES, MISC_OFF = LDSCTL_OFF + 320;
constexpr int LDS_BYTES = 147456;

#define GAS __attribute__((address_space(1)))
#define LAS __attribute__((address_space(3)))
typedef unsigned short bf16;
typedef unsigned v4u __attribute__((ext_vector_type(4)));
typedef unsigned v2u __attribute__((ext_vector_type(2)));
typedef float f32x4 __attribute__((ext_vector_type(4)));
typedef GAS unsigned gu32;
#define RLX_AGENT __ATOMIC_RELAXED, __HIP_MEMORY_SCOPE_AGENT
#define LDS_WAIT() asm volatile("s_waitcnt lgkmcnt(0)" ::: "memory")
#define VM_WAIT() asm volatile("s_waitcnt vmcnt(0)" ::: "memory")
__device__ __forceinline__ unsigned f2bf(float f) { unsigned u = __builtin_bit_cast(unsigned, f); return (u + 0x7fffu + ((u >> 16) & 1u)) >> 16; }
__device__ __forceinline__ unsigned pk2(float lo, float hi) { return f2bf(lo) | (f2bf(hi) << 16); }
__device__ __forceinline__ float bf2f(unsigned short b) { return __builtin_bit_cast(float, (unsigned)b << 16); }
__device__ __forceinline__ float bflo(unsigned w) { return __builtin_bit_cast(float, w << 16); }
__device__ __forceinline__ float bfhi(unsigned w) { return __builtin_bit_cast(float, w & 0xffff0000u); }
__device__ __forceinline__ float h2f(unsigned short b) { return (float)__builtin_bit_cast(_Float16, b); }

#define XB_TMO      128
#define XB_XCNT(j)  (256  + 64 * (j))
#define XB_XSUB(j)  (1280 + 64 * (j))
#define XB_XGEN(j)  (2304 + 64 * (j))
#define XB_TOP      3328
#define XB_TOPGEN   3392
#define XCD_BAR_WORDS 3456
#define XB_SPIN_CAP (1u << 18)
__device__ __forceinline__ unsigned xb_ld(unsigned* p)              { return __hip_atomic_load(p, __ATOMIC_RELAXED, __HIP_MEMORY_SCOPE_AGENT); }
__device__ __forceinline__ unsigned xb_add(unsigned* p, unsigned v) { return __hip_atomic_fetch_add(p, v, __ATOMIC_RELAXED, __HIP_MEMORY_SCOPE_AGENT); }
__device__ __forceinline__ unsigned xb_xcc_id() { return (unsigned)__builtin_amdgcn_s_getreg((3 << 11) | 20) & 0xFu; }
#define XB_SPIN(cond, bar) do { unsigned _sp = 0; while (cond) { __builtin_amdgcn_s_sleep(1); \
    if ((++_sp & 255u) == 0u) { if (xb_ld(&(bar)[XB_TMO])) break; if (_sp > XB_SPIN_CAP) { atomicAdd(&(bar)[XB_TMO], 1u); break; } } } } while (0)
struct XcdBarrier { unsigned* bar; unsigned x; volatile LAS unsigned* st; };
__device__ __forceinline__ XcdBarrier xcd_barrier_post(unsigned* bar, volatile LAS unsigned* st) {
    XcdBarrier b; b.bar = bar; b.x = xb_xcc_id(); b.st = st;
    if (threadIdx.x == 0) (void)xb_add(&bar[XB_XCNT(b.x)], 1u);
    return b;
}
__device__ __forceinline__ void xcd_barrier_complete(unsigned* bar, unsigned x, unsigned& nloc, unsigned& nx) {
    const unsigned G = gridDim.x * gridDim.y * gridDim.z;
    unsigned sum, cnt, mine, sp = 0u;
    for (;;) {
        sum = 0u; cnt = 0u; mine = 0u;
#pragma unroll
        for (unsigned j = 0; j < 16; ++j) { const unsigned c = xb_ld(&bar[XB_XCNT(j)]); sum += c; cnt += (c > 0u) ? 1u : 0u; mine = (j == x) ? c : mine; }
        if (sum == G) break;
        __builtin_amdgcn_s_sleep(1);
        if ((++sp & 255u) == 0u) { if (xb_ld(&bar[XB_TMO])) break; if (sp > XB_SPIN_CAP) { atomicAdd(&bar[XB_TMO], 1u); break; } }
    }
    nloc = mine > 0u ? mine : 1u; nx = cnt > 0u ? cnt : 1u;
}
__device__ __forceinline__ void xcd_barrier(const XcdBarrier& b) {
    asm volatile("s_waitcnt vmcnt(0)" ::: "memory");
    __syncthreads();
    if (threadIdx.x == 0) {
        unsigned* bar = b.bar;
        __builtin_amdgcn_s_waitcnt(0);
        unsigned nloc = b.st[0], nx = b.st[1];
        if (nloc == 0u) { xcd_barrier_complete(bar, b.x, nloc, nx); b.st[0] = nloc; b.st[1] = nx; }
        const unsigned old = xb_add(&bar[XB_XSUB(b.x)], 1u);
        const unsigned gen = old / nloc;
        if (old + 1u == (gen + 1u) * nloc) {
            __builtin_amdgcn_fence(__ATOMIC_RELEASE, "agent");
            asm volatile("s_waitcnt vmcnt(0)" ::: "memory");
            const unsigned og = xb_add(&bar[XB_TOP], 1u);
            const unsigned tg = og / nx;
            if (og + 1u == (tg + 1u) * nx) xb_add(&bar[XB_TOPGEN], 1u);
            else XB_SPIN(xb_ld(&bar[XB_TOPGEN]) == tg, bar);
            __builtin_amdgcn_fence(__ATOMIC_ACQUIRE, "agent");
            xb_add(&bar[XB_XGEN(b.x)], 1u);
            asm volatile("s_waitcnt vmcnt(0)" ::: "memory");
        } else {
            XB_SPIN(xb_ld(&bar[XB_XGEN(b.x)]) == gen, bar);
            __builtin_amdgcn_fence(__ATOMIC_ACQUIRE, "agent");
            asm volatile("s_waitcnt vmcnt(0)" ::: "memory");
        }
    }
    __syncthreads();
}

__device__ __forceinline__ float wave_sum(float v) {
#pragma unroll
    for (int o = 1; o < 64; o <<= 1) v += __shfl_xor(v, o);
    return v;
}
__device__ __forceinline__ float wave_max(float v) {
#pragma unroll
    for (int o = 1; o < 64; o <<= 1) v = fmaxf(v, __shfl_xor(v, o));
    return v;
}
__device__ __forceinline__ void transpose_item(const float* W, int K, int N, bf16* WT, int mode, LAS float* scr, int item, int lane, const float* gain, int tiled_rows, float wscale) {
    const int nblk = N / 32, kb = item / nblk, nb = item % nblk, k0 = 64 * kb, n0 = 32 * nb;
    const int rbase = (mode == 0) ? n0 : (mode == 3) ? (((0x75436210u >> (4 * (n0 >> 11))) & 7u) * 2048 + (n0 & 2047)) : (256 * (n0 >> 7) + (n0 & 127) + (mode == 2 ? 128 : 0));
    const int c = lane & 7;
    f32x4 ga = (f32x4){1.f, 1.f, 1.f, 1.f}, gb = ga;
    if (gain) { ga = *(const GAS f32x4*)(gain + k0 + 8 * c); gb = *(const GAS f32x4*)(gain + k0 + 8 * c + 4); }
#pragma unroll 8
    for (int i = 0; i < 32; ++i) { const int kk = 2 * i + (lane >> 5); scr[kk * 33 + (lane & 31)] = W[(size_t)(k0 + kk) * N + n0 + (lane & 31)]; }
    LDS_WAIT(); asm volatile("" ::: "memory");
    ga = ga * wscale; gb = gb * wscale;
#pragma unroll
    for (int j = 0; j < 4; ++j) { const int n = (lane >> 3) + 8 * j; const LAS float* s = scr + (8 * c) * 33 + n;
        v4u o; o.x = pk2(s[0 * 33] * ga.x, s[1 * 33] * ga.y); o.y = pk2(s[2 * 33] * ga.z, s[3 * 33] * ga.w); o.z = pk2(s[4 * 33] * gb.x, s[5 * 33] * gb.y); o.w = pk2(s[6 * 33] * gb.z, s[7 * 33] * gb.w);
        const int r = rbase + n;
        size_t ob;
        if (r < tiled_rows) { const int rr = r & 127, x = rr & 31, R = (rr & ~31) + 16 * ((x >> 2) & 1) + 4 * (x >> 3) + (x & 3);
            ob = ((size_t)(r >> 7) * (size_t)(K >> 6) + (size_t)(k0 >> 6)) * 16384u + (size_t)pg8::lds_byte(R, 8 * c); }
        else ob = ((size_t)r * K + k0 + 8 * c) * 2;
        *(GAS v4u*)((GAS unsigned char*)WT + ob) = o; }
    LDS_WAIT(); asm volatile("" ::: "memory");
}
__device__ __forceinline__ size_t tiled_off(int m, int k, int ktiles) { return ((size_t)(m >> 7) * (size_t)ktiles + (size_t)(k >> 6)) * 16384u + (size_t)pg8::lds_byte(m & 127, k & 63); }
__device__ __forceinline__ void rms_rowpair_to_bf16_tiled(const float* x, bf16* obase, int m0, int lane) {
    const int li = lane & 31, m = m0 + (lane >> 5);
    const GAS f32x4* xr = (const GAS f32x4*)(x + (size_t)m * DM) + li;
    f32x4 v[32]; float ss = 0.f;
#pragma unroll
    for (int j = 0; j < 32; ++j) v[j] = xr[32 * j];
#pragma unroll
    for (int j = 0; j < 32; ++j) ss += (v[j].x * v[j].x + v[j].y * v[j].y) + (v[j].z * v[j].z + v[j].w * v[j].w);
#pragma unroll
    for (int o = 1; o < 32; o <<= 1) ss += __shfl_xor(ss, o);
    const float rs = 1.0f / sqrtf(ss * (1.0f / DM) + EPS);
    GAS unsigned char* o8 = (GAS unsigned char*)obase + tiled_off(m, 4 * li, DM / 64);
#pragma unroll
    for (int j = 0; j < 32; ++j) { const f32x4 a = v[j]; v2u w; w.x = pk2(a.x * rs, a.y * rs); w.y = pk2(a.z * rs, a.w * rs); *(GAS v2u*)(o8 + (size_t)j * 32768u) = w; }
}
__device__ __forceinline__ void rms_row_to_bf16(const float* xrow, const float* gain, bf16* orow, int lane) {
    const GAS f32x4* xr = (const GAS f32x4*)xrow + lane; const GAS f32x4* gr = (const GAS f32x4*)gain + lane;
    f32x4 v[16], gg[16]; float ss = 0.f;
#pragma unroll
    for (int j = 0; j < 16; ++j) { v[j] = xr[64 * j]; gg[j] = gr[64 * j]; }
#pragma unroll
    for (int j = 0; j < 16; ++j) ss += (v[j].x * v[j].x + v[j].y * v[j].y) + (v[j].z * v[j].z + v[j].w * v[j].w);
    const float rs = 1.0f / sqrtf(wave_sum(ss) * (1.0f / DM) + EPS);
    GAS v2u* o8 = (GAS v2u*)orow + lane;
#pragma unroll
    for (int j = 0; j < 16; ++j) { const f32x4 g = gg[j]; v2u w; w.x = pk2(v[j].x * rs * g.x, v[j].y * rs * g.y); w.y = pk2(v[j].z * rs * g.z, v[j].w * rs * g.w); o8[64 * j] = w; }
}
template <bool BASE_TILED, bool OUT_TILED>
__device__ __forceinline__ void norm_res_rowpair(const bf16* ffbuf, const bf16* basebuf, void* outbuf, float w, const LAS float* gl, float* rsout, const float* bscale, int m0, int lane) {
    const int li = lane & 31, m = m0 + (lane >> 5);
    const unsigned toff = (unsigned)tiled_off(m, 4 * li, DM / 64), roff2 = (unsigned)((size_t)m * DM * 2 + (size_t)li * 8), roff4 = (unsigned)((size_t)m * DM * 4 + (size_t)li * 16);
    v2u f[32], b[32];
    { unsigned o_ = roff2; asm volatile("" : "+v"(o_));
#pragma unroll
      for (int j = 0; j < 32; ++j) f[j] = *(const GAS v2u*)((const GAS unsigned char*)ffbuf + (size_t)j * 256u + o_); }
    { unsigned o_ = BASE_TILED ? toff : roff2; asm volatile("" : "+v"(o_));
#pragma unroll
      for (int j = 0; j < 32; ++j) b[j] = *(const GAS v2u*)((const GAS unsigned char*)basebuf + (size_t)j * (BASE_TILED ? 32768u : 256u) + o_); }
    const float bs = bscale ? 1.0f / bscale[m] : 1.0f;
    float ss = 0.f;
#pragma unroll
    for (int j = 0; j < 32; ++j) { const float a0 = bflo(f[j].x), a1 = bfhi(f[j].x), a2 = bflo(f[j].y), a3 = bfhi(f[j].y); ss += (a0 * a0 + a1 * a1) + (a2 * a2 + a3 * a3); }
#pragma unroll
    for (int o = 1; o < 32; o <<= 1) ss += __shfl_xor(ss, o);
    const float rs = w / sqrtf(ss * (1.0f / DM) + EPS);
    const LAS unsigned char* gl_ = (const LAS unsigned char*)gl + li * 16;
#define NRP_H(j) const f32x4 g = *(const LAS f32x4*)(gl_ + (j) * 512); \
        asm volatile("" : "+v"(f[j].x), "+v"(f[j].y), "+v"(b[j].x), "+v"(b[j].y));       \
        f32x4 h; h.x = bflo(b[j].x) * bs + bflo(f[j].x) * rs * g.x; h.y = bfhi(b[j].x) * bs + bfhi(f[j].x) * rs * g.y; h.z = bflo(b[j].y) * bs + bflo(f[j].y) * rs * g.z; h.w = bfhi(b[j].y) * bs + bfhi(f[j].y) * rs * g.w
    if constexpr (OUT_TILED) {
        float s2 = 0.f;
#pragma unroll
        for (int j = 0; j < 32; ++j) { NRP_H(j); s2 += (h.x * h.x + h.y * h.y) + (h.z * h.z + h.w * h.w); if ((j & 3) == 3) asm volatile("" ::: "memory"); }
#pragma unroll
        for (int o = 1; o < 32; o <<= 1) s2 += __shfl_xor(s2, o);
        const float r2 = 1.0f / sqrtf(s2 * (1.0f / DM) + EPS);
        if (li == 0) rsout[m] = r2;
        unsigned o_ = toff; asm volatile("" : "+v"(o_));
#pragma unroll
        for (int j = 0; j < 32; ++j) { NRP_H(j); v2u o; o.x = pk2(h.x * r2, h.y * r2); o.y = pk2(h.z * r2, h.w * r2); *(GAS v2u*)((GAS unsigned char*)outbuf + (size_t)j * 32768u + o_) = o;
            if ((j & 3) == 3) asm volatile("" ::: "memory"); }
    } else {
        unsigned o_ = roff4; asm volatile("" : "+v"(o_));
#pragma unroll
        for (int j = 0; j < 32; ++j) { NRP_H(j); *(GAS f32x4*)((GAS unsigned char*)outbuf + (size_t)j * 512u + o_) = h; if ((j & 3) == 3) asm volatile("" ::: "memory"); }
    }
#undef NRP_H
}
template <bool BASE_BF16, bool OUT_BF16>
__device__ __forceinline__ void norm_res_row(const bf16* ffrow, const void* baserow, void* hrow, float w, const float* gpost, float* rsrow, int lane) {
    const GAS v2u* fr = (const GAS v2u*)ffrow + lane; const GAS f32x4* gp = (const GAS f32x4*)gpost + lane;
    f32x4 v[16]; float ss = 0.f;
    v2u rb16[16]; f32x4 rb32[BASE_BF16 ? 1 : 16];
#pragma unroll
    for (int j = 0; j < 16; ++j) { if (BASE_BF16) rb16[j] = ((const GAS v2u*)baserow + lane)[64 * j]; else rb32[j] = ((const GAS f32x4*)baserow + lane)[64 * j]; }
#pragma unroll
    for (int j = 0; j < 16; ++j) { const v2u r = fr[64 * j]; v[j] = (f32x4){bflo(r.x), bfhi(r.x), bflo(r.y), bfhi(r.y)}; ss += (v[j].x * v[j].x + v[j].y * v[j].y) + (v[j].z * v[j].z + v[j].w * v[j].w); }
    const float rs = w / sqrtf(wave_sum(ss) * (1.0f / DM) + EPS);
    float s2 = 0.f;
#pragma unroll
    for (int j = 0; j < 16; ++j) { const f32x4 g = gp[64 * j]; f32x4 b;
        if (BASE_BF16) { const v2u r = rb16[j]; b = (f32x4){bflo(r.x), bfhi(r.x), bflo(r.y), bfhi(r.y)}; } else b = rb32[j];
        v[j] = b + v[j] * rs * g;
        if (OUT_BF16 && !rsrow) { v2u o; o.x = pk2(v[j].x, v[j].y); o.y = pk2(v[j].z, v[j].w); ((GAS v2u*)hrow + lane)[64 * j] = o; } else if (!OUT_BF16) ((GAS f32x4*)hrow + lane)[64 * j] = v[j];
        s2 += (v[j].x * v[j].x + v[j].y * v[j].y) + (v[j].z * v[j].z + v[j].w * v[j].w); }
    if (rsrow) {
        const float r2 = 1.0f / sqrtf(wave_sum(s2) * (1.0f / DM) + EPS);
        if (lane == 0) *rsrow = r2;
        if (OUT_BF16) {
#pragma unroll
            for (int j = 0; j < 16; ++j) { v2u o; o.x = pk2(v[j].x * r2, v[j].y * r2); o.y = pk2(v[j].z * r2, v[j].w * r2); ((GAS v2u*)hrow + lane)[64 * j] = o; } }
    }
}

constexpr int HG_QB = 0, HG_KT = 8704, HG_KTT = 17408, HG_SC = 27648, HG_EL = 30208, HG_QT = 30720;
typedef short bf16x8 __attribute__((ext_vector_type(8)));
typedef short bf16x4 __attribute__((ext_vector_type(4)));
__device__ __forceinline__ void hgrn_mfma_unit(LAS unsigned char* lds0, const bf16* proj, const bf16* it, bf16* obuf, int b, int h, int dir, int tid) {
    const int lane = tid & 63, wave = __builtin_amdgcn_readfirstlane(tid >> 6), i16 = lane & 15, g = lane >> 4;
    const int k = 16 * wave + i16, qd = g;
    const size_t rowbase = (size_t)b * SEQ;
    const int gcol = (dir ? C_GB : C_GF) + h * HD + k, qcol = C_Q + h * HD + k;
    f32x4 S[8];
#pragma unroll
    for (int kt = 0; kt < 8; ++kt) S[kt] = (f32x4){0.f, 0.f, 0.f, 0.f};
    const GAS unsigned char* vbase = (const GAS unsigned char*)it + ((size_t)(h * HD + 16 * wave) * MROWS + rowbase) * 2;
    const GAS unsigned char* pbase = (const GAS unsigned char*)proj + rowbase * (size_t)(PROJ_W * 2);
    GAS unsigned char* obase = (GAS unsigned char*)obuf + (rowbase * (size_t)HGW + h * HD + 16 * wave) * 2;
    const unsigned lv = (unsigned)(i16 * MROWS + 8 * g) * 2u, lq = (unsigned)(8 * qd * PROJ_W + qcol) * 2u, lg = (unsigned)(8 * qd * PROJ_W + gcol) * 2u, lo_ = (unsigned)(4 * g * HGW + i16) * 2u;
    unsigned short qn[8], gn[8]; bf16x8 vn; f32x4 op[2]; op[0] = (f32x4){0.f, 0.f, 0.f, 0.f}; op[1] = op[0];
    { const int t0 = dir ? (SEQ - 32) : 0; vn = *(const GAS bf16x8*)(vbase + (size_t)t0 * 2 + lv);
#pragma unroll
      for (int j = 0; j < 8; ++j) { const GAS unsigned char* ub = pbase + (size_t)(t0 + j) * (PROJ_W * 2); qn[j] = *(const GAS unsigned short*)(ub + lq); gn[j] = *(const GAS unsigned short*)(ub + lg); } }
    for (int cc = 0; cc < SEQ / 32; ++cc) {
        LAS unsigned char* lds = lds0 + (cc & 1) * 32768;
        LAS float* EL = (LAS float*)(lds + HG_EL);
        const int t0 = dir ? (SEQ - 32 * (cc + 1)) : 32 * cc;
        const bf16x8 vfrag = vn;
        float qv[8], gv[8];
#pragma unroll
        for (int j = 0; j < 8; ++j) { qv[j] = bf2f(qn[j]); gv[j] = h2f(gn[j]); }
        if (cc > 0) { const int tp = dir ? (SEQ - 32 * cc) : 32 * (cc - 1); unsigned lo2 = lo_; asm volatile("" : "+v"(lo2));
#pragma unroll
            for (int itl = 0; itl < 2; ++itl)
#pragma unroll
                for (int e = 0; e < 4; e += 2) { const unsigned pk = pg8::cvt_pk_bf16(op[itl][e], op[itl][e + 1]); GAS unsigned char* ub = obase + (size_t)(tp + 16 * itl + e) * (HGW * 2); GAS unsigned char* ub2 = ub + HGW * 2; asm volatile("" : "+s"(ub2));
                    *(GAS unsigned short*)(ub + lo2) = (unsigned short)(pk & 0xffffu); *(GAS unsigned short*)(ub2 + lo2) = (unsigned short)(pk >> 16); } }
        asm volatile("" ::: "memory");
        if (cc + 1 < SEQ / 32) {
            unsigned lv_ = lv, lq_ = lq, lg_ = lg; asm volatile("" : "+v"(lv_), "+v"(lq_), "+v"(lg_));
            const int t1 = dir ? (SEQ - 32 * (cc + 2)) : 32 * (cc + 1); vn = *(const GAS bf16x8*)(vbase + (size_t)t1 * 2 + lv_);
#pragma unroll
            for (int j = 0; j < 8; ++j) { const GAS unsigned char* ub = pbase + (size_t)(t1 + j) * (PROJ_W * 2); qn[j] = *(const GAS unsigned short*)(ub + lq_); gn[j] = *(const GAS unsigned short*)(ub + lg_); } }
        float cs[8]; float tot = 0.f;
        if (dir == 0) {
#pragma unroll
            for (int j = 0; j < 8; ++j) { tot += gv[j]; cs[j] = tot; }
        } else {
#pragma unroll
            for (int j = 7; j >= 0; --j) { tot += gv[j]; cs[j] = tot; }
        }
        { const float t0q = __shfl(tot, i16), t1q = __shfl(tot, i16 + 16), t2q = __shfl(tot, i16 + 32), t3q = __shfl(tot, i16 + 48);
          float off;
          if (dir == 0) off = (qd > 0 ? t0q : 0.f) + (qd > 1 ? t1q : 0.f) + (qd > 2 ? t2q : 0.f);
          else          off = (qd < 3 ? t3q : 0.f) + (qd < 2 ? t2q : 0.f) + (qd < 1 ? t1q : 0.f);
          if (qd == 0) EL[k] = __builtin_amdgcn_exp2f((t0q + t1q) + (t2q + t3q));
          unsigned kt8[8];
#pragma unroll
          for (int j = 0; j < 8; ++j) { const float bb = cs[j] + off; const float kk = 1.0f - __builtin_amdgcn_exp2f(gv[j]);
              const float qb = qv[j] * __builtin_amdgcn_exp2f(bb), ktv = kk * __builtin_amdgcn_exp2f(fminf(-bb, 115.f));
              const unsigned pk = pg8::cvt_pk_bf16(qb, ktv);
              *(LAS unsigned short*)(lds + HG_QB + (8 * qd + j) * 272 + 2 * k) = (unsigned short)(pk & 0xffffu);
              *(LAS unsigned short*)(lds + HG_KT + (8 * qd + j) * 272 + 2 * k) = (unsigned short)(pk >> 16);
              kt8[j] = pk >> 16; }
          v4u w; w.x = kt8[0] | (kt8[1] << 16); w.y = kt8[2] | (kt8[3] << 16); w.z = kt8[4] | (kt8[5] << 16); w.w = kt8[6] | (kt8[7] << 16);
          *(LAS v4u*)(lds + HG_KTT + k * 80 + 16 * qd) = w; }
        __syncthreads();
        if (wave < 4) { const int ti = wave >> 1, ts = wave & 1; f32x4 a = (f32x4){0.f, 0.f, 0.f, 0.f};
#pragma unroll
            for (int ks = 0; ks < 4; ++ks) { const bf16x8 af = *(const LAS bf16x8*)(lds + HG_QB + (16 * ti + i16) * 272 + (32 * ks + 8 * g) * 2), bfr = *(const LAS bf16x8*)(lds + HG_KT + (16 * ts + i16) * 272 + (32 * ks + 8 * g) * 2);
                a = __builtin_amdgcn_mfma_f32_16x16x32_bf16(af, bfr, a, 0, 0, 0); }
            const int ss = 16 * ts + i16;
#pragma unroll
            for (int e = 0; e < 4; e += 2) { const int si = 16 * ti + 4 * g + e; const bool k0 = dir ? (ss >= si) : (ss <= si), k1 = dir ? (ss >= si + 1) : (ss <= si + 1);
                const unsigned pk = pg8::cvt_pk_bf16(k0 ? a[e] : 0.f, k1 ? a[e + 1] : 0.f);
                *(LAS unsigned short*)(lds + HG_SC + si * 80 + 2 * ss) = (unsigned short)(pk & 0xffffu); *(LAS unsigned short*)(lds + HG_SC + (si + 1) * 80 + 2 * ss) = (unsigned short)(pk >> 16); } }
        f32x4 o[2]; o[0] = (f32x4){0.f, 0.f, 0.f, 0.f}; o[1] = o[0];
#pragma unroll
        for (int s4 = 0; s4 < 4; ++s4) {
            v4u sw; sw.x = pg8::cvt_pk_bf16(S[2 * s4][0], S[2 * s4][1]); sw.y = pg8::cvt_pk_bf16(S[2 * s4][2], S[2 * s4][3]); sw.z = pg8::cvt_pk_bf16(S[2 * s4 + 1][0], S[2 * s4 + 1][1]); sw.w = pg8::cvt_pk_bf16(S[2 * s4 + 1][2], S[2 * s4 + 1][3]);
            const bf16x8 sb = __builtin_bit_cast(bf16x8, sw);
#pragma unroll
            for (int itl = 0; itl < 2; ++itl) { const LAS unsigned char* qr = lds + HG_QB + (16 * itl + i16) * 272 + (32 * s4 + 4 * g) * 2;
                const v2u lo = *(const LAS v2u*)qr, hi = *(const LAS v2u*)(qr + 32);
                v4u aw; aw.x = lo.x; aw.y = lo.y; aw.z = hi.x; aw.w = hi.y;
                o[itl] = __builtin_amdgcn_mfma_f32_16x16x32_bf16(__builtin_bit_cast(bf16x8, aw), sb, o[itl], 0, 0, 0); }
        }
        __syncthreads();
#pragma unroll
        for (int itl = 0; itl < 2; ++itl) { const bf16x8 af = *(const LAS bf16x8*)(lds + HG_SC + (16 * itl + i16) * 80 + 16 * g);
            o[itl] = __builtin_amdgcn_mfma_f32_16x16x32_bf16(af, vfrag, o[itl], 0, 0, 0); }
        op[0] = o[0]; op[1] = o[1];
#pragma unroll
        for (int kt = 0; kt < 8; ++kt) { const bf16x8 af = *(const LAS bf16x8*)(lds + HG_KTT + (16 * kt + i16) * 80 + 16 * g);
            S[kt] = __builtin_amdgcn_mfma_f32_16x16x32_bf16(af, vfrag, S[kt], 0, 0, 0);
            const f32x4 el = *(const LAS f32x4*)(EL + 16 * kt + 4 * g);
            S[kt] = S[kt] * el; }
    }
    { const int tp = dir ? 0 : (SEQ - 32);
#pragma unroll
      for (int itl = 0; itl < 2; ++itl)
#pragma unroll
          for (int e = 0; e < 4; e += 2) { const unsigned pk = pg8::cvt_pk_bf16(op[itl][e], op[itl][e + 1]); GAS unsigned char* ub = obase + (size_t)(tp + 16 * itl + e) * (HGW * 2);
              *(GAS unsigned short*)(ub + lo_) = (unsigned short)(pk & 0xffffu); *(GAS unsigned short*)(ub + HGW * 2 + lo_) = (unsigned short)(pk >> 16); } }
    __syncthreads();
}

constexpr float NA_THR = 8.0f;
__device__ __forceinline__ void na_pair_mfma(const LAS float* tbl, const bf16* proj, const bf16* vt, bf16* mix, int b, int h, int rp, int cb, int lane) {
    const int r0 = 2 * rp;
    const int cbase = (cb == 0) ? 0 : (cb == 1) ? 8 : (cb == 2) ? 24 : 32;
    const int kb = min(max(r0 - WIN_R / 2, 0), NROWS - WIN_R), rs1 = min(max(r0 + 1 - WIN_R / 2, 0), NROWS - WIN_R);
    const int i = lane & 15, g = lane >> 4;
    const int c = 16 * cb + i, cs = min(max(c - WIN_C / 2, 0), GRID_W - WIN_C);
    const size_t tok0 = (size_t)b * SEQ;
    const bf16* qp = proj + (tok0 + r0 * GRID_W + c) * PROJ_W + C_NQ + h * HD + 8 * g;
    bf16x8 qf[2][4];
#pragma unroll
    for (int q = 0; q < 2; ++q)
#pragma unroll
        for (int ks = 0; ks < 4; ++ks) qf[q][ks] = *(const GAS bf16x8*)(qp + (size_t)q * GRID_W * PROJ_W + 32 * ks);
    const int kco = 8 * (i >> 2) + (i & 3);
    const bf16* kp0 = proj + (tok0 + cbase + kco) * PROJ_W + C_NK + h * HD + 8 * g;
    const bf16* vp0 = vt + (size_t)(h * HD + i) * MROWS + tok0 + cbase + 8 * g;
    const LAS float* tb = tbl + h * (15 * 31);
    int dcol[8]; bool okc[8];
#pragma unroll
    for (int j = 0; j < 8; ++j) { const int kcol = cbase + 8 * g + j; okc[j] = (kcol >= cs) && (kcol < cs + WIN_C); dcol[j] = min(max(kcol - c + WIN_C - 1, 0), 30); }
    f32x4 acc[2][8]; float m[2], l[2];
#pragma unroll
    for (int q = 0; q < 2; ++q) { m[q] = -1.0e30f; l[q] = 0.f;
#pragma unroll
        for (int dt = 0; dt < 8; ++dt) acc[q][dt] = (f32x4){0.f, 0.f, 0.f, 0.f}; }
#pragma unroll 1
    for (int kr = 0; kr < 9; ++kr) {
        const int krow = kb + kr, lrow = min(krow, NROWS - 1);
        const bf16* kp = kp0 + (size_t)(lrow * GRID_W) * PROJ_W;
        bf16x8 kf[2][4];
#pragma unroll
        for (int t = 0; t < 2; ++t)
#pragma unroll
            for (int ks = 0; ks < 4; ++ks) kf[t][ks] = *(const GAS bf16x8*)(kp + (size_t)(4 * t) * PROJ_W + 32 * ks);
        bf16x8 vf[8];
#pragma unroll
        for (int dt = 0; dt < 8; ++dt) vf[dt] = *(const GAS bf16x8*)(vp0 + (size_t)(16 * dt) * MROWS + lrow * GRID_W);
#pragma unroll
        for (int q = 0; q < 2; ++q) {
            const int r = r0 + q, rsq = q ? rs1 : kb;
            const bool rowok = (krow >= rsq) && (krow < rsq + WIN_R);
            const int dr = min(max(krow - r + WIN_R - 1, 0), 14);
            f32x4 s0 = (f32x4){0.f, 0.f, 0.f, 0.f}, s1 = s0;
#pragma unroll
            for (int ks = 0; ks < 4; ++ks) { s0 = __builtin_amdgcn_mfma_f32_16x16x32_bf16(kf[0][ks], qf[q][ks], s0, 0, 0, 0); s1 = __builtin_amdgcn_mfma_f32_16x16x32_bf16(kf[1][ks], qf[q][ks], s1, 0, 0, 0); }
            float v[8]; float cmax = -3.0e38f;
#pragma unroll
            for (int j = 0; j < 8; ++j) { const float sv = (j < 4) ? s0[j & 3] : s1[j & 3]; v[j] = (rowok && okc[j]) ? sv + tb[dr * 31 + dcol[j]] : -3.0e38f; cmax = fmaxf(cmax, v[j]); }
            if (__any(cmax > m[q] + NA_THR)) {
                float mx = fmaxf(cmax, __shfl_xor(cmax, 16)); mx = fmaxf(mx, __shfl_xor(mx, 32));
                const float mn = fmaxf(m[q], mx); const float sc = __builtin_amdgcn_exp2f((m[q] - mn) * 1.4426950408889634f);
                l[q] *= sc;
#pragma unroll
                for (int dt = 0; dt < 8; ++dt) acc[q][dt] = acc[q][dt] * sc;
                m[q] = mn; }
            float p[8];
#pragma unroll
            for (int j = 0; j < 8; ++j) { p[j] = __builtin_amdgcn_exp2f((v[j] - m[q]) * 1.4426950408889634f); l[q] += p[j]; }
            v4u w; w.x = pg8::cvt_pk_bf16(p[0], p[1]); w.y = pg8::cvt_pk_bf16(p[2], p[3]); w.z = pg8::cvt_pk_bf16(p[4], p[5]); w.w = pg8::cvt_pk_bf16(p[6], p[7]);
            const bf16x8 pf = __builtin_bit_cast(bf16x8, w);
#pragma unroll
            for (int dt = 0; dt < 8; ++dt) acc[q][dt] = __builtin_amdgcn_mfma_f32_16x16x32_bf16(vf[dt], pf, acc[q][dt], 0, 0, 0);
        }
    }
#pragma unroll
    for (int q = 0; q < 2; ++q) { float lq = l[q]; lq += __shfl_xor(lq, 16); lq += __shfl_xor(lq, 32);
        const float inv = 1.0f / lq;
        bf16* op = mix + (tok0 + (r0 + q) * GRID_W + c) * DM + HGW + h * HD + 4 * g;
#pragma unroll
        for (int dt = 0; dt < 8; ++dt) { v2u w; w.x = pg8::cvt_pk_bf16(acc[q][dt][0] * inv, acc[q][dt][1] * inv); w.y = pg8::cvt_pk_bf16(acc[q][dt][2] * inv, acc[q][dt][3] * inv); *(GAS v2u*)(op + 16 * dt) = w; } }
}

__device__ __forceinline__ void hgrn_combine_row(const bf16* of, const bf16* ob, const bf16* gaterow, const float* hn, bf16* orow, int lane) {
    const GAS v2u* a = (const GAS v2u*)of + lane; const GAS v2u* bq = (const GAS v2u*)ob + lane; const GAS v2u* gr = (const GAS v2u*)gaterow + lane;
    const f32x4 hg = *((const GAS f32x4*)hn + (lane & 31));
    GAS v2u* o8 = (GAS v2u*)orow + lane;
    v2u ra[8], rb[8], rg[8];
#pragma unroll
    for (int j = 0; j < 8; ++j) { ra[j] = a[64 * j]; rb[j] = bq[64 * j]; rg[j] = gr[64 * j]; }
#pragma unroll
    for (int j = 0; j < 8; ++j) {
        f32x4 v = (f32x4){bflo(ra[j].x) + bflo(rb[j].x), bfhi(ra[j].x) + bfhi(rb[j].x), bflo(ra[j].y) + bflo(rb[j].y), bfhi(ra[j].y) + bfhi(rb[j].y)};
        float ss = (v.x * v.x + v.y * v.y) + (v.z * v.z + v.w * v.w);
#pragma unroll
        for (int o = 1; o < 32; o <<= 1) ss += __shfl_xor(ss, o);
        const float rs = 1.0f / sqrtf(ss * (1.0f / HD) + EPS);
        const v2u g = rg[j];
        v2u w; w.x = pk2(v.x * rs * hg.x * bflo(g.x), v.y * rs * hg.y * bfhi(g.x)); w.y = pk2(v.z * rs * hg.z * bflo(g.y), v.w * rs * hg.w * bfhi(g.y));
        o8[64 * j] = w;
    }
}

struct Args { const float* in[18]; float* out; unsigned char* ws; int ph_lo, ph_hi; };
__global__ void __launch_bounds__(NWAVES * 64, 2) fwd_kernel(Args args) {
    extern __shared__ __attribute__((aligned(16))) unsigned char lds_raw[];
    LAS unsigned char* lds = (LAS unsigned char*)lds_raw;
    volatile LAS unsigned* MISC = (volatile LAS unsigned*)(lds + MISC_OFF);
    const int G = gridDim.x, bx = blockIdx.x;
    const int vcu = (G % 8 == 0) ? (bx % 8) * (G / 8) + bx / 8 : bx;
    gu32* ctl = (gu32*)(args.ws + WS_CTL);
    for (int u = threadIdx.x; u < (LDS_BYTES - LDSCTL_OFF) / 4; u += NWAVES * 64) ((LAS unsigned*)(lds + LDSCTL_OFF))[u] = 0u;
    __syncthreads();
    XcdBarrier bar; bar.bar = (unsigned*)(args.ws + WS_CTL) + CW_BAR; bar.x = 0; bar.st = nullptr;
#if !MK_PER_PHASE
    bar = xcd_barrier_post((unsigned*)(args.ws + WS_CTL) + CW_BAR, MISC + 8);
#endif
    const int lo = args.ph_lo, hi = args.ph_hi;
#if DIAG_BAR
    unsigned diag_wait = 0; int diag_nb = 0;
#endif
#define IN(k) (lo <= (k) && (k) < hi)
#define BOTH(k) (IN(k) && IN((k) + 1))
#if MK_PER_PHASE
#define GRID_BAR() do { if (threadIdx.x == 0) __hip_atomic_store(ctl + CW_TMO, 0xBADBA0u, RLX_AGENT); } while (0)
#else
#if DIAG_BAR
#define GRID_BAR() do { const unsigned long long t_a = __builtin_amdgcn_s_memrealtime(); xcd_barrier(bar); const unsigned long long t_b = __builtin_amdgcn_s_memrealtime(); \
        if (DIAG_BAR < 100 || DIAG_BAR - 100 == diag_nb) diag_wait += (unsigned)(t_b - t_a); ++diag_nb; } while (0)
#else
#define GRID_BAR() xcd_barrier(bar)
#endif
#endif
#define WGU1 ((bf16*)(args.ws + WS_WGU1))
#define WGU2 ((bf16*)(args.ws + WS_WGU2))
#define WD1 ((bf16*)(args.ws + WS_WD1))
#define WD2 ((bf16*)(args.ws + WS_WD2))
#define WIN ((bf16*)(args.ws + WS_WIN))
#define WOUT ((bf16*)(args.ws + WS_WOUT))
#define R1 ((bf16*)(args.ws + WS_R1))
#define IT ((bf16*)(args.ws + WS_TT))
#define VT ((bf16*)(args.ws + WS_TT) + (size_t)HGW * MROWS)
#define R2 ((float*)(args.ws + WS_R2))
#define R3 ((bf16*)(args.ws + WS_R3))
#define LB ((float*)(args.ws + WS_LB))
#define RS ((float*)(args.ws + WS_LB + 64 * 1024))
#define PHASE_IDS() int tid = threadIdx.x; asm volatile("" : "+v"(tid)); const int lane = tid & 63, wave = __builtin_amdgcn_readfirstlane(tid >> 6); \
    const int gw = vcu * NWAVES + wave, NGW = G * NWAVES; (void)lane; (void)gw; (void)NGW
#define PHASE_GATEUP(k, W, AP, RSP, ATILED) if (IN(k)) { _Pragma("unroll") for (int rr_ = 0; rr_ < NREP(k); ++rr_) { \
        pg8::Gemm g{(AP), (W), MROWS, 2 * FF, DM}; pg8::StaticOrder S; S.init(MROWS, GU_MAIN_N, G, bx); S.wgm = WGM_GU; \
        pg8::EpiSwiGLU E{R1, FF, (RSP)}; \
        pg8::gemm_phase<pg8::EpiSwiGLU, pg8::StaticOrder, G_ALIGN, G_SP2, true, ATILED>(lds + RING_OFF, g, S, E); \
        pg8::gemm_half_units<pg8::EpiSwiGLU, true, ATILED>(lds + RING_OFF, g, GU_MAIN_N / 256, (2 * FF - GU_MAIN_N) / 256, E, bx, G); } \
        if (BOTH(k)) GRID_BAR(); }
#define PHASE_DOWN(k, W, RSP) if (IN(k)) { _Pragma("unroll") for (int rr_ = 0; rr_ < NREP(k); ++rr_) { \
        pg8::Gemm g{R1, (W), MROWS, DM, FF}; pg8::StaticOrder S; S.init(MROWS, DM, G, bx); S.wgm = WGM_DOWN; \
        pg8::EpiBf16Plain E{(bf16*)R2, DM, (RSP)}; \
        pg8::gemm_phase<pg8::EpiBf16Plain, pg8::StaticOrder, G_ALIGN, G_SP2, true, true>(lds + RING_OFF, g, S, E); } \
        if (BOTH(k)) GRID_BAR(); }
#define PHASE_NORM(k, BBF, OBF, BASE, HOUT, WGT, GPOST, HASU) if (IN(k)) { PHASE_IDS(); \
        _Pragma("unroll") for (int rr_ = 0; rr_ < NREP(k); ++rr_) for (int m = gw; m < MROWS; m += NGW) \
            norm_res_row<BBF, OBF>((const bf16*)R2 + (size_t)m * DM, (const void*)(BASE), (void*)(HOUT), (WGT), (GPOST), (HASU) ? RS + m : (float*)nullptr, lane); \
        if (BOTH(k)) GRID_BAR(); }
#define HB ((bf16*)(args.ws + WS_R2 + 128 * MiB))

    if (IN(0)) { PHASE_IDS();
        LAS float* scr = (LAS float*)(lds + RING_OFF + wave * 16384);
        constexpr int I_GU = (DM / 64) * (FF / 32), I_D = (FF / 64) * (DM / 32), I_IN = (DM / 64) * (16384 / 32), I_OUT = (DM / 64) * (DM / 32);
        constexpr int NITEMS = 6 * I_GU + I_IN + I_OUT;
        static_assert(I_GU == I_D, "items");
        for (int rr_ = 0; rr_ < NREP(0); ++rr_)
        for (int it = gw; it < NITEMS; it += NGW) {
            int r = it; const float* W; bf16* WT; int K = DM, N = FF, mode = 0; const float* gain = nullptr;
            if (r < I_GU) { W = args.in[2]; WT = WGU1; mode = 1; gain = args.in[1]; }
            else if ((r -= I_GU) < I_GU) { W = args.in[3]; WT = WGU1; mode = 2; gain = args.in[1]; }
            else if ((r -= I_GU) < I_D) { W = args.in[4]; WT = WD1; K = FF; N = DM; }
            else if ((r -= I_D) < I_IN) { W = args.in[7]; WT = WIN; N = 16384; mode = 3; gain = args.in[6]; }
            else if ((r -= I_IN) < I_OUT) { W = args.in[11]; WT = WOUT; N = DM; }
            else if ((r -= I_OUT) < I_GU) { W = args.in[14]; WT = WGU2; mode = 1; gain = args.in[13]; }
            else if ((r -= I_GU) < I_GU) { W = args.in[15]; WT = WGU2; mode = 2; gain = args.in[13]; }
            else { r -= I_GU; W = args.in[16]; WT = WD2; K = FF; N = DM; }
            transpose_item(W, K, N, WT, mode, scr, r, lane, gain, (mode == 3) ? PROJ_W : (1 << 30), mode == 1 ? 1.4426950408889634f : mode == 2 ? 0.6931471805599453f : 1.0f);
        }
        for (int mp = gw; mp < MROWS / 2; mp += NGW) rms_rowpair_to_bf16_tiled(args.in[0], R3, 2 * mp, lane);
        for (int i = bx * 512 + tid; i < 2 * HGW; i += G * 512) { const float l0 = args.in[8][i], l1 = args.in[8][2 * HGW + i]; LB[i] = 1.0f / (1.0f + expf(l1 - l0)); }
        if (BOTH(0)) GRID_BAR();
    }
    PHASE_GATEUP(1, WGU1, R3, (const float*)nullptr, true)
    PHASE_DOWN(2, WD1, (const float*)nullptr)
    PHASE_NORM(3, false, true, args.in[0] + (size_t)m * DM, HB + (size_t)m * DM, 0.5f, args.in[5], true)
    if (IN(3) && IN(4)) { for (int eb = 0; eb < EXTRA_BARS; ++eb) GRID_BAR(); }
    if (IN(4)) {
#pragma unroll
        for (int rr_ = 0; rr_ < NREP(4); ++rr_) {
        { pg8::Gemm g{HB, WIN, MROWS, PROJ_W, DM}; pg8::StaticOrder S; S.init(MROWS, PROJ_W, G, bx); S.wgm = WGM_IN;
          pg8::EpiProj E{R1, PROJ_W, LB, (const float*)nullptr};
          pg8::gemm_phase<pg8::EpiProj, pg8::StaticOrder, G_ALIGN, G_SP2, true>(lds + RING_OFF, g, S, E); }
        { pg8::Gemm g{WIN + (size_t)PROJ_W * DM, HB, HGW + NAW, MROWS, DM}; pg8::StaticOrder S; S.init(HGW + NAW, MROWS, G, bx); S.wgm = WGM_TT;
          pg8::EpiBf16Plain E{IT, MROWS, (const float*)nullptr};
          pg8::gemm_phase<pg8::EpiBf16Plain, pg8::StaticOrder, G_ALIGN, G_SP2>(lds + RING_OFF, g, S, E); }
        }
        if (BOTH(4)) GRID_BAR();
    }
    if (IN(5)) { PHASE_IDS();
        for (int rr_ = 0; rr_ < NREP(5); ++rr_)
        if (bx < 2 * BATCH * NHEAD) { const int dir = bx & 1, h = (bx >> 1) & 15, b = bx >> 5;
            hgrn_mfma_unit(lds + RING_OFF, R1, IT, (bf16*)R2 + (size_t)dir * MROWS * HGW, b, h, dir, tid); }
        { LAS float* tbl = (LAS float*)(lds + RING_OFF);
          for (int q = tid; q < NHEAD * 15 * 31; q += 512) tbl[q] = args.in[10][q];
          __syncthreads();
          const int xq = (int)(xb_xcc_id() & 7u);
          for (int rr_ = 0; rr_ < NREP(12); ++rr_)
          for (int qq = 0; qq < 8; ++qq) { const int q = (xq + qq) & 7;
            for (;;) {
              if (tid == 0) MISC[16] = __hip_atomic_fetch_add(ctl + CW_QUEUE + 64 * (8 * rr_ + q), 1u, RLX_AGENT);
              __syncthreads();
              const int li = (int)MISC[16];
              __syncthreads();
              if (li >= 128) break;
              const int rq = li & 15, bh = q * 8 + (li >> 4), h = bh & 15, b = bh >> 4;
              na_pair_mfma(tbl, R1, VT, R3, b, h, 2 * rq + (wave >> 2), wave & 3, lane);
            } }
        }
        if (BOTH(5)) GRID_BAR();
    }
    if (IN(6)) { PHASE_IDS();
        for (int rr_ = 0; rr_ < NREP(6); ++rr_)
        for (int m = gw; m < MROWS; m += NGW)
            hgrn_combine_row((const bf16*)R2 + (size_t)m * HGW, (const bf16*)R2 + (size_t)MROWS * HGW + (size_t)m * HGW, R1 + (size_t)m * PROJ_W + C_GATE, args.in[9], R3 + (size_t)m * DM, lane);
        if (BOTH(6)) GRID_BAR();
    }
    if (IN(7)) {
#pragma unroll
        for (int rr_ = 0; rr_ < NREP(7); ++rr_) {
        pg8::Gemm g{R3, WOUT, MROWS, DM, DM}; pg8::StaticOrder S; S.init(MROWS, DM, G, bx); S.nrep = P7_INNER_REP; S.wgm = WGM_OUT;
        pg8::EpiBf16Plain E{(bf16*)R2, DM, (const float*)nullptr};
        pg8::gemm_phase<pg8::EpiBf16Plain, pg8::StaticOrder, G_ALIGN, G_SP2, true>(lds + RING_OFF, g, S, E); }
        if (BOTH(7)) GRID_BAR();
    }
    if (IN(8)) { PHASE_IDS();
        LAS float* gl = (LAS float*)(lds + RING_OFF);
        for (int i = tid; i < DM / 4; i += 512) ((LAS f32x4*)gl)[i] = ((const GAS f32x4*)args.in[12])[i];
        __syncthreads();
        _Pragma("unroll") for (int rr_ = 0; rr_ < NREP(8); ++rr_) for (int mp = gw; mp < MROWS / 2; mp += NGW)
            norm_res_rowpair<false, true>((const bf16*)R2, HB, (void*)R3, 1.0f, gl, RS, RS, 2 * mp, lane);
        if (BOTH(8)) GRID_BAR(); }
    PHASE_GATEUP(9, WGU2, R3, (const float*)nullptr, true)
    PHASE_DOWN(10, WD2, (const float*)nullptr)
    if (IN(11)) { PHASE_IDS();
        LAS float* gl = (LAS float*)(lds + RING_OFF);
        for (int i = tid; i < DM / 4; i += 512) ((LAS f32x4*)gl)[i] = ((const GAS f32x4*)args.in[17])[i];
        __syncthreads();
        for (int mp = gw; mp < MROWS / 2; mp += NGW)
            norm_res_rowpair<true, false>((const bf16*)R2, R3, (void*)args.out, 0.5f, gl, (float*)nullptr, RS, 2 * mp, lane); }
#if DIAG_BAR
    if (threadIdx.x == 0) { gu32* dw = ctl + 12288;
        __hip_atomic_fetch_add(dw, diag_wait, RLX_AGENT); __hip_atomic_fetch_max(dw + 64, diag_wait, RLX_AGENT);
        __threadfence();
        const unsigned prev = __hip_atomic_fetch_add(dw + 128, 1u, RLX_AGENT);
        if (prev == (unsigned)G - 1u) { __threadfence(); const unsigned sum = __hip_atomic_load(dw, RLX_AGENT), mx = __hip_atomic_load(dw + 64, RLX_AGENT);
            const float val = (DIAG_BAR == 2) ? (float)mx * 0.01f : (float)sum * 0.01f / (float)G;
            args.out[0] = 1000.0f + floorf(val * (1.0f / 40.0f)) * 40.0f; } }
#endif
#if !MK_PER_PHASE
    if (IN(11)) { if (xb_ld((unsigned*)(args.ws + WS_CTL) + CW_BAR + XB_TMO) != 0u) { const float q = __builtin_nanf(""); for (int m = bx; m < MROWS; m += G) for (int c = threadIdx.x; c < DM; c += 512) args.out[(size_t)m * DM + c] = q; } }
#endif
#undef IN
#undef BOTH
}

extern "C" void kernel_launch(void* const* d_in, const int* in_sizes, int n_in, void* d_out, int out_size, void* d_ws, size_t ws_size, hipStream_t stream) {
    static int grid = 0;
    if (grid == 0) {
        if (n_in != 18 || in_sizes[0] != MROWS * DM || out_size != MROWS * DM || ws_size < WS_END) {
            fprintf(stderr, "kernel_launch: unexpected shapes (n_in %d, in0 %d, out %d, ws %zu need %zu); nothing launched\n", n_in, n_in > 0 ? in_sizes[0] : -1, out_size, ws_size, (size_t)WS_END); grid = -1; return; }
        int dev = 0, cus = 0;
        if (hipGetDevice(&dev) != hipSuccess || hipDeviceGetAttribute(&cus, hipDeviceAttributeMultiprocessorCount, dev) != hipSuccess) { grid = -1; return; }
        if (hipFuncSetAttribute((const void*)fwd_kernel, hipFuncAttributeMaxDynamicSharedMemorySize, LDS_BYTES) != hipSuccess) { fprintf(stderr, "kernel_launch: hipFuncSetAttribute failed\n"); grid = -1; return; }
        int per_cu = 0;
        if (hipOccupancyMaxActiveBlocksPerMultiprocessor(&per_cu, (const void*)fwd_kernel, NWAVES * 64, LDS_BYTES) != hipSuccess || per_cu < 1)
            fprintf(stderr, "kernel_launch: note: occupancy query reports %d workgroups per CU\n", per_cu);
        (void)hipGetLastError();
        grid = cus;
    }
    if (grid < 0) return;
    if (hipMemsetAsync((char*)d_ws + WS_CTL, 0, CTL_ZERO_BYTES, stream) != hipSuccess) { fprintf(stderr, "kernel_launch: memset failed\n"); return; }
    Args a{};
    for (int i = 0; i < 18; ++i) a.in[i] = (const float*)d_in[i];
    a.out = (float*)d_out; a.ws = (unsigned char*)d_ws;
#if MK_PER_PHASE
    for (int p = 0; p < N_PHASES; ++p) { a.ph_lo = p; a.ph_hi = p + 1; hipLaunchKernelGGL(fwd_kernel, dim3(grid), dim3(NWAVES * 64), LDS_BYTES, stream, a); }
#else
    a.ph_lo = 0; a.ph_hi = N_PHASES;
    hipLaunchKernelGGL(fwd_kernel, dim3(grid), dim3(NWAVES * 64), LDS_BYTES, stream, a);
#endif
    const hipError_t le = hipPeekAtLastError();
    if (le != hipSuccess) fprintf(stderr, "kernel_launch: launch failed: %s\n", hipGetErrorName(le));
}
```
